# Optimizing an MI355X kernel written in HIP

```python
import math
import jax, jax.numpy as jnp
from jax import lax
import numpy as np

D_MODEL = 1024
BATCH = 8
SEQ = 2048
DEPTH = 1
DEC_BATCH = 128
DEC_SEQ = 4
PAST_LEN = 16384
PAGE_SIZE = 128

D_MIX = D_MODEL
D_LRU = D_MIX // 2
D_SCONV = D_MIX - D_LRU
N_LRU_HEADS = 8
LRU_HEAD_DIM = D_LRU // N_LRU_HEADS
N_SCONV_GROUPS = 8
LRU_CONV_W = 4
SCONV_W = 3
RG_C = 8.0
D_FF = 3 * D_MODEL
N_MOD = 9
D_IN = 2 * D_LRU + 3 * D_SCONV
EPS = 1e-6

kernel_name = "hymba_rglru_shortconv_macaron_adaln_step"


def rmsnorm(x, g):
    xf = x.astype(jnp.float32)
    r = xf * lax.rsqrt(jnp.mean(xf * xf, axis=-1, keepdims=True) + EPS)
    return (r * g.astype(jnp.float32)).astype(x.dtype)


def modulate(h, shift, scale):
    return h * (1 + scale[:, None, :]) + shift[:, None, :]


def swiglu(h, w_gate, w_up, w_down):
    return (jax.nn.silu(h @ w_gate) * (h @ w_up)) @ w_down


def causal_dwconv(buf, u, w):
    K = w.shape[0]
    T = u.shape[1]
    full = jnp.concatenate([buf, u], axis=1)
    out = full[:, 0:T] * w[0]
    for k in range(1, K):
        out = out + full[:, k:k + T] * w[k]
    return out, full[:, -(K - 1):]


def rglru(xc, h0, w_a, b_a, w_x, b_x, lam):
    B, T, _ = xc.shape
    xh = xc.reshape(B, T, N_LRU_HEADS, LRU_HEAD_DIM)
    r = jax.nn.sigmoid(jnp.einsum('bthi,hij->bthj', xh, w_a) + b_a).reshape(B, T, D_LRU)
    i = jax.nn.sigmoid(jnp.einsum('bthi,hij->bthj', xh, w_x) + b_x).reshape(B, T, D_LRU)
    log_a = -RG_C * r.astype(jnp.float32) * jax.nn.softplus(-lam.astype(jnp.float32))
    a = jnp.exp(log_a)
    mult = jnp.sqrt(-jnp.expm1(2.0 * log_a))
    b = mult * (i.astype(jnp.float32) * xc.astype(jnp.float32))
    b = b.at[:, 0].add(a[:, 0] * h0.astype(jnp.float32))

    def combine(left, right):
        a1, b1 = left
        a2, b2 = right
        return a1 * a2, a2 * b1 + b2

    _, h = lax.associative_scan(combine, (a, b), axis=1)
    return h.astype(xc.dtype), h[:, -1].astype(xc.dtype)


def mixer(h, lru_buf, h0, sc_buf, w_mix_in, w_lru_conv, b_lru_conv, w_gate_a, b_gate_a,
          w_gate_x, b_gate_x, lru_lambda, w_sconv, w_mix_out):
    z = h @ w_mix_in
    x_l = z[..., 0:D_LRU]
    g_l = z[..., D_LRU:2 * D_LRU]
    o = 2 * D_LRU
    b_s = z[..., o:o + D_SCONV]
    c_s = z[..., o + D_SCONV:o + 2 * D_SCONV]
    v_s = z[..., o + 2 * D_SCONV:o + 3 * D_SCONV]
    xc, new_lru_buf = causal_dwconv(lru_buf, x_l, w_lru_conv)
    xc = xc + b_lru_conv
    hl, h_last = rglru(xc, h0, w_gate_a, b_gate_a, w_gate_x, b_gate_x, lru_lambda)
    lru_out = hl * jax.nn.gelu(g_l)
    u = c_s * v_s
    cv, new_sc_buf = causal_dwconv(sc_buf, u, w_sconv)
    sc_out = b_s * cv
    out = jnp.concatenate([lru_out, sc_out], axis=-1) @ w_mix_out
    return out, new_lru_buf, h_last, new_sc_buf


def layer(x, c, lru_buf, h0, sc_buf, w_ada, b_ada, g_ffn1, w1_gate, w1_up, w1_down, g_mix,
          w_mix_in, w_lru_conv, b_lru_conv, w_gate_a, b_gate_a, w_gate_x, b_gate_x, lru_lambda,
          w_sconv, w_mix_out, g_ffn2, w2_gate, w2_up, w2_down):
    B = x.shape[0]
    mod = (jax.nn.silu(c) @ w_ada + b_ada).reshape(B, N_MOD, D_MODEL)
    hn = modulate(rmsnorm(x, g_ffn1), mod[:, 0], mod[:, 1])
    x = x + 0.5 * mod[:, 2][:, None, :] * swiglu(hn, w1_gate, w1_up, w1_down)
    hn = modulate(rmsnorm(x, g_mix), mod[:, 3], mod[:, 4])
    mo, new_lru_buf, h_last, new_sc_buf = mixer(hn, lru_buf, h0, sc_buf, w_mix_in, w_lru_conv,
                                                b_lru_conv, w_gate_a, b_gate_a, w_gate_x, b_gate_x,
                                                lru_lambda, w_sconv, w_mix_out)
    x = x + mod[:, 5][:, None, :] * mo
    hn = modulate(rmsnorm(x, g_ffn2), mod[:, 6], mod[:, 7])
    x = x + 0.5 * mod[:, 8][:, None, :] * swiglu(hn, w2_gate, w2_up, w2_down)
    return x, new_lru_buf, h_last, new_sc_buf


def setup_inputs(seed: int = 0) -> dict:
    key = jax.random.key(seed)
    ks = jax.random.split(key, 32)
    f32 = jnp.float32
    n = lambda k, shape, s: (jax.random.normal(k, shape, f32) * s)
    a_base = jax.random.uniform(ks[20], (DEPTH, D_LRU), f32, 0.9, 0.999) ** (1.0 / RG_C)
    lru_lambda = jnp.log(a_base / (1.0 - a_base))
    return {
        "x_prompt": n(ks[0], (BATCH, SEQ, D_MODEL), 1.0),
        "x_sample": n(ks[1], (DEC_BATCH, DEC_SEQ, D_MODEL), 1.0),
        "state_lru_conv": n(ks[2], (DEPTH, DEC_BATCH, LRU_CONV_W - 1, D_LRU), 0.5),
        "state_lru_h": n(ks[3], (DEPTH, DEC_BATCH, D_LRU), 0.5),
        "state_sconv": n(ks[4], (DEPTH, DEC_BATCH, SCONV_W - 1, D_SCONV), 0.5),
        "c_prompt": n(ks[5], (BATCH, D_MODEL), 1.0),
        "c_sample": n(ks[6], (DEC_BATCH, D_MODEL), 1.0),
        "w_ada": n(ks[7], (DEPTH, D_MODEL, N_MOD * D_MODEL), D_MODEL ** -0.5),
        "b_ada": n(ks[8], (DEPTH, N_MOD * D_MODEL), 0.02),
        "g_ffn1": 1.0 + n(ks[9], (DEPTH, D_MODEL), 0.02),
        "w1_gate": n(ks[10], (DEPTH, D_MODEL, D_FF), D_MODEL ** -0.5),
        "w1_up": n(ks[11], (DEPTH, D_MODEL, D_FF), D_MODEL ** -0.5),
        "w1_down": n(ks[12], (DEPTH, D_FF, D_MODEL), D_FF ** -0.5),
        "g_mix": 1.0 + n(ks[13], (DEPTH, D_MODEL), 0.02),
        "w_mix_in": n(ks[14], (DEPTH, D_MODEL, D_IN), D_MODEL ** -0.5),
        "w_lru_conv": n(ks[15], (DEPTH, LRU_CONV_W, D_LRU), LRU_CONV_W ** -0.5),
        "b_lru_conv": n(ks[16], (DEPTH, D_LRU), 0.02),
        "w_gate_a": n(ks[17], (DEPTH, N_LRU_HEADS, LRU_HEAD_DIM, LRU_HEAD_DIM), LRU_HEAD_DIM ** -0.5),
        "b_gate_a": n(ks[18], (DEPTH, N_LRU_HEADS, LRU_HEAD_DIM), 0.02),
        "w_gate_x": n(ks[19], (DEPTH, N_LRU_HEADS, LRU_HEAD_DIM, LRU_HEAD_DIM), LRU_HEAD_DIM ** -0.5),
        "b_gate_x": n(ks[21], (DEPTH, N_LRU_HEADS, LRU_HEAD_DIM), 0.02),
        "lru_lambda": lru_lambda,
        "w_sconv": n(ks[22], (DEPTH, SCONV_W, D_SCONV), SCONV_W ** -0.5),
        "w_mix_out": n(ks[23], (DEPTH, D_MIX, D_MODEL), D_MIX ** -0.5),
        "g_ffn2": 1.0 + n(ks[24], (DEPTH, D_MODEL), 0.02),
        "w2_gate": n(ks[25], (DEPTH, D_MODEL, D_FF), D_MODEL ** -0.5),
        "w2_up": n(ks[26], (DEPTH, D_MODEL, D_FF), D_MODEL ** -0.5),
        "w2_down": n(ks[27], (DEPTH, D_FF, D_MODEL), D_FF ** -0.5),
        "final_gain": 1.0 + n(ks[28], (D_MODEL,), 0.02),
    }


def reference(x_prompt, x_sample, state_lru_conv, state_lru_h, state_sconv, c_prompt, c_sample,
              w_ada, b_ada, g_ffn1, w1_gate, w1_up, w1_down, g_mix, w_mix_in, w_lru_conv, b_lru_conv,
              w_gate_a, b_gate_a, w_gate_x, b_gate_x, lru_lambda, w_sconv, w_mix_out,
              g_ffn2, w2_gate, w2_up, w2_down, final_gain):
    Bp = x_prompt.shape[0]
    dt = x_prompt.dtype
    xp = x_prompt
    xs = x_sample
    p_conv, p_h, p_sc = [], [], []
    s_conv, s_h, s_sc = [], [], []
    for l in range(DEPTH):
        w = (w_ada[l], b_ada[l], g_ffn1[l], w1_gate[l], w1_up[l], w1_down[l], g_mix[l], w_mix_in[l],
             w_lru_conv[l], b_lru_conv[l], w_gate_a[l], b_gate_a[l], w_gate_x[l], b_gate_x[l],
             lru_lambda[l], w_sconv[l], w_mix_out[l], g_ffn2[l], w2_gate[l], w2_up[l], w2_down[l])
        z_conv = jnp.zeros((Bp, LRU_CONV_W - 1, D_LRU), dt)
        z_h = jnp.zeros((Bp, D_LRU), dt)
        z_sc = jnp.zeros((Bp, SCONV_W - 1, D_SCONV), dt)
        xp, nc, nh, ns = layer(xp, c_prompt, z_conv, z_h, z_sc, *w)
        p_conv.append(nc); p_h.append(nh); p_sc.append(ns)
        xs, nc, nh, ns = layer(xs, c_sample, state_lru_conv[l], state_lru_h[l], state_sconv[l], *w)
        s_conv.append(nc); s_h.append(nh); s_sc.append(ns)
    y_prompt = rmsnorm(xp, final_gain)
    y_sample = rmsnorm(xs, final_gain)
    new_lru_conv_prompt = jnp.stack(p_conv)
    new_lru_h_prompt = jnp.stack(p_h)
    new_sconv_prompt = jnp.stack(p_sc)
    new_lru_conv_sample = jnp.stack(s_conv)
    new_lru_h_sample = jnp.stack(s_h)
    new_sconv_sample = jnp.stack(s_sc)
    return (y_prompt, y_sample, new_lru_conv_prompt, new_lru_h_prompt, new_sconv_prompt,
            new_lru_conv_sample, new_lru_h_sample, new_sconv_sample)
```

```cpp
#include <hip/hip_runtime.h>
#include <hip/hip_cooperative_groups.h>
#include <cstdio>
#include <cstdint>
namespace cg = cooperative_groups;

#ifndef MK_N_LAUNCHES
#define MK_N_LAUNCHES 13
#endif

constexpr int D = 1024, NP = 16384, NS = 512, M = NP + NS, FF = 3072, DIN = 2560, DL = 512;
constexpr int TP = 2048, NBATCH = 136, NMOD = 9;
constexpr float EPS = 1e-6f;
__device__ __forceinline__ int row_batch(int r) { return r < NP ? (r >> 11) : 8 + ((r - NP) >> 2); }

namespace pg8 {
#define PG8_LAS __attribute__((address_space(3)))
typedef unsigned short bf16_t;
typedef short bf16x8 __attribute__((ext_vector_type(8)));
typedef float f32x4 __attribute__((ext_vector_type(4)));
typedef unsigned u32x4 __attribute__((ext_vector_type(4)));
constexpr int BM = 256, BK = 64, HALF = 128, HTB = HALF * BK * 2  , STAGE_BYTES = 8 * HTB, NXCD = 8, WGM = 8;

__host__ __device__ __forceinline__ int lds_byte(int r, int c) { const int st = (r >> 4) * 2 + (c >> 5), rr = r & 15, cc = c & 31, ob = rr * 64 + cc * 2; return st * 1024 + (ob ^ (((ob >> 9) & 1) << 5)); }
__host__ __device__ __forceinline__ void stage_rc(int b, int& R, int& C) { const int st = b / 1024, sb = b % 1024, swz = sb ^ (((sb >> 9) & 1) << 5); R = (st >> 1) * 16 + swz / 64; C = (st & 1) * 32 + (swz % 64) / 2; }
__host__ __device__ __forceinline__ int perm32(int rho) { const int n = rho >> 4, i = rho & 15; return 8 * (i >> 2) + 4 * n + (i & 3); }

struct Unit { int pm, pn; };
struct Gemm { const bf16_t* A; const bf16_t* Bt; int M, N, K; };

struct StaticOrder {
    int nM, nN, nwg, G, c;
    __host__ __device__ void init(int M, int N, int G_, int c_) { nM = M / BM; nN = N / BM; nwg = nM * nN; G = G_; c = c_; }
    __host__ __device__ bool next(int i, Unit& u) const {
        const long L = (long)i * G + c; if (L >= nwg) return false;
        int wgid = (int)L; { const int q = nwg / NXCD, r = nwg % NXCD, xcd = wgid % NXCD, off = wgid / NXCD; wgid = (xcd < r ? xcd * (q + 1) : r * (q + 1) + (xcd - r) * q) + off; }
        const int nig = WGM * nN, gid = wgid / nig, fm = gid * WGM, gsz = (nM - fm) < WGM ? (nM - fm) : WGM;
        u.pm = fm + ((wgid % nig) % gsz); u.pn = (wgid % nig) / gsz; return true;
    }
    __device__ __forceinline__ void a_ready(const Unit&) const {}
    __device__ __forceinline__ void done(const Unit&) const {}
};

__device__ __forceinline__ unsigned cvt_pk_bf16(float lo, float hi) { unsigned r; asm volatile("v_cvt_pk_bf16_f32 %0, %1, %2" : "=v"(r) : "v"(lo), "v"(hi)); return r; }
__device__ __forceinline__ float silu_f(float g) { return g * __builtin_amdgcn_rcpf(1.0f + __builtin_amdgcn_exp2f(g * -1.44269504089f)); }

struct EpiBf16 {
    static constexpr bool PERM = true, AFTER_DRAIN = false;
    bf16_t* O; int ldc;
    __device__ __forceinline__ void operator()(const f32x4 (&acc)[2][2][4][2], const Unit& u, int wr, int wc, int fr, int fq) const {
        const int row0 = u.pm * BM + wr * 64 + fr; const int col0 = u.pn * BM + wc * 32 + 8 * fq;
#pragma unroll
        for (int ai = 0; ai < 2; ++ai)
#pragma unroll
            for (int m = 0; m < 4; ++m) { bf16_t* rowp = O + (size_t)(row0 + ai * HALF + m * 16) * ldc + col0;
#pragma unroll
                for (int bj = 0; bj < 2; ++bj) { const f32x4 v0 = acc[ai][bj][m][0], v1 = acc[ai][bj][m][1];
                    u32x4 w; w.x = cvt_pk_bf16(v0[0], v0[1]); w.y = cvt_pk_bf16(v0[2], v0[3]); w.z = cvt_pk_bf16(v1[0], v1[1]); w.w = cvt_pk_bf16(v1[2], v1[3]);
                    *(u32x4*)(rowp + bj * HALF) = w; } }
    }
};
struct EpiSwiglu {
    static constexpr bool PERM = true, AFTER_DRAIN = false;
    bf16_t* O; int ldc;
    __device__ __forceinline__ void operator()(const f32x4 (&acc)[2][2][4][2], const Unit& u, int wr, int wc, int fr, int fq) const {
        const int row0 = u.pm * BM + wr * 64 + fr; const int col0 = u.pn * HALF + wc * 32 + 8 * fq;
#pragma unroll
        for (int ai = 0; ai < 2; ++ai)
#pragma unroll
            for (int m = 0; m < 4; ++m) { bf16_t* rowp = O + (size_t)(row0 + ai * HALF + m * 16) * ldc + col0;
                const f32x4 g0 = acc[ai][0][m][0], g1 = acc[ai][0][m][1], u0 = acc[ai][1][m][0], u1 = acc[ai][1][m][1];
                u32x4 w;
                w.x = cvt_pk_bf16(silu_f(g0[0]) * u0[0], silu_f(g0[1]) * u0[1]); w.y = cvt_pk_bf16(silu_f(g0[2]) * u0[2], silu_f(g0[3]) * u0[3]);
                w.z = cvt_pk_bf16(silu_f(g1[0]) * u1[0], silu_f(g1[1]) * u1[1]); w.w = cvt_pk_bf16(silu_f(g1[2]) * u1[2], silu_f(g1[3]) * u1[3]);
                *(u32x4*)rowp = w; }
    }
};
struct EpiResid {
    static constexpr bool PERM = false, AFTER_DRAIN = false;
    const float* baseP; const float* baseS; float* out; const float* mod; int idx; float fac;
    __device__ __forceinline__ void operator()(const f32x4 (&acc)[2][2][4][2], const Unit& u, int wr, int wc, int fr, int fq) const {
        const int colb = u.pn * BM + wc * 32 + 4 * fq;
#pragma unroll
        for (int ai = 0; ai < 2; ++ai)
#pragma unroll
            for (int m = 0; m < 4; ++m) {
                const int r = u.pm * BM + ai * HALF + wr * 64 + m * 16 + fr;
                const float* bp = (r < NP) ? baseP + (size_t)r * D : baseS + (size_t)(r - NP) * D;
                const float* mp = mod + (size_t)(row_batch(r) * NMOD + idx) * D;
                float* op = out + (size_t)r * D;
#pragma unroll
                for (int bj = 0; bj < 2; ++bj)
#pragma unroll
                    for (int n = 0; n < 2; ++n) { const int c = colb + bj * HALF + n * 16;
                        const f32x4 bs = *(const f32x4*)(bp + c); const f32x4 mv = *(const f32x4*)(mp + c);
                        *(f32x4*)(op + c) = bs + (mv * fac) * acc[ai][bj][m][n]; }
                if (m & 1) asm volatile("" ::: "memory"); }
    }
};

template <class Epi, class Sched, bool ALIGN_EPI = false, bool SP2 = false>
__device__ __forceinline__ void gemm_phase(PG8_LAS unsigned char* lds, const Gemm g, const Sched& S, const Epi& E) {
    const int tid = threadIdx.x, wid = __builtin_amdgcn_readfirstlane(tid >> 6), lane = tid & 63, wr = wid >> 2, wc = wid & 3, fr = lane & 15, fq = lane >> 4;
    const int K = g.K, nt = K / BK;
    unsigned voffA[2], voffB[2];
#pragma unroll
    for (int i = 0; i < 2; ++i) { int R, C; stage_rc(tid * 16 + i * 8192, R, C); const int Rb = Epi::PERM ? ((R & ~31) + perm32(R & 31)) : R;
        voffA[i] = (unsigned)(R * K + C) * 2u; voffB[i] = (unsigned)(Rb * K + C) * 2u; }
    const size_t kstep = (size_t)(BK * 2);
    const size_t hstep = (size_t)HALF * K * 2;
    const size_t tstep = 2 * hstep;
    const unsigned ldsw = (unsigned)wid * 1024u;
    const int aoff = lds_byte(wr * 64 + fr, fq * 8), boff = lds_byte(wc * 32 + fr, fq * 8);
#define PG8_SA(b, h) (((b) * 2 + (h)) * HTB)
#define PG8_SB(b, h) ((4 + (b) * 2 + (h)) * HTB)
#define PG8_STAGE(bufoff, gbase, voff) do { _Pragma("unroll") for (int _i = 0; _i < 2; ++_i) \
        __builtin_amdgcn_global_load_lds((const unsigned*)((const char*)(gbase) + (voff)[_i]), (PG8_LAS unsigned*)(lds + (bufoff) + ldsw + _i * 8192), 16, 0, 0); } while (0)
#define PG8_LDA(dst, b, h) do { _Pragma("unroll") for (int m = 0; m < 4; ++m) _Pragma("unroll") for (int k = 0; k < 2; ++k) dst[m][k] = *(const PG8_LAS bf16x8*)(lds + PG8_SA(b, h) + aoff + m * 2048 + k * 1024); } while (0)
#define PG8_LDB(dst, b, h) do { _Pragma("unroll") for (int n = 0; n < 2; ++n) _Pragma("unroll") for (int k = 0; k < 2; ++k) dst[n][k] = *(const PG8_LAS bf16x8*)(lds + PG8_SB(b, h) + boff + n * 2048 + k * 1024); } while (0)
#define PG8_MMA(ai, bj, At, Bt) do { __builtin_amdgcn_s_setprio(1); _Pragma("unroll") for (int m = 0; m < 4; ++m) _Pragma("unroll") for (int n = 0; n < 2; ++n) _Pragma("unroll") for (int k = 0; k < 2; ++k) \
        acc[ai][bj][m][n] = __builtin_amdgcn_mfma_f32_16x16x32_bf16(Bt[n][k], At[m][k], acc[ai][bj][m][n], 0, 0, 0); __builtin_amdgcn_s_setprio(0); } while (0)
#define PG8_WAIT_V(n) asm volatile("s_waitcnt vmcnt(" #n ")" ::: "memory")
#define PG8_WAIT_L(n) asm volatile("s_waitcnt lgkmcnt(" #n ")" ::: "memory")
#define PG8_BAR __builtin_amdgcn_s_barrier()
#define PG8_SCHED __builtin_amdgcn_sched_barrier(0)
    Unit cur, nxt; int ui = 0;
    if (!S.next(0, cur)) return;
    f32x4 acc[2][2][4][2];
#pragma unroll
    for (int a = 0; a < 2; ++a)
#pragma unroll
        for (int b = 0; b < 2; ++b)
#pragma unroll
            for (int m = 0; m < 4; ++m)
#pragma unroll
                for (int n = 0; n < 2; ++n) acc[a][b][m][n] = (f32x4){0.f, 0.f, 0.f, 0.f};
    bf16x8 At[4][2], B0[2][2], B1[2][2];
    const char* cA = (const char*)g.A + (size_t)cur.pm * tstep; const char* cB = (const char*)g.Bt + (size_t)cur.pn * tstep;
    S.a_ready(cur);
    if constexpr (SP2) {
        PG8_STAGE(PG8_SB(0, 0), cB, voffB); PG8_STAGE(PG8_SB(0, 1), cB + hstep, voffB); PG8_STAGE(PG8_SA(0, 0), cA, voffA); PG8_STAGE(PG8_SA(0, 1), cA + hstep, voffA);
        if (wr == 1) PG8_BAR;
        PG8_WAIT_V(2); PG8_BAR;
        PG8_STAGE(PG8_SB(1, 0), cB + kstep, voffB); PG8_STAGE(PG8_SA(1, 0), cA + kstep, voffA); PG8_STAGE(PG8_SB(1, 1), cB + hstep + kstep, voffB);
        PG8_WAIT_V(6); PG8_BAR;
    } else {
        PG8_STAGE(PG8_SB(0, 0), cB, voffB); PG8_STAGE(PG8_SA(0, 0), cA, voffA); PG8_STAGE(PG8_SB(0, 1), cB + hstep, voffB); PG8_STAGE(PG8_SA(0, 1), cA + hstep, voffA);
        if (wr == 1) PG8_BAR;
        PG8_WAIT_V(4); PG8_BAR;
        PG8_STAGE(PG8_SB(1, 0), cB + kstep, voffB); PG8_STAGE(PG8_SA(1, 0), cA + kstep, voffA); PG8_STAGE(PG8_SB(1, 1), cB + hstep + kstep, voffB);
        PG8_WAIT_V(6); PG8_BAR;
    }
    for (;;) {
        const bool has_next = S.next(ui + 1, nxt);
        const char* nA = has_next ? (const char*)g.A + (size_t)nxt.pm * tstep : cA; const char* nB = has_next ? (const char*)g.Bt + (size_t)nxt.pn * tstep : cB;
        for (int t = 0; t < nt; t += 2) {
            const bool last = (t == nt - 2);
            const char* a1 = cA + (size_t)(t + 1) * kstep;
            const char* a2 = last ? nA : cA + (size_t)(t + 2) * kstep; const char* b2 = last ? nB : cB + (size_t)(t + 2) * kstep;
            const char* a3 = a2 + kstep; const char* b3 = b2 + kstep;
            if (last && has_next) S.a_ready(nxt);
            if constexpr (SP2) {
            PG8_LDB(B0, 0, 0); PG8_LDB(B1, 0, 1); PG8_SCHED; PG8_LDA(At, 0, 0); PG8_STAGE(PG8_SA(1, 1), a1 + hstep, voffA);
            PG8_WAIT_V(8); PG8_WAIT_L(0); PG8_BAR; PG8_MMA(0, 0, At, B0); PG8_MMA(0, 1, At, B1); PG8_BAR; PG8_SCHED;
            PG8_LDA(At, 0, 1); PG8_STAGE(PG8_SB(0, 0), b2, voffB); PG8_STAGE(PG8_SB(0, 1), b2 + hstep, voffB); PG8_STAGE(PG8_SA(0, 0), a2, voffA);
            PG8_WAIT_V(8); PG8_WAIT_L(0); PG8_BAR; PG8_MMA(1, 0, At, B0); PG8_MMA(1, 1, At, B1); PG8_BAR; PG8_SCHED;
            PG8_LDB(B0, 1, 0); PG8_LDB(B1, 1, 1); PG8_SCHED; PG8_LDA(At, 1, 0); PG8_STAGE(PG8_SA(0, 1), a2 + hstep, voffA);
            PG8_WAIT_V(8); PG8_WAIT_L(0); PG8_BAR; PG8_MMA(0, 0, At, B0); PG8_MMA(0, 1, At, B1); PG8_BAR; PG8_SCHED;
            PG8_LDA(At, 1, 1); PG8_STAGE(PG8_SB(1, 0), b3, voffB); PG8_STAGE(PG8_SB(1, 1), b3 + hstep, voffB); PG8_STAGE(PG8_SA(1, 0), a3, voffA);
            PG8_WAIT_V(8); PG8_WAIT_L(0); PG8_BAR; PG8_MMA(1, 0, At, B0); PG8_MMA(1, 1, At, B1); PG8_BAR; PG8_SCHED;
            } else {
            PG8_LDB(B0, 0, 0); PG8_SCHED; PG8_LDA(At, 0, 0); PG8_STAGE(PG8_SA(1, 1), a1 + hstep, voffA);
            PG8_WAIT_L(8); PG8_BAR; PG8_WAIT_L(0); PG8_MMA(0, 0, At, B0); PG8_BAR; PG8_SCHED;
            PG8_LDB(B1, 0, 1); PG8_STAGE(PG8_SB(0, 0), b2, voffB);
            PG8_BAR; PG8_WAIT_L(0); PG8_MMA(0, 1, At, B1); PG8_BAR;
            PG8_LDA(At, 0, 1); PG8_STAGE(PG8_SA(0, 0), a2, voffA);
            PG8_BAR; PG8_WAIT_L(0); PG8_MMA(1, 0, At, B0); PG8_BAR; PG8_SCHED;
            PG8_STAGE(PG8_SB(0, 1), b2 + hstep, voffB);
            PG8_WAIT_V(6); PG8_BAR; PG8_MMA(1, 1, At, B1); PG8_BAR;
            PG8_LDB(B0, 1, 0); PG8_SCHED; PG8_LDA(At, 1, 0); PG8_STAGE(PG8_SA(0, 1), a2 + hstep, voffA);
            PG8_WAIT_L(8); PG8_BAR; PG8_WAIT_L(0); PG8_MMA(0, 0, At, B0); PG8_BAR; PG8_SCHED;
            PG8_LDB(B1, 1, 1); PG8_STAGE(PG8_SB(1, 0), b3, voffB);
            PG8_BAR; PG8_WAIT_L(0); PG8_MMA(0, 1, At, B1); PG8_BAR;
            PG8_LDA(At, 1, 1); PG8_STAGE(PG8_SA(1, 0), a3, voffA);
            PG8_BAR; PG8_WAIT_L(0); PG8_MMA(1, 0, At, B0); PG8_BAR; PG8_SCHED;
            PG8_STAGE(PG8_SB(1, 1), b3 + hstep, voffB);
            PG8_WAIT_V(6); PG8_BAR; PG8_MMA(1, 1, At, B1); PG8_BAR;
            }
        }
        if constexpr (ALIGN_EPI) { if (wr == 0) PG8_BAR; }
        if constexpr (!Epi::AFTER_DRAIN) { E(acc, cur, wr, wc, fr, fq); S.done(cur); }
        if (!has_next) break;
#pragma unroll
        for (int a = 0; a < 2; ++a)
#pragma unroll
            for (int b = 0; b < 2; ++b)
#pragma unroll
                for (int m = 0; m < 4; ++m)
#pragma unroll
                    for (int n = 0; n < 2; ++n) acc[a][b][m][n] = (f32x4){0.f, 0.f, 0.f, 0.f};
        cur = nxt; cA = nA; cB = nB; ++ui;
        if constexpr (ALIGN_EPI) { if (wr == 1) PG8_BAR; }
    }
    PG8_WAIT_V(0);
    if constexpr (!ALIGN_EPI) { if (wr == 0) PG8_BAR; }
    PG8_BAR;
    if constexpr (Epi::AFTER_DRAIN) { E.fused(acc, cur, wr, wc, fr, fq, lds, wid, lane); S.done(cur); }
#undef PG8_SA
#undef PG8_SB
#undef PG8_STAGE
#undef PG8_LDA
#undef PG8_LDB
#undef PG8_MMA
#undef PG8_WAIT_V
#undef PG8_WAIT_L
#undef PG8_BAR
#undef PG8_SCHED
}
}
#ifndef PG8_SP2
#define PG8_SP2 true
#endif
#ifndef PG8_ALIGN
#define PG8_ALIGN true
#endif

constexpr int NWAVES = 8;
constexpr int N_PHASES = 13;
constexpr size_t MiB = 1u << 20;
constexpr size_t WS_MOD = 1 * MiB;
constexpr size_t WS_AGG = 6 * MiB, WS_WG = 7 * MiB;
constexpr size_t WS_W1GU = 8 * MiB, WS_W1D = 20 * MiB, WS_WMI = 26 * MiB, WS_WMO = 31 * MiB, WS_W2GU = 33 * MiB, WS_W2D = 45 * MiB;
constexpr size_t WS_XN = 52 * MiB;
constexpr size_t WS_H = 86 * MiB;
constexpr size_t WS_END = 186 * MiB;
constexpr size_t O_YP = 0, O_YS = (size_t)NP * D, O_CP = O_YS + (size_t)NS * D, O_HP = O_CP + 8 * 3 * 512, O_SP = O_HP + 8 * 512,
                 O_CS = O_SP + 8 * 2 * 512, O_HS = O_CS + 128 * 3 * 512, O_SS = O_HS + 128 * 512, O_END = O_SS + 128 * 2 * 512;
constexpr int LDS_BYTES = 147456;

#define LAS __attribute__((address_space(3)))
typedef unsigned short bf16;
typedef unsigned v4u __attribute__((ext_vector_type(4)));
typedef float f32x4 __attribute__((ext_vector_type(4)));
typedef short bf16x8 __attribute__((ext_vector_type(8)));
#define LDS_WAIT() asm volatile("s_waitcnt lgkmcnt(0)" ::: "memory")
__device__ __forceinline__ unsigned f2bf(float f) { unsigned u = __builtin_bit_cast(unsigned, f); return (u + 0x7fffu + ((u >> 16) & 1u)) >> 16; }
__device__ __forceinline__ unsigned pk2(float lo, float hi) { return f2bf(lo) | (f2bf(hi) << 16); }
__device__ __forceinline__ float bf2f(unsigned short h) { return __builtin_bit_cast(float, (unsigned)h << 16); }
__device__ __forceinline__ float bflo(unsigned w) { return __builtin_bit_cast(float, w << 16); }
__device__ __forceinline__ float bfhi(unsigned w) { return __builtin_bit_cast(float, w & 0xffff0000u); }
__device__ __forceinline__ void unpack8(const v4u v, float (&o)[8]) { o[0] = bflo(v.x); o[1] = bfhi(v.x); o[2] = bflo(v.y); o[3] = bfhi(v.y); o[4] = bflo(v.z); o[5] = bfhi(v.z); o[6] = bflo(v.w); o[7] = bfhi(v.w); }
__device__ __forceinline__ v4u pack8(const float (&o)[8]) { v4u v; v.x = pk2(o[0], o[1]); v.y = pk2(o[2], o[3]); v.z = pk2(o[4], o[5]); v.w = pk2(o[6], o[7]); return v; }
__device__ __forceinline__ void ld8f(const float* p, float (&o)[8]) { const f32x4 a = *(const f32x4*)p, b = *(const f32x4*)(p + 4); o[0] = a.x; o[1] = a.y; o[2] = a.z; o[3] = a.w; o[4] = b.x; o[5] = b.y; o[6] = b.z; o[7] = b.w; }
__device__ __forceinline__ void st8f(float* p, const float (&o)[8]) { *(f32x4*)p = (f32x4){o[0], o[1], o[2], o[3]}; *(f32x4*)(p + 4) = (f32x4){o[4], o[5], o[6], o[7]}; }
__device__ __forceinline__ float sigmoid_f(float x) { return __builtin_amdgcn_rcpf(1.0f + __builtin_amdgcn_exp2f(x * -1.44269504089f)); }
__device__ __forceinline__ float wave_sum(float v) {
#pragma unroll
    for (int o = 1; o < 64; o <<= 1) v += __shfl_xor(v, o);
    return v;
}

struct Frame {
    LAS unsigned char* lds;
    int tid, lane, wave, G;
    const float* in[29];
    float* out;
    float* mod; float* agg;
    bf16 *W1GU, *W1D, *WMI, *WMO, *W2GU, *W2D, *XN, *U, *H, *Z, *WG;
};

__device__ __forceinline__ void p0_transpose_item(const float* W, int K, int N, bf16* WT, int mode, LAS float* scr, int item, int lane) {
    const int nblk = N / 32, kb = item / nblk, nb = item % nblk, k0 = 64 * kb, n0 = 32 * nb;
    const int rbase = (mode == 0) ? n0 : (256 * (n0 >> 7) + (n0 & 127) + (mode == 2 ? 128 : 0));
#pragma unroll 8
    for (int i = 0; i < 32; ++i) { const int kk = 2 * i + (lane >> 5); scr[kk * 33 + (lane & 31)] = W[(size_t)(k0 + kk) * N + n0 + (lane & 31)]; }
    LDS_WAIT(); asm volatile("" ::: "memory");
    const int c = lane & 7;
#pragma unroll
    for (int j = 0; j < 4; ++j) { const int n = (lane >> 3) + 8 * j; const LAS float* s = scr + (8 * c) * 33 + n;
        v4u o; o.x = pk2(s[0 * 33], s[1 * 33]); o.y = pk2(s[2 * 33], s[3 * 33]); o.z = pk2(s[4 * 33], s[5 * 33]); o.w = pk2(s[6 * 33], s[7 * 33]);
        *(v4u*)(WT + (size_t)(rbase + n) * K + k0 + 8 * c) = o; }
    LDS_WAIT(); asm volatile("" ::: "memory");
}
__device__ __forceinline__ void p0_prologue(Frame& F) {
    {
        const float* cP = F.in[5]; const float* cS = F.in[6]; const float* wada = F.in[7]; const float* bada = F.in[8];
        const int fr = F.lane & 15, fq = F.lane >> 4, w = F.wave;
        LAS float* red = (LAS float*)F.lds;
        for (int it = blockIdx.x; it < 576; it += F.G) {
            const int n0 = it * 16;
            f32x4 acc[9];
#pragma unroll
            for (int mt = 0; mt < 9; ++mt) acc[mt] = (f32x4){0.f, 0.f, 0.f, 0.f};
#pragma unroll 1
            for (int kk = 0; kk < 4; ++kk) {
                const int k0 = 128 * w + 32 * kk + 8 * fq;
                float bv[8];
#pragma unroll
                for (int j = 0; j < 8; ++j) bv[j] = wada[(size_t)(k0 + j) * (NMOD * D) + n0 + fr];
                const v4u bp = pack8(bv); const bf16x8 bfrag = __builtin_bit_cast(bf16x8, bp);
#pragma unroll
                for (int mt = 0; mt < 9; ++mt) {
                    const int row = 16 * mt + fr;
                    float av[8];
                    if (row < NBATCH) { const float* cp = (row < 8) ? cP + (size_t)row * D : cS + (size_t)(row - 8) * D; ld8f(cp + k0, av);
#pragma unroll
                        for (int j = 0; j < 8; ++j) av[j] = av[j] * sigmoid_f(av[j]); }
                    else {
#pragma unroll
                        for (int j = 0; j < 8; ++j) av[j] = 0.f; }
                    const v4u ap = pack8(av); const bf16x8 afrag = __builtin_bit_cast(bf16x8, ap);
                    acc[mt] = __builtin_amdgcn_mfma_f32_16x16x32_bf16(afrag, bfrag, acc[mt], 0, 0, 0);
                }
            }
#pragma unroll
            for (int mt = 0; mt < 9; ++mt)
#pragma unroll
                for (int i = 0; i < 4; ++i) red[(w * 144 + 16 * mt + 4 * fq + i) * 16 + fr] = acc[mt][i];
            __syncthreads();
            for (int o = F.tid; o < NBATCH * 16; o += NWAVES * 64) {
                const int row = o >> 4, c = o & 15; float s = bada[n0 + c];
#pragma unroll
                for (int ww = 0; ww < 8; ++ww) s += red[(ww * 144 + row) * 16 + c];
                F.mod[(size_t)row * (NMOD * D) + n0 + c] = s;
            }
            __syncthreads();
        }
    }
    LAS float* scr = (LAS float*)(F.lds + F.wave * 16384);
    const int gw = blockIdx.x * NWAVES + F.wave, NGW = F.G * NWAVES;
    constexpr int I_GU = (D / 64) * (FF / 32), I_DN = (FF / 64) * (D / 32), I_MI = (D / 64) * (DIN / 32), I_MO = (D / 64) * (D / 32);
    constexpr int NITEMS = 6 * I_GU + I_MI + I_MO;
    static_assert(I_GU == I_DN, "item counts");
    for (int it = gw; it < NITEMS; it += NGW) {
        int r = it;
        if (r < I_GU) { p0_transpose_item(F.in[10], D, FF, F.W1GU, 1, scr, r, F.lane); continue; } r -= I_GU;
        if (r < I_GU) { p0_transpose_item(F.in[11], D, FF, F.W1GU, 2, scr, r, F.lane); continue; } r -= I_GU;
        if (r < I_DN) { p0_transpose_item(F.in[12], FF, D, F.W1D, 0, scr, r, F.lane); continue; } r -= I_DN;
        if (r < I_MI) { p0_transpose_item(F.in[14], D, DIN, F.WMI, 0, scr, r, F.lane); continue; } r -= I_MI;
        if (r < I_MO) { p0_transpose_item(F.in[23], D, D, F.WMO, 0, scr, r, F.lane); continue; } r -= I_MO;
        if (r < I_GU) { p0_transpose_item(F.in[25], D, FF, F.W2GU, 1, scr, r, F.lane); continue; } r -= I_GU;
        if (r < I_GU) { p0_transpose_item(F.in[26], D, FF, F.W2GU, 2, scr, r, F.lane); continue; } r -= I_GU;
        p0_transpose_item(F.in[27], FF, D, F.W2D, 0, scr, r, F.lane);
    }
    for (int o = blockIdx.x * (NWAVES * 64) + F.tid; o < 2 * 32768; o += F.G * NWAVES * 64) {
        const int g = o >> 15, r = o & 32767, h = r >> 12, n = (r >> 6) & 63, k = r & 63;
        const float* w = g ? F.in[19] : F.in[17];
        F.WG[o] = (bf16)f2bf(w[(h * 64 + k) * 64 + n]);
    }
}

__device__ __forceinline__ void norm_pass(Frame& F, const float* srcP, const float* srcS, const float* gain, int ishift, int iscale) {
    const int gw = blockIdx.x * NWAVES + F.wave, NGW = F.G * NWAVES;
    for (int m = gw; m < M; m += NGW) {
        const float* xrow = (m < NP) ? srcP + (size_t)m * D : srcS + (size_t)(m - NP) * D;
        const int b = row_batch(m);
        const f32x4* xr = (const f32x4*)xrow + F.lane;
        const f32x4* gr = (const f32x4*)gain + F.lane;
        const f32x4* sh = (const f32x4*)(F.mod + (size_t)(b * NMOD + ishift) * D) + F.lane;
        const f32x4* sc = (const f32x4*)(F.mod + (size_t)(b * NMOD + iscale) * D) + F.lane;
        f32x4 v[4]; float s = 0.f;
#pragma unroll
        for (int j = 0; j < 4; ++j) { v[j] = xr[64 * j]; s += (v[j].x * v[j].x + v[j].y * v[j].y) + (v[j].z * v[j].z + v[j].w * v[j].w); }
        const float rstd = 1.0f / sqrtf(wave_sum(s) * (1.f / D) + EPS);
        unsigned long long* o8 = (unsigned long long*)(F.XN + (size_t)m * D) + F.lane;
#pragma unroll
        for (int j = 0; j < 4; ++j) { const f32x4 g = gr[64 * j], a = sh[64 * j], c = sc[64 * j];
            const f32x4 o = (v[j] * rstd) * g * (c + 1.0f) + a;
            o8[64 * j] = (unsigned long long)pk2(o.x, o.y) | ((unsigned long long)pk2(o.z, o.w) << 32); }
    }
}
__device__ __forceinline__ void final_norm(Frame& F) {
    const int gw = blockIdx.x * NWAVES + F.wave, NGW = F.G * NWAVES;
    const f32x4* gr = (const f32x4*)F.in[28] + F.lane;
    for (int m = gw; m < M; m += NGW) {
        f32x4* xr = (f32x4*)(F.out + (size_t)m * D) + F.lane;
        f32x4 v[4]; float s = 0.f;
#pragma unroll
        for (int j = 0; j < 4; ++j) { v[j] = xr[64 * j]; s += (v[j].x * v[j].x + v[j].y * v[j].y) + (v[j].z * v[j].z + v[j].w * v[j].w); }
        const float rstd = 1.0f / sqrtf(wave_sum(s) * (1.f / D) + EPS);
#pragma unroll
        for (int j = 0; j < 4; ++j) xr[64 * j] = (v[j] * rstd) * gr[64 * j];
    }
}

#ifndef NEG_EXPM1
#define NEG_EXPM1(x) (-expm1f(x))
#endif
constexpr int RS = 1040;
constexpr int XL_OFF = 0, XC_OFF = 67 * RS;
static_assert(XC_OFF % 16 == 0 && XC_OFF + 64 * RS <= LDS_BYTES, "mixer LDS map");
template <int PASS>
__device__ __forceinline__ void mixer_mid(Frame& F) {
    const int tid = F.tid, lane = F.lane, fr = lane & 15, fq = lane >> 4;
    LAS unsigned char* lds = F.lds;
    const bf16* Z = F.Z;
    const float* st_conv = F.in[2]; const float* st_h = F.in[3]; const float* st_sc = F.in[4];
    for (int unit = blockIdx.x; unit < 264; unit += F.G) {
        const bool samp = unit >= 256;
        const int row0 = unit * 64;
        const int b = unit >> 5, chunk = unit & 31;
        const int seq0 = (unit - 256) * 16;
        if (PASS == 1) {
            const int ch0 = (tid & 63) * 8, r = tid >> 6;
            const float* wsc = F.in[22];
            float w0[8], w1[8], w2[8]; ld8f(wsc + ch0, w0); ld8f(wsc + 512 + ch0, w1); ld8f(wsc + 1024 + ch0, w2);
            float u2[8], u1[8];
#pragma unroll
            for (int j = 0; j < 8; ++j) { u2[j] = 0.f; u1[j] = 0.f; }
            if (!samp && (r > 0 || chunk > 0)) {
                const bf16* zr = Z + (size_t)(row0 + 8 * r - 2) * DIN + ch0;
                float c[8], v[8];
                unpack8(*(const v4u*)(zr + 1536), c); unpack8(*(const v4u*)(zr + 2048), v);
#pragma unroll
                for (int j = 0; j < 8; ++j) u2[j] = c[j] * v[j];
                unpack8(*(const v4u*)(zr + DIN + 1536), c); unpack8(*(const v4u*)(zr + DIN + 2048), v);
#pragma unroll
                for (int j = 0; j < 8; ++j) u1[j] = c[j] * v[j];
            }
#pragma unroll
            for (int t = 0; t < 8; ++t) {
                const int tok = 8 * r + t; const int seq = seq0 + (tok >> 2);
                if (samp && (t & 3) == 0) { ld8f(st_sc + (size_t)(seq * 2 + 0) * 512 + ch0, u2); ld8f(st_sc + (size_t)(seq * 2 + 1) * 512 + ch0, u1); }
                const bf16* zr = Z + (size_t)(row0 + tok) * DIN + ch0;
                float bs[8], c[8], v[8], u0[8], o[8];
                unpack8(*(const v4u*)(zr + 1024), bs); unpack8(*(const v4u*)(zr + 1536), c); unpack8(*(const v4u*)(zr + 2048), v);
#pragma unroll
                for (int j = 0; j < 8; ++j) { u0[j] = c[j] * v[j]; o[j] = bs[j] * (w0[j] * u2[j] + w1[j] * u1[j] + w2[j] * u0[j]); }
                *(v4u*)(F.U + (size_t)(row0 + tok) * D + 512 + ch0) = pack8(o);
                if (samp) { if ((t & 3) >= 2) st8f(F.out + O_SS + (size_t)(seq * 2 + ((t & 3) - 2)) * 512 + ch0, u0); }
                else if (chunk == 31 && tok >= 62) st8f(F.out + O_SP + (size_t)(b * 2 + (tok - 62)) * 512 + ch0, u0);
#pragma unroll
                for (int j = 0; j < 8; ++j) { u2[j] = u1[j]; u1[j] = u0[j]; }
            }
            if (samp) continue;
        }
        for (int p = tid; p < 67 * 64; p += NWAVES * 64) {
            const int hr = p >> 6, c16 = p & 63, tok = hr - 3;
            v4u v = (v4u){0u, 0u, 0u, 0u};
            const bool valid = samp ? (tok >= 0) : (tok >= 0 || chunk > 0);
            if (valid) v = *(const v4u*)(Z + (size_t)(row0 + tok) * DIN + c16 * 8);
            *(LAS v4u*)(lds + XL_OFF + hr * RS + c16 * 16) = v;
        }
        __syncthreads();
        {
            const int ch0 = (tid & 63) * 8, r = tid >> 6;
            const float* wc = F.in[15]; const float* bc = F.in[16];
            float w0[8], w1[8], w2[8], w3[8], bb[8];
            ld8f(wc + ch0, w0); ld8f(wc + 512 + ch0, w1); ld8f(wc + 1024 + ch0, w2); ld8f(wc + 1536 + ch0, w3); ld8f(bc + ch0, bb);
            float x3[8], x2[8], x1[8];
            unpack8(*(const LAS v4u*)(lds + XL_OFF + (8 * r + 0) * RS + ch0 * 2), x3);
            unpack8(*(const LAS v4u*)(lds + XL_OFF + (8 * r + 1) * RS + ch0 * 2), x2);
            unpack8(*(const LAS v4u*)(lds + XL_OFF + (8 * r + 2) * RS + ch0 * 2), x1);
#pragma unroll
            for (int t = 0; t < 8; ++t) {
                const int tok = 8 * r + t; const int seq = seq0 + (tok >> 2);
                if (samp && (t & 3) == 0) { ld8f(st_conv + (size_t)(seq * 3 + 0) * 512 + ch0, x3); ld8f(st_conv + (size_t)(seq * 3 + 1) * 512 + ch0, x2); ld8f(st_conv + (size_t)(seq * 3 + 2) * 512 + ch0, x1); }
                float x0[8], o[8];
                unpack8(*(const LAS v4u*)(lds + XL_OFF + (tok + 3) * RS + ch0 * 2), x0);
#pragma unroll
                for (int j = 0; j < 8; ++j) o[j] = bb[j] + w3[j] * x0[j] + w2[j] * x1[j] + w1[j] * x2[j] + w0[j] * x3[j];
                *(LAS v4u*)(lds + XC_OFF + tok * RS + ch0 * 2) = pack8(o);
                if (PASS == 2) {
                    if (samp) { if ((t & 3) >= 1) st8f(F.out + O_CS + (size_t)(seq * 3 + ((t & 3) - 1)) * 512 + ch0, x0); }
                    else if (chunk == 31 && tok >= 61) st8f(F.out + O_CP + (size_t)(b * 3 + (tok - 61)) * 512 + ch0, x0);
                }
#pragma unroll
                for (int j = 0; j < 8; ++j) { x3[j] = x2[j]; x2[j] = x1[j]; x1[j] = x0[j]; }
            }
        }
        __syncthreads();
        if (PASS == 2) {
            for (int p = tid; p < 64 * 64; p += NWAVES * 64) {
                const int tok = p >> 6, c16 = p & 63;
                *(LAS v4u*)(lds + XL_OFF + tok * RS + c16 * 16) = *(const v4u*)(Z + (size_t)(row0 + tok) * DIN + 512 + c16 * 8);
            }
            __syncthreads();
        }
        {
            const int chb = 64 * F.wave;
            const bf16* wga = F.WG + (size_t)F.wave * 4096; const bf16* wgx = F.WG + 32768 + (size_t)F.wave * 4096;
            bf16x8 wa[4][2], wx[4][2];
#pragma unroll
            for (int nt = 0; nt < 4; ++nt)
#pragma unroll
                for (int kk = 0; kk < 2; ++kk) { const int o = (16 * nt + fr) * 64 + 32 * kk + 8 * fq;
                    wa[nt][kk] = *(const bf16x8*)(wga + o); wx[nt][kk] = *(const bf16x8*)(wgx + o); }
            float ba[4], bx[4], cl[4], hc[4], Ac[4];
#pragma unroll
            for (int nt = 0; nt < 4; ++nt) { const int ch = chb + 16 * nt + fr; ba[nt] = F.in[18][ch]; bx[nt] = F.in[20][ch];
                cl[nt] = -8.0f * log1pf(__expf(-F.in[21][ch])); hc[nt] = 0.f; Ac[nt] = 1.f; }
            if (PASS == 2 && !samp) {
                for (int jc = 0; jc < chunk; ++jc) {
#pragma unroll
                    for (int nt = 0; nt < 4; ++nt) { const int ch = chb + 16 * nt + fr; const float* ap = F.agg + (size_t)((b * 32 + jc) * 2) * 512 + ch;
                        hc[nt] = ap[0] * hc[nt] + ap[512]; }
                }
            }
#pragma unroll 1
            for (int mt = 0; mt < 4; ++mt) {
                bf16x8 xa[2];
#pragma unroll
                for (int kk = 0; kk < 2; ++kk) xa[kk] = *(const LAS bf16x8*)(lds + XC_OFF + (16 * mt + fr) * RS + (chb + 32 * kk + 8 * fq) * 2);
                f32x4 accA[4], accX[4];
#pragma unroll
                for (int nt = 0; nt < 4; ++nt) { accA[nt] = (f32x4){0.f, 0.f, 0.f, 0.f}; accX[nt] = (f32x4){0.f, 0.f, 0.f, 0.f};
#pragma unroll
                    for (int kk = 0; kk < 2; ++kk) { accA[nt] = __builtin_amdgcn_mfma_f32_16x16x32_bf16(xa[kk], wa[nt][kk], accA[nt], 0, 0, 0);
                        accX[nt] = __builtin_amdgcn_mfma_f32_16x16x32_bf16(xa[kk], wx[nt][kk], accX[nt], 0, 0, 0); } }
#pragma unroll
                for (int nt = 0; nt < 4; ++nt) {
                    const int ch = chb + 16 * nt + fr;
                    float P[4], Hh[4];
#pragma unroll
                    for (int i = 0; i < 4; ++i) {
                        const int tok = 16 * mt + 4 * fq + i;
                        const float xcv = bf2f(*(const LAS unsigned short*)(lds + XC_OFF + tok * RS + ch * 2));
                        const float rg = sigmoid_f(accA[nt][i] + ba[nt]), ig = sigmoid_f(accX[nt][i] + bx[nt]);
                        const float la = cl[nt] * rg;
                        const float a = __expf(la), mult = sqrtf(NEG_EXPM1(2.0f * la));
                        const float bvv = mult * (ig * xcv);
                        if (i == 0) { P[0] = a; Hh[0] = bvv; } else { P[i] = a * P[i - 1]; Hh[i] = a * Hh[i - 1] + bvv; }
                    }
                    float hin;
                    if (samp) { hin = st_h[(size_t)(seq0 + 4 * mt + fq) * 512 + ch]; }
                    else {
                        float Ai = P[3], Bi = Hh[3];
                        float Au = __shfl_up(Ai, 16), Bu = __shfl_up(Bi, 16);
                        if (fq >= 1) { Bi = Ai * Bu + Bi; Ai = Au * Ai; }
                        Au = __shfl_up(Ai, 32); Bu = __shfl_up(Bi, 32);
                        if (fq >= 2) { Bi = Ai * Bu + Bi; Ai = Au * Ai; }
                        float Ae = __shfl_up(Ai, 16), Be = __shfl_up(Bi, 16);
                        if (fq == 0) { Ae = 1.f; Be = 0.f; }
                        hin = Ae * hc[nt] + Be;
                        const float At = __shfl(Ai, fr + 48), Bt = __shfl(Bi, fr + 48);
                        hc[nt] = At * hc[nt] + Bt;
                        if (PASS == 1) Ac[nt] *= At;
                    }
                    if (PASS == 2) {
                        float hv[4];
#pragma unroll
                        for (int i = 0; i < 4; ++i) {
                            const int tok = 16 * mt + 4 * fq + i;
                            hv[i] = P[i] * hin + Hh[i];
                            const float g = bf2f(*(const LAS unsigned short*)(lds + XL_OFF + tok * RS + ch * 2));
                            const float y2 = 1.5957691216f * (g + 0.044715f * g * g * g);
                            const float o = hv[i] * (g * sigmoid_f(y2));
                            *(LAS unsigned short*)(lds + XC_OFF + tok * RS + ch * 2) = (unsigned short)f2bf(o);
                        }
                        if (samp) F.out[O_HS + (size_t)(seq0 + 4 * mt + fq) * 512 + ch] = hv[3];
                        else if (chunk == 31 && mt == 3 && fq == 3) F.out[O_HP + (size_t)b * 512 + ch] = hv[3];
                    }
                }
            }
            if (PASS == 1 && fq == 0) {
#pragma unroll
                for (int nt = 0; nt < 4; ++nt) { const int ch = chb + 16 * nt + fr; float* ap = F.agg + (size_t)((b * 32 + chunk) * 2) * 512 + ch; ap[0] = Ac[nt]; ap[512] = hc[nt]; }
            }
        }
        __syncthreads();
        if (PASS == 2) {
            for (int p = tid; p < 64 * 64; p += NWAVES * 64) {
                const int tok = p >> 6, c16 = p & 63;
                *(v4u*)(F.U + (size_t)(row0 + tok) * D + c16 * 8) = *(const LAS v4u*)(lds + XC_OFF + tok * RS + c16 * 16);
            }
        }
    }
}

struct Args { const float* in[29]; float* out; unsigned char* ws; int ph_lo, ph_hi; };
__global__ void __launch_bounds__(NWAVES * 64, 2) fwd_kernel(Args args) {
    extern __shared__ __attribute__((aligned(16))) unsigned char lds_raw[];
    Frame F;
    F.lds = (LAS unsigned char*)lds_raw;
    F.tid = threadIdx.x; F.lane = F.tid & 63; F.wave = __builtin_amdgcn_readfirstlane(F.tid >> 6); F.G = gridDim.x;
#pragma unroll
    for (int i = 0; i < 29; ++i) F.in[i] = args.in[i];
    F.out = args.out;
    unsigned char* ws = args.ws;
    F.mod = (float*)(ws + WS_MOD); F.agg = (float*)(ws + WS_AGG);
    F.W1GU = (bf16*)(ws + WS_W1GU); F.W1D = (bf16*)(ws + WS_W1D); F.WMI = (bf16*)(ws + WS_WMI); F.WMO = (bf16*)(ws + WS_WMO); F.W2GU = (bf16*)(ws + WS_W2GU); F.W2D = (bf16*)(ws + WS_W2D);
    F.WG = (bf16*)(ws + WS_WG); F.XN = (bf16*)(ws + WS_XN); F.U = F.XN; F.H = (bf16*)(ws + WS_H); F.Z = F.H;
    const int lo = args.ph_lo, hi = args.ph_hi;
#ifndef PH_MASK
#define PH_MASK 0x1FFF
#endif
#define IN(k) (((PH_MASK >> (k)) & 1) && lo <= (k) && (k) < hi)
#define SEAM(k) do { if (IN(k) && IN((k) + 1)) cg::this_grid().sync(); } while (0)

    if (IN(0)) { p0_prologue(F); } SEAM(0);
    if (IN(1)) { norm_pass(F, F.in[0], F.in[1], F.in[9], 0, 1); } SEAM(1);
    if (IN(2)) { pg8::Gemm g{F.XN, F.W1GU, M, 2 * FF, D}; pg8::StaticOrder S; S.init(M, 2 * FF, F.G, (int)blockIdx.x);
        pg8::EpiSwiglu E{F.H, FF}; pg8::gemm_phase<pg8::EpiSwiglu, pg8::StaticOrder, PG8_ALIGN, PG8_SP2>(F.lds, g, S, E); } SEAM(2);
    if (IN(3)) { pg8::Gemm g{F.H, F.W1D, M, D, FF}; pg8::StaticOrder S; S.init(M, D, F.G, (int)blockIdx.x);
        pg8::EpiResid E{F.in[0], F.in[1], F.out, F.mod, 2, 0.5f}; pg8::gemm_phase<pg8::EpiResid, pg8::StaticOrder, PG8_ALIGN, PG8_SP2>(F.lds, g, S, E); } SEAM(3);
    if (IN(4)) { norm_pass(F, F.out, F.out + (size_t)NP * D, F.in[13], 3, 4); } SEAM(4);
    if (IN(5)) { pg8::Gemm g{F.XN, F.WMI, M, DIN, D}; pg8::StaticOrder S; S.init(M, DIN, F.G, (int)blockIdx.x);
        pg8::EpiBf16 E{F.Z, DIN}; pg8::gemm_phase<pg8::EpiBf16, pg8::StaticOrder, PG8_ALIGN, PG8_SP2>(F.lds, g, S, E); } SEAM(5);
    if (IN(6)) { mixer_mid<1>(F); } SEAM(6);
    if (IN(7)) { mixer_mid<2>(F); } SEAM(7);
    if (IN(8)) { pg8::Gemm g{F.U, F.WMO, M, D, D}; pg8::StaticOrder S; S.init(M, D, F.G, (int)blockIdx.x);
        pg8::EpiResid E{F.out, F.out + (size_t)NP * D, F.out, F.mod, 5, 1.0f}; pg8::gemm_phase<pg8::EpiResid, pg8::StaticOrder, PG8_ALIGN, PG8_SP2>(F.lds, g, S, E); } SEAM(8);
    if (IN(9)) { norm_pass(F, F.out, F.out + (size_t)NP * D, F.in[24], 6, 7); } SEAM(9);
    if (IN(10)) { pg8::Gemm g{F.XN, F.W2GU, M, 2 * FF, D}; pg8::StaticOrder S; S.init(M, 2 * FF, F.G, (int)blockIdx.x);
        pg8::EpiSwiglu E{F.H, FF}; pg8::gemm_phase<pg8::EpiSwiglu, pg8::StaticOrder, PG8_ALIGN, PG8_SP2>(F.lds, g, S, E); } SEAM(10);
    if (IN(11)) { pg8::Gemm g{F.H, F.W2D, M, D, FF}; pg8::StaticOrder S; S.init(M, D, F.G, (int)blockIdx.x);
        pg8::EpiResid E{F.out, F.out + (size_t)NP * D, F.out, F.mod, 8, 0.5f}; pg8::gemm_phase<pg8::EpiResid, pg8::StaticOrder, PG8_ALIGN, PG8_SP2>(F.lds, g, S, E); } SEAM(11);
    if (IN(12)) { final_norm(F); }
#undef IN
#undef SEAM
}

extern "C" void kernel_launch(void* const* d_in, const int* in_sizes, int n_in, void* d_out, int out_size, void* d_ws, size_t ws_size, hipStream_t stream) {
    static int grid = 0;
    if (grid == 0) {
        if (n_in != 29 || in_sizes[0] != NP * D || (size_t)out_size != O_END || ws_size < WS_END) {
            fprintf(stderr, "kernel_launch: unexpected shapes: n_in %d in0 %d out %d ws %zu\n", n_in, n_in > 0 ? in_sizes[0] : -1, out_size, ws_size); grid = -1; return; }
        int dev = 0, cus = 0, per_cu = 0;
        (void)hipGetDevice(&dev); (void)hipDeviceGetAttribute(&cus, hipDeviceAttributeMultiprocessorCount, dev);
        if (hipFuncSetAttribute((const void*)fwd_kernel, hipFuncAttributeMaxDynamicSharedMemorySize, LDS_BYTES) != hipSuccess) { fprintf(stderr, "kernel_launch: hipFuncSetAttribute failed\n"); grid = -1; return; }
        if (hipOccupancyMaxActiveBlocksPerMultiprocessor(&per_cu, (const void*)fwd_kernel, NWAVES * 64, LDS_BYTES) != hipSuccess || per_cu < 1) { fprintf(stderr, "kernel_launch: occupancy query says %d\n", per_cu); per_cu = 1; }
        (void)hipGetLastError();
        grid = cus * per_cu;
        fprintf(stderr, "kernel_launch: cus %d per_cu %d grid %d\n", cus, per_cu, grid);
    }
    if (grid < 0) return;
    Args a{};
    for (int i = 0; i < 29; ++i) a.in[i] = (const float*)d_in[i];
    a.out = (float*)d_out; a.ws = (unsigned char*)d_ws;
#if MK_N_LAUNCHES == 1
    a.ph_lo = 0; a.ph_hi = N_PHASES;
    void* kargs[] = {&a};
    hipError_t e = hipLaunchCooperativeKernel((const void*)fwd_kernel, dim3(grid), dim3(NWAVES * 64), kargs, LDS_BYTES, stream);
    if (e != hipSuccess) fprintf(stderr, "kernel_launch: cooperative launch failed: %s (grid %d)\n", hipGetErrorString(e), grid);
#else
    for (int li = 0; li < N_PHASES; ++li) {
        a.ph_lo = li; a.ph_hi = li + 1;
        hipLaunchKernelGGL(fwd_kernel, dim3(grid), dim3(NWAVES * 64), LDS_BYTES, stream, a);
    }
#endif
}
```

```cpp
#include <hip/hip_runtime.h>
#include <hip/hip_cooperative_groups.h>
#include <cstdio>
#include <cstdint>
namespace cg = cooperative_groups;

#ifndef MK_N_LAUNCHES
#define MK_N_LAUNCHES 1
#endif

constexpr int D = 1024, NP = 16384, NS = 512, M = NP + NS, FF = 3072, DIN = 2560, DL = 512;
constexpr int TP = 2048, NBATCH = 136, NMOD = 9;
constexpr float EPS = 1e-6f;
__device__ __forceinline__ int row_batch(int r) { return r < NP ? (r >> 11) : 8 + ((r - NP) >> 2); }

namespace pg8 {
#define PG8_LAS __attribute__((address_space(3)))
typedef unsigned short bf16_t;
typedef short bf16x8 __attribute__((ext_vector_type(8)));
typedef float f32x4 __attribute__((ext_vector_type(4)));
typedef unsigned u32x4 __attribute__((ext_vector_type(4)));
constexpr int BM = 256, BK = 64, HALF = 128, HTB = HALF * BK * 2  , STAGE_BYTES = 8 * HTB, NXCD = 8, WGM = 8;

__host__ __device__ __forceinline__ int lds_byte(int r, int c) { const int st = (r >> 4) * 2 + (c >> 5), rr = r & 15, cc = c & 31, ob = rr * 64 + cc * 2; return st * 1024 + (ob ^ (((ob >> 9) & 1) << 5)); }
__host__ __device__ __forceinline__ void stage_rc(int b, int& R, int& C) { const int st = b / 1024, sb = b % 1024, swz = sb ^ (((sb >> 9) & 1) << 5); R = (st >> 1) * 16 + swz / 64; C = (st & 1) * 32 + (swz % 64) / 2; }
__host__ __device__ __forceinline__ int perm32(int rho) { const int n = rho >> 4, i = rho & 15; return 8 * (i >> 2) + 4 * n + (i & 3); }

struct Unit { int pm, pn; };
struct Gemm { const bf16_t* A; const bf16_t* Bt; int M, N, K; };

struct StaticOrder {
    int nM, nN, nwg, G, c;
    __host__ __device__ void init(int M, int N, int G_, int c_) { nM = M / BM; nN = N / BM; nwg = nM * nN; G = G_; c = c_; }
    __host__ __device__ bool next(int i, Unit& u) const {
        const long L = (long)i * G + c; if (L >= nwg) return false;
        int wgid = (int)L; { const int q = nwg / NXCD, r = nwg % NXCD, xcd = wgid % NXCD, off = wgid / NXCD; wgid = (xcd < r ? xcd * (q + 1) : r * (q + 1) + (xcd - r) * q) + off; }
        const int nig = WGM * nN, gid = wgid / nig, fm = gid * WGM, gsz = (nM - fm) < WGM ? (nM - fm) : WGM;
        u.pm = fm + ((wgid % nig) % gsz); u.pn = (wgid % nig) / gsz; return true;
    }
    __device__ __forceinline__ void a_ready(const Unit&) const {}
    __device__ __forceinline__ void done(const Unit&) const {}
};

__device__ __forceinline__ unsigned cvt_pk_bf16(float lo, float hi) { unsigned r; asm volatile("v_cvt_pk_bf16_f32 %0, %1, %2" : "=v"(r) : "v"(lo), "v"(hi)); return r; }
__device__ __forceinline__ float silu_f(float g) { return g * __builtin_amdgcn_rcpf(1.0f + __builtin_amdgcn_exp2f(g * -1.44269504089f)); }

struct EpiBf16 {
    static constexpr bool PERM = true, AFTER_DRAIN = false;
    bf16_t* O; int ldc;
    __device__ __forceinline__ void operator()(const f32x4 (&acc)[2][2][4][2], const Unit& u, int wr, int wc, int fr, int fq) const {
        const int row0 = u.pm * BM + wr * 64 + fr; const int col0 = u.pn * BM + wc * 32 + 8 * fq;
#pragma unroll
        for (int ai = 0; ai < 2; ++ai)
#pragma unroll
            for (int m = 0; m < 4; ++m) { bf16_t* rowp = O + (size_t)(row0 + ai * HALF + m * 16) * ldc + col0;
#pragma unroll
                for (int bj = 0; bj < 2; ++bj) { const f32x4 v0 = acc[ai][bj][m][0], v1 = acc[ai][bj][m][1];
                    u32x4 w; w.x = cvt_pk_bf16(v0[0], v0[1]); w.y = cvt_pk_bf16(v0[2], v0[3]); w.z = cvt_pk_bf16(v1[0], v1[1]); w.w = cvt_pk_bf16(v1[2], v1[3]);
                    *(u32x4*)(rowp + bj * HALF) = w; } }
    }
};
struct EpiSwiglu {
    static constexpr bool PERM = true, AFTER_DRAIN = false;
    bf16_t* O; int ldc;
    __device__ __forceinline__ void operator()(const f32x4 (&acc)[2][2][4][2], const Unit& u, int wr, int wc, int fr, int fq) const {
        const int row0 = u.pm * BM + wr * 64 + fr; const int col0 = u.pn * HALF + wc * 32 + 8 * fq;
#pragma unroll
        for (int ai = 0; ai < 2; ++ai)
#pragma unroll
            for (int m = 0; m < 4; ++m) { bf16_t* rowp = O + (size_t)(row0 + ai * HALF + m * 16) * ldc + col0;
                const f32x4 g0 = acc[ai][0][m][0], g1 = acc[ai][0][m][1], u0 = acc[ai][1][m][0], u1 = acc[ai][1][m][1];
                u32x4 w;
                w.x = cvt_pk_bf16(silu_f(g0[0]) * u0[0], silu_f(g0[1]) * u0[1]); w.y = cvt_pk_bf16(silu_f(g0[2]) * u0[2], silu_f(g0[3]) * u0[3]);
                w.z = cvt_pk_bf16(silu_f(g1[0]) * u1[0], silu_f(g1[1]) * u1[1]); w.w = cvt_pk_bf16(silu_f(g1[2]) * u1[2], silu_f(g1[3]) * u1[3]);
                *(u32x4*)rowp = w; }
    }
};
struct EpiResid {
    static constexpr bool PERM = false, AFTER_DRAIN = false;
    const float* baseP; const float* baseS; float* out; const float* mod; int idx; float fac;
    __device__ __forceinline__ void operator()(const f32x4 (&acc)[2][2][4][2], const Unit& u, int wr, int wc, int fr, int fq) const {
        const int colb = u.pn * BM + wc * 32 + 4 * fq;
#pragma unroll
        for (int ai = 0; ai < 2; ++ai)
#pragma unroll
            for (int m = 0; m < 4; ++m) {
                const int r = u.pm * BM + ai * HALF + wr * 64 + m * 16 + fr;
                const float* bp = (r < NP) ? baseP + (size_t)r * D : baseS + (size_t)(r - NP) * D;
                const float* mp = mod + (size_t)(row_batch(r) * NMOD + idx) * D;
                float* op = out + (size_t)r * D;
#pragma unroll
                for (int bj = 0; bj < 2; ++bj)
#pragma unroll
                    for (int n = 0; n < 2; ++n) { const int c = colb + bj * HALF + n * 16;
                        const f32x4 bs = *(const f32x4*)(bp + c); const f32x4 mv = *(const f32x4*)(mp + c);
                        *(f32x4*)(op + c) = bs + (mv * fac) * acc[ai][bj][m][n]; }
                if (m & 1) asm volatile("" ::: "memory"); }
    }
};

template <class Epi, class Sched, bool ALIGN_EPI = false, bool SP2 = false>
__device__ __forceinline__ void gemm_phase(PG8_LAS unsigned char* lds, const Gemm g, const Sched& S, const Epi& E) {
    const int tid = threadIdx.x, wid = __builtin_amdgcn_readfirstlane(tid >> 6), lane = tid & 63, wr = wid >> 2, wc = wid & 3, fr = lane & 15, fq = lane >> 4;
    const int K = g.K, nt = K / BK;
    unsigned voffA[2], voffB[2];
#pragma unroll
    for (int i = 0; i < 2; ++i) { int R, C; stage_rc(tid * 16 + i * 8192, R, C); const int Rb = Epi::PERM ? ((R & ~31) + perm32(R & 31)) : R;
        voffA[i] = (unsigned)(R * K + C) * 2u; voffB[i] = (unsigned)(Rb * K + C) * 2u; }
    const size_t kstep = (size_t)(BK * 2);
    const size_t hstep = (size_t)HALF * K * 2;
    const size_t tstep = 2 * hstep;
    const unsigned ldsw = (unsigned)wid * 1024u;
    const int aoff = lds_byte(wr * 64 + fr, fq * 8), boff = lds_byte(wc * 32 + fr, fq * 8);
#define PG8_SA(b, h) (((b) * 2 + (h)) * HTB)
#define PG8_SB(b, h) ((4 + (b) * 2 + (h)) * HTB)
#define PG8_STAGE(bufoff, gbase, voff) do { _Pragma("unroll") for (int _i = 0; _i < 2; ++_i) \
        __builtin_amdgcn_global_load_lds((const unsigned*)((const char*)(gbase) + (voff)[_i]), (PG8_LAS unsigned*)(lds + (bufoff) + ldsw + _i * 8192), 16, 0, 0); } while (0)
#define PG8_LDA(dst, b, h) do { _Pragma("unroll") for (int m = 0; m < 4; ++m) _Pragma("unroll") for (int k = 0; k < 2; ++k) dst[m][k] = *(const PG8_LAS bf16x8*)(lds + PG8_SA(b, h) + aoff + m * 2048 + k * 1024); } while (0)
#define PG8_LDB(dst, b, h) do { _Pragma("unroll") for (int n = 0; n < 2; ++n) _Pragma("unroll") for (int k = 0; k < 2; ++k) dst[n][k] = *(const PG8_LAS bf16x8*)(lds + PG8_SB(b, h) + boff + n * 2048 + k * 1024); } while (0)
#define PG8_MMA(ai, bj, At, Bt) do { __builtin_amdgcn_s_setprio(1); _Pragma("unroll") for (int m = 0; m < 4; ++m) _Pragma("unroll") for (int n = 0; n < 2; ++n) _Pragma("unroll") for (int k = 0; k < 2; ++k) \
        acc[ai][bj][m][n] = __builtin_amdgcn_mfma_f32_16x16x32_bf16(Bt[n][k], At[m][k], acc[ai][bj][m][n], 0, 0, 0); __builtin_amdgcn_s_setprio(0); } while (0)
#define PG8_WAIT_V(n) asm volatile("s_waitcnt vmcnt(" #n ")" ::: "memory")
#define PG8_WAIT_L(n) asm volatile("s_waitcnt lgkmcnt(" #n ")" ::: "memory")
#define PG8_BAR __builtin_amdgcn_s_barrier()
#define PG8_SCHED __builtin_amdgcn_sched_barrier(0)
    Unit cur, nxt; int ui = 0;
    if (!S.next(0, cur)) return;
    f32x4 acc[2][2][4][2];
#pragma unroll
    for (int a = 0; a < 2; ++a)
#pragma unroll
        for (int b = 0; b < 2; ++b)
#pragma unroll
            for (int m = 0; m < 4; ++m)
#pragma unroll
                for (int n = 0; n < 2; ++n) acc[a][b][m][n] = (f32x4){0.f, 0.f, 0.f, 0.f};
    bf16x8 At[4][2], B0[2][2], B1[2][2];
    const char* cA = (const char*)g.A + (size_t)cur.pm * tstep; const char* cB = (const char*)g.Bt + (size_t)cur.pn * tstep;
    S.a_ready(cur);
    if constexpr (SP2) {
        PG8_STAGE(PG8_SB(0, 0), cB, voffB); PG8_STAGE(PG8_SB(0, 1), cB + hstep, voffB); PG8_STAGE(PG8_SA(0, 0), cA, voffA); PG8_STAGE(PG8_SA(0, 1), cA + hstep, voffA);
        if (wr == 1) PG8_BAR;
        PG8_WAIT_V(2); PG8_BAR;
        PG8_STAGE(PG8_SB(1, 0), cB + kstep, voffB); PG8_STAGE(PG8_SA(1, 0), cA + kstep, voffA); PG8_STAGE(PG8_SB(1, 1), cB + hstep + kstep, voffB);
        PG8_WAIT_V(6); PG8_BAR;
    } else {
        PG8_STAGE(PG8_SB(0, 0), cB, voffB); PG8_STAGE(PG8_SA(0, 0), cA, voffA); PG8_STAGE(PG8_SB(0, 1), cB + hstep, voffB); PG8_STAGE(PG8_SA(0, 1), cA + hstep, voffA);
        if (wr == 1) PG8_BAR;
        PG8_WAIT_V(4); PG8_BAR;
        PG8_STAGE(PG8_SB(1, 0), cB + kstep, voffB); PG8_STAGE(PG8_SA(1, 0), cA + kstep, voffA); PG8_STAGE(PG8_SB(1, 1), cB + hstep + kstep, voffB);
        PG8_WAIT_V(6); PG8_BAR;
    }
    for (;;) {
        const bool has_next = S.next(ui + 1, nxt);
        const char* nA = has_next ? (const char*)g.A + (size_t)nxt.pm * tstep : cA; const char* nB = has_next ? (const char*)g.Bt + (size_t)nxt.pn * tstep : cB;
        for (int t = 0; t < nt; t += 2) {
            const bool last = (t == nt - 2);
            const char* a1 = cA + (size_t)(t + 1) * kstep;
            const char* a2 = last ? nA : cA + (size_t)(t + 2) * kstep; const char* b2 = last ? nB : cB + (size_t)(t + 2) * kstep;
            const char* a3 = a2 + kstep; const char* b3 = b2 + kstep;
            if (last && has_next) S.a_ready(nxt);
            if constexpr (SP2) {
            PG8_LDB(B0, 0, 0); PG8_LDB(B1, 0, 1); PG8_SCHED; PG8_LDA(At, 0, 0); PG8_STAGE(PG8_SA(1, 1), a1 + hstep, voffA);
            PG8_WAIT_V(8); PG8_WAIT_L(0); PG8_BAR; PG8_MMA(0, 0, At, B0); PG8_MMA(0, 1, At, B1); PG8_BAR; PG8_SCHED;
            PG8_LDA(At, 0, 1); PG8_STAGE(PG8_SB(0, 0), b2, voffB); PG8_STAGE(PG8_SB(0, 1), b2 + hstep, voffB); PG8_STAGE(PG8_SA(0, 0), a2, voffA);
            PG8_WAIT_V(8); PG8_WAIT_L(0); PG8_BAR; PG8_MMA(1, 0, At, B0); PG8_MMA(1, 1, At, B1); PG8_BAR; PG8_SCHED;
            PG8_LDB(B0, 1, 0); PG8_LDB(B1, 1, 1); PG8_SCHED; PG8_LDA(At, 1, 0); PG8_STAGE(PG8_SA(0, 1), a2 + hstep, voffA);
            PG8_WAIT_V(8); PG8_WAIT_L(0); PG8_BAR; PG8_MMA(0, 0, At, B0); PG8_MMA(0, 1, At, B1); PG8_BAR; PG8_SCHED;
            PG8_LDA(At, 1, 1); PG8_STAGE(PG8_SB(1, 0), b3, voffB); PG8_STAGE(PG8_SB(1, 1), b3 + hstep, voffB); PG8_STAGE(PG8_SA(1, 0), a3, voffA);
            PG8_WAIT_V(8); PG8_WAIT_L(0); PG8_BAR; PG8_MMA(1, 0, At, B0); PG8_MMA(1, 1, At, B1); PG8_BAR; PG8_SCHED;
            } else {
            PG8_LDB(B0, 0, 0); PG8_SCHED; PG8_LDA(At, 0, 0); PG8_STAGE(PG8_SA(1, 1), a1 + hstep, voffA);
            PG8_WAIT_L(8); PG8_BAR; PG8_WAIT_L(0); PG8_MMA(0, 0, At, B0); PG8_BAR; PG8_SCHED;
            PG8_LDB(B1, 0, 1); PG8_STAGE(PG8_SB(0, 0), b2, voffB);
            PG8_BAR; PG8_WAIT_L(0); PG8_MMA(0, 1, At, B1); PG8_BAR;
            PG8_LDA(At, 0, 1); PG8_STAGE(PG8_SA(0, 0), a2, voffA);
            PG8_BAR; PG8_WAIT_L(0); PG8_MMA(1, 0, At, B0); PG8_BAR; PG8_SCHED;
            PG8_STAGE(PG8_SB(0, 1), b2 + hstep, voffB);
            PG8_WAIT_V(6); PG8_BAR; PG8_MMA(1, 1, At, B1); PG8_BAR;
            PG8_LDB(B0, 1, 0); PG8_SCHED; PG8_LDA(At, 1, 0); PG8_STAGE(PG8_SA(0, 1), a2 + hstep, voffA);
            PG8_WAIT_L(8); PG8_BAR; PG8_WAIT_L(0); PG8_MMA(0, 0, At, B0); PG8_BAR; PG8_SCHED;
            PG8_LDB(B1, 1, 1); PG8_STAGE(PG8_SB(1, 0), b3, voffB);
            PG8_BAR; PG8_WAIT_L(0); PG8_MMA(0, 1, At, B1); PG8_BAR;
            PG8_LDA(At, 1, 1); PG8_STAGE(PG8_SA(1, 0), a3, voffA);
            PG8_BAR; PG8_WAIT_L(0); PG8_MMA(1, 0, At, B0); PG8_BAR; PG8_SCHED;
            PG8_STAGE(PG8_SB(1, 1), b3 + hstep, voffB);
            PG8_WAIT_V(6); PG8_BAR; PG8_MMA(1, 1, At, B1); PG8_BAR;
            }
        }
        if constexpr (ALIGN_EPI) { if (wr == 0) PG8_BAR; }
        if constexpr (!Epi::AFTER_DRAIN) { E(acc, cur, wr, wc, fr, fq); S.done(cur); }
        if (!has_next) break;
#pragma unroll
        for (int a = 0; a < 2; ++a)
#pragma unroll
            for (int b = 0; b < 2; ++b)
#pragma unroll
                for (int m = 0; m < 4; ++m)
#pragma unroll
                    for (int n = 0; n < 2; ++n) acc[a][b][m][n] = (f32x4){0.f, 0.f, 0.f, 0.f};
        cur = nxt; cA = nA; cB = nB; ++ui;
        if constexpr (ALIGN_EPI) { if (wr == 1) PG8_BAR; }
    }
    PG8_WAIT_V(0);
    if constexpr (!ALIGN_EPI) { if (wr == 0) PG8_BAR; }
    PG8_BAR;
    if constexpr (Epi::AFTER_DRAIN) { E.fused(acc, cur, wr, wc, fr, fq, lds, wid, lane); S.done(cur); }
#undef PG8_SA
#undef PG8_SB
#undef PG8_STAGE
#undef PG8_LDA
#undef PG8_LDB
#undef PG8_MMA
#undef PG8_WAIT_V
#undef PG8_WAIT_L
#undef PG8_BAR
#undef PG8_SCHED
}
}
#ifndef PG8_SP2
#define PG8_SP2 true
#endif
#ifndef PG8_ALIGN
#define PG8_ALIGN true
#endif

constexpr int NWAVES = 8;
constexpr int N_PHASES = 13;
constexpr size_t MiB = 1u << 20;
constexpr size_t WS_MOD = 1 * MiB;
constexpr size_t WS_AGG = 6 * MiB, WS_WG = 7 * MiB;
constexpr size_t WS_W1GU = 8 * MiB, WS_W1D = 20 * MiB, WS_WMI = 26 * MiB, WS_WMO = 31 * MiB, WS_W2GU = 33 * MiB, WS_W2D = 45 * MiB;
constexpr size_t WS_XN = 52 * MiB;
constexpr size_t WS_H = 86 * MiB;
constexpr size_t WS_END = 186 * MiB;
constexpr size_t O_YP = 0, O_YS = (size_t)NP * D, O_CP = O_YS + (size_t)NS * D, O_HP = O_CP + 8 * 3 * 512, O_SP = O_HP + 8 * 512,
                 O_CS = O_SP + 8 * 2 * 512, O_HS = O_CS + 128 * 3 * 512, O_SS = O_HS + 128 * 512, O_END = O_SS + 128 * 2 * 512;
constexpr int LDS_BYTES = 147456;

#define LAS __attribute__((address_space(3)))
typedef unsigned short bf16;
typedef unsigned v4u __attribute__((ext_vector_type(4)));
typedef float f32x4 __attribute__((ext_vector_type(4)));
typedef short bf16x8 __attribute__((ext_vector_type(8)));
#define LDS_WAIT() asm volatile("s_waitcnt lgkmcnt(0)" ::: "memory")
__device__ __forceinline__ unsigned f2bf(float f) { unsigned u = __builtin_bit_cast(unsigned, f); return (u + 0x7fffu + ((u >> 16) & 1u)) >> 16; }
__device__ __forceinline__ unsigned pk2(float lo, float hi) { return f2bf(lo) | (f2bf(hi) << 16); }
__device__ __forceinline__ float bf2f(unsigned short h) { return __builtin_bit_cast(float, (unsigned)h << 16); }
__device__ __forceinline__ float bflo(unsigned w) { return __builtin_bit_cast(float, w << 16); }
__device__ __forceinline__ float bfhi(unsigned w) { return __builtin_bit_cast(float, w & 0xffff0000u); }
__device__ __forceinline__ void unpack8(const v4u v, float (&o)[8]) { o[0] = bflo(v.x); o[1] = bfhi(v.x); o[2] = bflo(v.y); o[3] = bfhi(v.y); o[4] = bflo(v.z); o[5] = bfhi(v.z); o[6] = bflo(v.w); o[7] = bfhi(v.w); }
__device__ __forceinline__ v4u pack8(const float (&o)[8]) { v4u v; v.x = pk2(o[0], o[1]); v.y = pk2(o[2], o[3]); v.z = pk2(o[4], o[5]); v.w = pk2(o[6], o[7]); return v; }
__device__ __forceinline__ void ld8f(const float* p, float (&o)[8]) { const f32x4 a = *(const f32x4*)p, b = *(const f32x4*)(p + 4); o[0] = a.x; o[1] = a.y; o[2] = a.z; o[3] = a.w; o[4] = b.x; o[5] = b.y; o[6] = b.z; o[7] = b.w; }
__device__ __forceinline__ void st8f(float* p, const float (&o)[8]) { *(f32x4*)p = (f32x4){o[0], o[1], o[2], o[3]}; *(f32x4*)(p + 4) = (f32x4){o[4], o[5], o[6], o[7]}; }
__device__ __forceinline__ float sigmoid_f(float x) { return __builtin_amdgcn_rcpf(1.0f + __builtin_amdgcn_exp2f(x * -1.44269504089f)); }
__device__ __forceinline__ float wave_sum(float v) {
#pragma unroll
    for (int o = 1; o < 64; o <<= 1) v += __shfl_xor(v, o);
    return v;
}

struct Frame {
    LAS unsigned char* lds;
    int tid, lane, wave, G;
    const float* in[29];
    float* out;
    float* mod; float* agg;
    bf16 *W1GU, *W1D, *WMI, *WMO, *W2GU, *W2D, *XN, *U, *H, *Z, *WG;
};

__device__ __forceinline__ void p0_transpose_item(const float* W, int K, int N, bf16* WT, int mode, LAS float* scr, int item, int lane) {
    const int nblk = N / 32, kb = item / nblk, nb = item % nblk, k0 = 64 * kb, n0 = 32 * nb;
    const int rbase = (mode == 0) ? n0 : (256 * (n0 >> 7) + (n0 & 127) + (mode == 2 ? 128 : 0));
#pragma unroll 8
    for (int i = 0; i < 32; ++i) { const int kk = 2 * i + (lane >> 5); scr[kk * 33 + (lane & 31)] = W[(size_t)(k0 + kk) * N + n0 + (lane & 31)]; }
    LDS_WAIT(); asm volatile("" ::: "memory");
    const int c = lane & 7;
#pragma unroll
    for (int j = 0; j < 4; ++j) { const int n = (lane >> 3) + 8 * j; const LAS float* s = scr + (8 * c) * 33 + n;
        v4u o; o.x = pk2(s[0 * 33], s[1 * 33]); o.y = pk2(s[2 * 33], s[3 * 33]); o.z = pk2(s[4 * 33], s[5 * 33]); o.w = pk2(s[6 * 33], s[7 * 33]);
        *(v4u*)(WT + (size_t)(rbase + n) * K + k0 + 8 * c) = o; }
    LDS_WAIT(); asm volatile("" ::: "memory");
}
__device__ __forceinline__ void p0_prologue(Frame& F) {
    {
        const float* cP = F.in[5]; const float* cS = F.in[6]; const float* wada = F.in[7]; const float* bada = F.in[8];
        const int fr = F.lane & 15, fq = F.lane >> 4, w = F.wave;
        LAS float* red = (LAS float*)F.lds;
        for (int it = blockIdx.x; it < 576; it += F.G) {
            const int n0 = it * 16;
            f32x4 acc[9];
#pragma unroll
            for (int mt = 0; mt < 9; ++mt) acc[mt] = (f32x4){0.f, 0.f, 0.f, 0.f};
#pragma unroll 1
            for (int kk = 0; kk < 4; ++kk) {
                const int k0 = 128 * w + 32 * kk + 8 * fq;
                float bv[8];
#pragma unroll
                for (int j = 0; j < 8; ++j) bv[j] = wada[(size_t)(k0 + j) * (NMOD * D) + n0 + fr];
                const v4u bp = pack8(bv); const bf16x8 bfrag = __builtin_bit_cast(bf16x8, bp);
#pragma unroll
                for (int mt = 0; mt < 9; ++mt) {
                    const int row = 16 * mt + fr;
                    float av[8];
                    if (row < NBATCH) { const float* cp = (row < 8) ? cP + (size_t)row * D : cS + (size_t)(row - 8) * D; ld8f(cp + k0, av);
#pragma unroll
                        for (int j = 0; j < 8; ++j) av[j] = av[j] * sigmoid_f(av[j]); }
                    else {
#pragma unroll
                        for (int j = 0; j < 8; ++j) av[j] = 0.f; }
                    const v4u ap = pack8(av); const bf16x8 afrag = __builtin_bit_cast(bf16x8, ap);
                    acc[mt] = __builtin_amdgcn_mfma_f32_16x16x32_bf16(afrag, bfrag, acc[mt], 0, 0, 0);
                }
            }
#pragma unroll
            for (int mt = 0; mt < 9; ++mt)
#pragma unroll
                for (int i = 0; i < 4; ++i) red[(w * 144 + 16 * mt + 4 * fq + i) * 16 + fr] = acc[mt][i];
            __syncthreads();
            for (int o = F.tid; o < NBATCH * 16; o += NWAVES * 64) {
                const int row = o >> 4, c = o & 15; float s = bada[n0 + c];
#pragma unroll
                for (int ww = 0; ww < 8; ++ww) s += red[(ww * 144 + row) * 16 + c];
                F.mod[(size_t)row * (NMOD * D) + n0 + c] = s;
            }
            __syncthreads();
        }
    }
    LAS float* scr = (LAS float*)(F.lds + F.wave * 16384);
    const int gw = blockIdx.x * NWAVES + F.wave, NGW = F.G * NWAVES;
    constexpr int I_GU = (D / 64) * (FF / 32), I_DN = (FF / 64) * (D / 32), I_MI = (D / 64) * (DIN / 32), I_MO = (D / 64) * (D / 32);
    constexpr int NITEMS = 6 * I_GU + I_MI + I_MO;
    static_assert(I_GU == I_DN, "item counts");
    for (int it = gw; it < NITEMS; it += NGW) {
        int r = it;
        if (r < I_GU) { p0_transpose_item(F.in[10], D, FF, F.W1GU, 1, scr, r, F.lane); continue; } r -= I_GU;
        if (r < I_GU) { p0_transpose_item(F.in[11], D, FF, F.W1GU, 2, scr, r, F.lane); continue; } r -= I_GU;
        if (r < I_DN) { p0_transpose_item(F.in[12], FF, D, F.W1D, 0, scr, r, F.lane); continue; } r -= I_DN;
        if (r < I_MI) { p0_transpose_item(F.in[14], D, DIN, F.WMI, 0, scr, r, F.lane); continue; } r -= I_MI;
        if (r < I_MO) { p0_transpose_item(F.in[23], D, D, F.WMO, 0, scr, r, F.lane); continue; } r -= I_MO;
        if (r < I_GU) { p0_transpose_item(F.in[25], D, FF, F.W2GU, 1, scr, r, F.lane); continue; } r -= I_GU;
        if (r < I_GU) { p0_transpose_item(F.in[26], D, FF, F.W2GU, 2, scr, r, F.lane); continue; } r -= I_GU;
        p0_transpose_item(F.in[27], FF, D, F.W2D, 0, scr, r, F.lane);
    }
    for (int o = blockIdx.x * (NWAVES * 64) + F.tid; o < 2 * 32768; o += F.G * NWAVES * 64) {
        const int g = o >> 15, r = o & 32767, h = r >> 12, n = (r >> 6) & 63, k = r & 63;
        const float* w = g ? F.in[19] : F.in[17];
        F.WG[o] = (bf16)f2bf(w[(h * 64 + k) * 64 + n]);
    }
}

__device__ __forceinline__ void norm_pass(Frame& F, const float* srcP, const float* srcS, const float* gain, int ishift, int iscale) {
    const int gw = blockIdx.x * NWAVES + F.wave, NGW = F.G * NWAVES;
    for (int m = gw; m < M; m += NGW) {
        const float* xrow = (m < NP) ? srcP + (size_t)m * D : srcS + (size_t)(m - NP) * D;
        const int b = row_batch(m);
        const f32x4* xr = (const f32x4*)xrow + F.lane;
        const f32x4* gr = (const f32x4*)gain + F.lane;
        const f32x4* sh = (const f32x4*)(F.mod + (size_t)(b * NMOD + ishift) * D) + F.lane;
        const f32x4* sc = (const f32x4*)(F.mod + (size_t)(b * NMOD + iscale) * D) + F.lane;
        f32x4 v[4]; float s = 0.f;
#pragma unroll
        for (int j = 0; j < 4; ++j) { v[j] = xr[64 * j]; s += (v[j].x * v[j].x + v[j].y * v[j].y) + (v[j].z * v[j].z + v[j].w * v[j].w); }
        const float rstd = 1.0f / sqrtf(wave_sum(s) * (1.f / D) + EPS);
        unsigned long long* o8 = (unsigned long long*)(F.XN + (size_t)m * D) + F.lane;
#pragma unroll
        for (int j = 0; j < 4; ++j) { const f32x4 g = gr[64 * j], a = sh[64 * j], c = sc[64 * j];
            const f32x4 o = (v[j] * rstd) * g * (c + 1.0f) + a;
            o8[64 * j] = (unsigned long long)pk2(o.x, o.y) | ((unsigned long long)pk2(o.z, o.w) << 32); }
    }
}
__device__ __forceinline__ void final_norm(Frame& F) {
    const int gw = blockIdx.x * NWAVES + F.wave, NGW = F.G * NWAVES;
    const f32x4* gr = (const f32x4*)F.in[28] + F.lane;
    for (int m = gw; m < M; m += NGW) {
        f32x4* xr = (f32x4*)(F.out + (size_t)m * D) + F.lane;
        f32x4 v[4]; float s = 0.f;
#pragma unroll
        for (int j = 0; j < 4; ++j) { v[j] = xr[64 * j]; s += (v[j].x * v[j].x + v[j].y * v[j].y) + (v[j].z * v[j].z + v[j].w * v[j].w); }
        const float rstd = 1.0f / sqrtf(wave_sum(s) * (1.f / D) + EPS);
#pragma unroll
        for (int j = 0; j < 4; ++j) xr[64 * j] = (v[j] * rstd) * gr[64 * j];
    }
}

#ifndef NEG_EXPM1
#define NEG_EXPM1(x) (-expm1f(x))
#endif
constexpr int RS = 1040;
constexpr int XL_OFF = 0, XC_OFF = 67 * RS;
static_assert(XC_OFF % 16 == 0 && XC_OFF + 64 * RS <= LDS_BYTES, "mixer LDS map");
template <int PASS>
__device__ __forceinline__ void mixer_mid(Frame& F) {
    const int tid = F.tid, lane = F.lane, fr = lane & 15, fq = lane >> 4;
    LAS unsigned char* lds = F.lds;
    const bf16* Z = F.Z;
    const float* st_conv = F.in[2]; const float* st_h = F.in[3]; const float* st_sc = F.in[4];
    for (int unit = blockIdx.x; unit < 264; unit += F.G) {
        const bool samp = unit >= 256;
        const int row0 = unit * 64;
        const int b = unit >> 5, chunk = unit & 31;
        const int seq0 = (unit - 256) * 16;
        if (PASS == 1) {
            const int ch0 = (tid & 63) * 8, r = tid >> 6;
            const float* wsc = F.in[22];
            float w0[8], w1[8], w2[8]; ld8f(wsc + ch0, w0); ld8f(wsc + 512 + ch0, w1); ld8f(wsc + 1024 + ch0, w2);
            float u2[8], u1[8];
#pragma unroll
            for (int j = 0; j < 8; ++j) { u2[j] = 0.f; u1[j] = 0.f; }
            if (!samp && (r > 0 || chunk > 0)) {
                const bf16* zr = Z + (size_t)(row0 + 8 * r - 2) * DIN + ch0;
                float c[8], v[8];
                unpack8(*(const v4u*)(zr + 1536), c); unpack8(*(const v4u*)(zr + 2048), v);
#pragma unroll
                for (int j = 0; j < 8; ++j) u2[j] = c[j] * v[j];
                unpack8(*(const v4u*)(zr + DIN + 1536), c); unpack8(*(const v4u*)(zr + DIN + 2048), v);
#pragma unroll
                for (int j = 0; j < 8; ++j) u1[j] = c[j] * v[j];
            }
#pragma unroll
            for (int t = 0; t < 8; ++t) {
                const int tok = 8 * r + t; const int seq = seq0 + (tok >> 2);
                if (samp && (t & 3) == 0) { ld8f(st_sc + (size_t)(seq * 2 + 0) * 512 + ch0, u2); ld8f(st_sc + (size_t)(seq * 2 + 1) * 512 + ch0, u1); }
                const bf16* zr = Z + (size_t)(row0 + tok) * DIN + ch0;
                float bs[8], c[8], v[8], u0[8], o[8];
                unpack8(*(const v4u*)(zr + 1024), bs); unpack8(*(const v4u*)(zr + 1536), c); unpack8(*(const v4u*)(zr + 2048), v);
#pragma unroll
                for (int j = 0; j < 8; ++j) { u0[j] = c[j] * v[j]; o[j] = bs[j] * (w0[j] * u2[j] + w1[j] * u1[j] + w2[j] * u0[j]); }
                *(v4u*)(F.U + (size_t)(row0 + tok) * D + 512 + ch0) = pack8(o);
                if (samp) { if ((t & 3) >= 2) st8f(F.out + O_SS + (size_t)(seq * 2 + ((t & 3) - 2)) * 512 + ch0, u0); }
                else if (chunk == 31 && tok >= 62) st8f(F.out + O_SP + (size_t)(b * 2 + (tok - 62)) * 512 + ch0, u0);
#pragma unroll
                for (int j = 0; j < 8; ++j) { u2[j] = u1[j]; u1[j] = u0[j]; }
            }
            if (samp) continue;
        }
        for (int p = tid; p < 67 * 64; p += NWAVES * 64) {
            const int hr = p >> 6, c16 = p & 63, tok = hr - 3;
            v4u v = (v4u){0u, 0u, 0u, 0u};
            const bool valid = samp ? (tok >= 0) : (tok >= 0 || chunk > 0);
            if (valid) v = *(const v4u*)(Z + (size_t)(row0 + tok) * DIN + c16 * 8);
            *(LAS v4u*)(lds + XL_OFF + hr * RS + c16 * 16) = v;
        }
        __syncthreads();
        {
            const int ch0 = (tid & 63) * 8, r = tid >> 6;
            const float* wc = F.in[15]; const float* bc = F.in[16];
            float w0[8], w1[8], w2[8], w3[8], bb[8];
            ld8f(wc + ch0, w0); ld8f(wc + 512 + ch0, w1); ld8f(wc + 1024 + ch0, w2); ld8f(wc + 1536 + ch0, w3); ld8f(bc + ch0, bb);
            float x3[8], x2[8], x1[8];
            unpack8(*(const LAS v4u*)(lds + XL_OFF + (8 * r + 0) * RS + ch0 * 2), x3);
            unpack8(*(const LAS v4u*)(lds + XL_OFF + (8 * r + 1) * RS + ch0 * 2), x2);
            unpack8(*(const LAS v4u*)(lds + XL_OFF + (8 * r + 2) * RS + ch0 * 2), x1);
#pragma unroll
            for (int t = 0; t < 8; ++t) {
                const int tok = 8 * r + t; const int seq = seq0 + (tok >> 2);
                if (samp && (t & 3) == 0) { ld8f(st_conv + (size_t)(seq * 3 + 0) * 512 + ch0, x3); ld8f(st_conv + (size_t)(seq * 3 + 1) * 512 + ch0, x2); ld8f(st_conv + (size_t)(seq * 3 + 2) * 512 + ch0, x1); }
                float x0[8], o[8];
                unpack8(*(const LAS v4u*)(lds + XL_OFF + (tok + 3) * RS + ch0 * 2), x0);
#pragma unroll
                for (int j = 0; j < 8; ++j) o[j] = bb[j] + w3[j] * x0[j] + w2[j] * x1[j] + w1[j] * x2[j] + w0[j] * x3[j];
                *(LAS v4u*)(lds + XC_OFF + tok * RS + ch0 * 2) = pack8(o);
                if (PASS == 2) {
                    if (samp) { if ((t & 3) >= 1) st8f(F.out + O_CS + (size_t)(seq * 3 + ((t & 3) - 1)) * 512 + ch0, x0); }
                    else if (chunk == 31 && tok >= 61) st8f(F.out + O_CP + (size_t)(b * 3 + (tok - 61)) * 512 + ch0, x0);
                }
#pragma unroll
                for (int j = 0; j < 8; ++j) { x3[j] = x2[j]; x2[j] = x1[j]; x1[j] = x0[j]; }
            }
        }
        __syncthreads();
        if (PASS == 2) {
            for (int p = tid; p < 64 * 64; p += NWAVES * 64) {
                const int tok = p >> 6, c16 = p & 63;
                *(LAS v4u*)(lds + XL_OFF + tok * RS + c16 * 16) = *(const v4u*)(Z + (size_t)(row0 + tok) * DIN + 512 + c16 * 8);
            }
            __syncthreads();
        }
        {
            const int chb = 64 * F.wave;
            const bf16* wga = F.WG + (size_t)F.wave * 4096; const bf16* wgx = F.WG + 32768 + (size_t)F.wave * 4096;
            bf16x8 wa[4][2], wx[4][2];
#pragma unroll
            for (int nt = 0; nt < 4; ++nt)
#pragma unroll
                for (int kk = 0; kk < 2; ++kk) { const int o = (16 * nt + fr) * 64 + 32 * kk + 8 * fq;
                    wa[nt][kk] = *(const bf16x8*)(wga + o); wx[nt][kk] = *(const bf16x8*)(wgx + o); }
            float ba[4], bx[4], cl[4], hc[4], Ac[4];
#pragma unroll
            for (int nt = 0; nt < 4; ++nt) { const int ch = chb + 16 * nt + fr; ba[nt] = F.in[18][ch]; bx[nt] = F.in[20][ch];
                cl[nt] = -8.0f * log1pf(__expf(-F.in[21][ch])); hc[nt] = 0.f; Ac[nt] = 1.f; }
            if (PASS == 2 && !samp) {
                for (int jc = 0; jc < chunk; ++jc) {
#pragma unroll
                    for (int nt = 0; nt < 4; ++nt) { const int ch = chb + 16 * nt + fr; const float* ap = F.agg + (size_t)((b * 32 + jc) * 2) * 512 + ch;
                        hc[nt] = ap[0] * hc[nt] + ap[512]; }
                }
            }
#pragma unroll 1
            for (int mt = 0; mt < 4; ++mt) {
                bf16x8 xa[2];
#pragma unroll
                for (int kk = 0; kk < 2; ++kk) xa[kk] = *(const LAS bf16x8*)(lds + XC_OFF + (16 * mt + fr) * RS + (chb + 32 * kk + 8 * fq) * 2);
                f32x4 accA[4], accX[4];
#pragma unroll
                for (int nt = 0; nt < 4; ++nt) { accA[nt] = (f32x4){0.f, 0.f, 0.f, 0.f}; accX[nt] = (f32x4){0.f, 0.f, 0.f, 0.f};
#pragma unroll
                    for (int kk = 0; kk < 2; ++kk) { accA[nt] = __builtin_amdgcn_mfma_f32_16x16x32_bf16(xa[kk], wa[nt][kk], accA[nt], 0, 0, 0);
                        accX[nt] = __builtin_amdgcn_mfma_f32_16x16x32_bf16(xa[kk], wx[nt][kk], accX[nt], 0, 0, 0); } }
#pragma unroll
                for (int nt = 0; nt < 4; ++nt) {
                    const int ch = chb + 16 * nt + fr;
                    float P[4], Hh[4];
#pragma unroll
                    for (int i = 0; i < 4; ++i) {
                        const int tok = 16 * mt + 4 * fq + i;
                        const float xcv = bf2f(*(const LAS unsigned short*)(lds + XC_OFF + tok * RS + ch * 2));
                        const float rg = sigmoid_f(accA[nt][i] + ba[nt]), ig = sigmoid_f(accX[nt][i] + bx[nt]);
                        const float la = cl[nt] * rg;
                        const float a = __expf(la), mult = sqrtf(NEG_EXPM1(2.0f * la));
                        const float bvv = mult * (ig * xcv);
                        if (i == 0) { P[0] = a; Hh[0] = bvv; } else { P[i] = a * P[i - 1]; Hh[i] = a * Hh[i - 1] + bvv; }
                    }
                    float hin;
                    if (samp) { hin = st_h[(size_t)(seq0 + 4 * mt + fq) * 512 + ch]; }
                    else {
                        float Ai = P[3], Bi = Hh[3];
                        float Au = __shfl_up(Ai, 16), Bu = __shfl_up(Bi, 16);
                        if (fq >= 1) { Bi = Ai * Bu + Bi; Ai = Au * Ai; }
                        Au = __shfl_up(Ai, 32); Bu = __shfl_up(Bi, 32);
                        if (fq >= 2) { Bi = Ai * Bu + Bi; Ai = Au * Ai; }
                        float Ae = __shfl_up(Ai, 16), Be = __shfl_up(Bi, 16);
                        if (fq == 0) { Ae = 1.f; Be = 0.f; }
                        hin = Ae * hc[nt] + Be;
                        const float At = __shfl(Ai, fr + 48), Bt = __shfl(Bi, fr + 48);
                        hc[nt] = At * hc[nt] + Bt;
                        if (PASS == 1) Ac[nt] *= At;
                    }
                    if (PASS == 2) {
                        float hv[4];
#pragma unroll
                        for (int i = 0; i < 4; ++i) {
                            const int tok = 16 * mt + 4 * fq + i;
                            hv[i] = P[i] * hin + Hh[i];
                            const float g = bf2f(*(const LAS unsigned short*)(lds + XL_OFF + tok * RS + ch * 2));
                            const float y2 = 1.5957691216f * (g + 0.044715f * g * g * g);
                            const float o = hv[i] * (g * sigmoid_f(y2));
                            *(LAS unsigned short*)(lds + XC_OFF + tok * RS + ch * 2) = (unsigned short)f2bf(o);
                        }
                        if (samp) F.out[O_HS + (size_t)(seq0 + 4 * mt + fq) * 512 + ch] = hv[3];
                        else if (chunk == 31 && mt == 3 && fq == 3) F.out[O_HP + (size_t)b * 512 + ch] = hv[3];
                    }
                }
            }
            if (PASS == 1 && fq == 0) {
#pragma unroll
                for (int nt = 0; nt < 4; ++nt) { const int ch = chb + 16 * nt + fr; float* ap = F.agg + (size_t)((b * 32 + chunk) * 2) * 512 + ch; ap[0] = Ac[nt]; ap[512] = hc[nt]; }
            }
        }
        __syncthreads();
        if (PASS == 2) {
            for (int p = tid; p < 64 * 64; p += NWAVES * 64) {
                const int tok = p >> 6, c16 = p & 63;
                *(v4u*)(F.U + (size_t)(row0 + tok) * D + c16 * 8) = *(const LAS v4u*)(lds + XC_OFF + tok * RS + c16 * 16);
            }
        }
    }
}

struct Args { const float* in[29]; float* out; unsigned char* ws; int ph_lo, ph_hi; };
__global__ void __launch_bounds__(NWAVES * 64, 2) fwd_kernel(Args args) {
    extern __shared__ __attribute__((aligned(16))) unsigned char lds_raw[];
    Frame F;
    F.lds = (LAS unsigned char*)lds_raw;
    F.tid = threadIdx.x; F.lane = F.tid & 63; F.wave = __builtin_amdgcn_readfirstlane(F.tid >> 6); F.G = gridDim.x;
#pragma unroll
    for (int i = 0; i < 29; ++i) F.in[i] = args.in[i];
    F.out = args.out;
    unsigned char* ws = args.ws;
    F.mod = (float*)(ws + WS_MOD); F.agg = (float*)(ws + WS_AGG);
    F.W1GU = (bf16*)(ws + WS_W1GU); F.W1D = (bf16*)(ws + WS_W1D); F.WMI = (bf16*)(ws + WS_WMI); F.WMO = (bf16*)(ws + WS_WMO); F.W2GU = (bf16*)(ws + WS_W2GU); F.W2D = (bf16*)(ws + WS_W2D);
    F.WG = (bf16*)(ws + WS_WG); F.XN = (bf16*)(ws + WS_XN); F.U = F.XN; F.H = (bf16*)(ws + WS_H); F.Z = F.H;
    const int lo = args.ph_lo, hi = args.ph_hi;
#ifndef PH_MASK
#define PH_MASK 0x1FFF
#endif
#define IN(k) (((PH_MASK >> (k)) & 1) && lo <= (k) && (k) < hi)
#define SEAM(k) do { if (IN(k) && IN((k) + 1)) cg::this_grid().sync(); } while (0)

    if (IN(0)) { p0_prologue(F); } SEAM(0);
    if (IN(1)) { norm_pass(F, F.in[0], F.in[1], F.in[9], 0, 1); } SEAM(1);
    if (IN(2)) { pg8::Gemm g{F.XN, F.W1GU, M, 2 * FF, D}; pg8::StaticOrder S; S.init(M, 2 * FF, F.G, (int)blockIdx.x);
        pg8::EpiSwiglu E{F.H, FF}; pg8::gemm_phase<pg8::EpiSwiglu, pg8::StaticOrder, PG8_ALIGN, PG8_SP2>(F.lds, g, S, E); } SEAM(2);
    if (IN(3)) { pg8::Gemm g{F.H, F.W1D, M, D, FF}; pg8::StaticOrder S; S.init(M, D, F.G, (int)blockIdx.x);
        pg8::EpiResid E{F.in[0], F.in[1], F.out, F.mod, 2, 0.5f}; pg8::gemm_phase<pg8::EpiResid, pg8::StaticOrder, PG8_ALIGN, PG8_SP2>(F.lds, g, S, E); } SEAM(3);
    if (IN(4)) { norm_pass(F, F.out, F.out + (size_t)NP * D, F.in[13], 3, 4); } SEAM(4);
    if (IN(5)) { pg8::Gemm g{F.XN, F.WMI, M, DIN, D}; pg8::StaticOrder S; S.init(M, DIN, F.G, (int)blockIdx.x);
        pg8::EpiBf16 E{F.Z, DIN}; pg8::gemm_phase<pg8::EpiBf16, pg8::StaticOrder, PG8_ALIGN, PG8_SP2>(F.lds, g, S, E); } SEAM(5);
    if (IN(6)) { mixer_mid<1>(F); } SEAM(6);
    if (IN(7)) { mixer_mid<2>(F); } SEAM(7);
    if (IN(8)) { pg8::Gemm g{F.U, F.WMO, M, D, D}; pg8::StaticOrder S; S.init(M, D, F.G, (int)blockIdx.x);
        pg8::EpiResid E{F.out, F.out + (size_t)NP * D, F.out, F.mod, 5, 1.0f}; pg8::gemm_phase<pg8::EpiResid, pg8::StaticOrder, PG8_ALIGN, PG8_SP2>(F.lds, g, S, E); } SEAM(8);
    if (IN(9)) { norm_pass(F, F.out, F.out + (size_t)NP * D, F.in[24], 6, 7); } SEAM(9);
    if (IN(10)) { pg8::Gemm g{F.XN, F.W2GU, M, 2 * FF, D}; pg8::StaticOrder S; S.init(M, 2 * FF, F.G, (int)blockIdx.x);
        pg8::EpiSwiglu E{F.H, FF}; pg8::gemm_phase<pg8::EpiSwiglu, pg8::StaticOrder, PG8_ALIGN, PG8_SP2>(F.lds, g, S, E); } SEAM(10);
    if (IN(11)) { pg8::Gemm g{F.H, F.W2D, M, D, FF}; pg8::StaticOrder S; S.init(M, D, F.G, (int)blockIdx.x);
        pg8::EpiResid E{F.out, F.out + (size_t)NP * D, F.out, F.mod, 8, 0.5f}; pg8::gemm_phase<pg8::EpiResid, pg8::StaticOrder, PG8_ALIGN, PG8_SP2>(F.lds, g, S, E); } SEAM(11);
    if (IN(12)) { final_norm(F); }
#undef IN
#undef SEAM
}

extern "C" void kernel_launch(void* const* d_in, const int* in_sizes, int n_in, void* d_out, int out_size, void* d_ws, size_t ws_size, hipStream_t stream) {
    static int grid = 0;
    if (grid == 0) {
        if (n_in != 29 || in_sizes[0] != NP * D || (size_t)out_size != O_END || ws_size < WS_END) {
            fprintf(stderr, "kernel_launch: unexpected shapes: n_in %d in0 %d out %d ws %zu\n", n_in, n_in > 0 ? in_sizes[0] : -1, out_size, ws_size); grid = -1; return; }
        int dev = 0, cus = 0, per_cu = 0;
        (void)hipGetDevice(&dev); (void)hipDeviceGetAttribute(&cus, hipDeviceAttributeMultiprocessorCount, dev);
        if (hipFuncSetAttribute((const void*)fwd_kernel, hipFuncAttributeMaxDynamicSharedMemorySize, LDS_BYTES) != hipSuccess) { fprintf(stderr, "kernel_launch: hipFuncSetAttribute failed\n"); grid = -1; return; }
        if (hipOccupancyMaxActiveBlocksPerMultiprocessor(&per_cu, (const void*)fwd_kernel, NWAVES * 64, LDS_BYTES) != hipSuccess || per_cu < 1) { fprintf(stderr, "kernel_launch: occupancy query says %d\n", per_cu); per_cu = 1; }
        (void)hipGetLastError();
        grid = cus * per_cu;
        fprintf(stderr, "kernel_launch: cus %d per_cu %d grid %d\n", cus, per_cu, grid);
    }
    if (grid < 0) return;
    Args a{};
    for (int i = 0; i < 29; ++i) a.in[i] = (const float*)d_in[i];
    a.out = (float*)d_out; a.ws = (unsigned char*)d_ws;
#if MK_N_LAUNCHES == 1
    a.ph_lo = 0; a.ph_hi = N_PHASES;
    void* kargs[] = {&a};
    hipError_t e = hipLaunchCooperativeKernel((const void*)fwd_kernel, dim3(grid), dim3(NWAVES * 64), kargs, LDS_BYTES, stream);
    if (e != hipSuccess) fprintf(stderr, "kernel_launch: cooperative launch failed: %s (grid %d)\n", hipGetErrorString(e), grid);
#else
    for (int li = 0; li < N_PHASES; ++li) {
        a.ph_lo = li; a.ph_hi = li + 1;
        hipLaunchKernelGGL(fwd_kernel, dim3(grid), dim3(NWAVES * 64), LDS_BYTES, stream, a);
    }
#endif
}
```

```cpp
#include <hip/hip_runtime.h>
#include <hip/hip_cooperative_groups.h>
#include <cstdio>
#include <cstdint>
namespace cg = cooperative_groups;

#ifndef MK_N_LAUNCHES
#define MK_N_LAUNCHES 1
#endif

constexpr int D = 1024, NP = 16384, NS = 512, M = NP + NS, FF = 3072, DIN = 2560, DL = 512;
constexpr int TP = 2048, NBATCH = 136, NMOD = 9;
constexpr float EPS = 1e-6f;
__device__ __forceinline__ int row_batch(int r) { return r < NP ? (r >> 11) : 8 + ((r - NP) >> 2); }

namespace pg8 {
#define PG8_LAS __attribute__((address_space(3)))
typedef unsigned short bf16_t;
typedef short bf16x8 __attribute__((ext_vector_type(8)));
typedef float f32x4 __attribute__((ext_vector_type(4)));
typedef unsigned u32x4 __attribute__((ext_vector_type(4)));
constexpr int BM = 256, BK = 64, HALF = 128, HTB = HALF * BK * 2  , STAGE_BYTES = 8 * HTB, NXCD = 8, WGM = 8;

__host__ __device__ __forceinline__ int lds_byte(int r, int c) { const int st = (r >> 4) * 2 + (c >> 5), rr = r & 15, cc = c & 31, ob = rr * 64 + cc * 2; return st * 1024 + (ob ^ (((ob >> 9) & 1) << 5)); }
__host__ __device__ __forceinline__ void stage_rc(int b, int& R, int& C) { const int st = b / 1024, sb = b % 1024, swz = sb ^ (((sb >> 9) & 1) << 5); R = (st >> 1) * 16 + swz / 64; C = (st & 1) * 32 + (swz % 64) / 2; }
__host__ __device__ __forceinline__ int perm32(int rho) { const int n = rho >> 4, i = rho & 15; return 8 * (i >> 2) + 4 * n + (i & 3); }

struct Unit { int pm, pn, kt0, nkt, slab; };
struct Gemm { const bf16_t* A; const bf16_t* Bt; int M, N, K; };

struct StaticOrder {
    int nM, nN, nwg, G, c, nkt;
    __host__ __device__ void init(int M, int N, int K, int G_, int c_) { nM = M / BM; nN = N / BM; nwg = nM * nN; G = G_; c = c_; nkt = K / BK; }
    __host__ __device__ __forceinline__ bool next(int i, Unit& u) const {
        const long L = (long)i * G + c; if (L >= nwg) return false;
        int wgid = (int)L; { const int q = nwg / NXCD, r = nwg % NXCD, xcd = wgid % NXCD, off = wgid / NXCD; wgid = (xcd < r ? xcd * (q + 1) : r * (q + 1) + (xcd - r) * q) + off; }
        const int nig = WGM * nN, gid = wgid / nig, fm = gid * WGM, gsz = (nM - fm) < WGM ? (nM - fm) : WGM;
        u.pm = fm + ((wgid % nig) % gsz); u.pn = (wgid % nig) / gsz; u.kt0 = 0; u.nkt = nkt; u.slab = -1; return true;
    }
    __device__ __forceinline__ void a_ready(const Unit&) const {}
    __device__ __forceinline__ void done(const Unit&) const {}
};
struct SplitOrder {
    StaticOrder P; int G, c, S, nkt;
    __host__ __device__ void init(int K, int S_, int G_, int c_) { P.init(64 * BM, 4 * BM, K, 1, 0); G = G_; c = c_; S = S_; nkt = K / BK; }
    __host__ __device__ __forceinline__ bool next(int i, Unit& u) const {
        const int L = i * G + c;
        if (L >= 256 + 8 * S) return false;
        const bool pr = L < 256; const int r = L - 256, t = r & 7, s = r >> 3, ns = nkt / S;
        const int w = (L & 7) * 32 + (L >> 3);
        u.pm = pr ? ((w >> 5) * 8 + (w & 7)) : 64 + (t >> 2); u.pn = pr ? ((w & 31) >> 3) : (t & 3);
        u.kt0 = pr ? 0 : s * ns; u.nkt = pr ? nkt : ns; u.slab = pr ? -1 : s; return true;
    }
    __device__ __forceinline__ void a_ready(const Unit&) const {}
    __device__ __forceinline__ void done(const Unit&) const {}
};


__device__ __forceinline__ unsigned cvt_pk_bf16(float lo, float hi) { unsigned r; asm volatile("v_cvt_pk_bf16_f32 %0, %1, %2" : "=v"(r) : "v"(lo), "v"(hi)); return r; }
__device__ __forceinline__ float silu_f(float g) { return g * __builtin_amdgcn_rcpf(1.0f + __builtin_amdgcn_exp2f(g * -1.44269504089f)); }

struct EpiBf16 {
    static constexpr bool PERM = true, AFTER_DRAIN = false;
    bf16_t* O; int ldc;
    __device__ __forceinline__ void operator()(const f32x4 (&acc)[2][2][4][2], const Unit& u, int wr, int wc, int fr, int fq) const {
        const int row0 = u.pm * BM + wr * 64 + fr; const int col0 = u.pn * BM + wc * 32 + 8 * fq;
#pragma unroll
        for (int ai = 0; ai < 2; ++ai)
#pragma unroll
            for (int m = 0; m < 4; ++m) { bf16_t* rowp = O + (size_t)(row0 + ai * HALF + m * 16) * ldc + col0;
#pragma unroll
                for (int bj = 0; bj < 2; ++bj) { const f32x4 v0 = acc[ai][bj][m][0], v1 = acc[ai][bj][m][1];
                    u32x4 w; w.x = cvt_pk_bf16(v0[0], v0[1]); w.y = cvt_pk_bf16(v0[2], v0[3]); w.z = cvt_pk_bf16(v1[0], v1[1]); w.w = cvt_pk_bf16(v1[2], v1[3]);
                    *(u32x4*)(rowp + bj * HALF) = w; } }
    }
};
struct EpiSwiglu {
    static constexpr bool PERM = true, AFTER_DRAIN = false;
    bf16_t* O; int ldc;
    __device__ __forceinline__ void operator()(const f32x4 (&acc)[2][2][4][2], const Unit& u, int wr, int wc, int fr, int fq) const {
        const int row0 = u.pm * BM + wr * 64 + fr; const int col0 = u.pn * HALF + wc * 32 + 8 * fq;
#pragma unroll
        for (int ai = 0; ai < 2; ++ai)
#pragma unroll
            for (int m = 0; m < 4; ++m) { bf16_t* rowp = O + (size_t)(row0 + ai * HALF + m * 16) * ldc + col0;
                const f32x4 g0 = acc[ai][0][m][0], g1 = acc[ai][0][m][1], u0 = acc[ai][1][m][0], u1 = acc[ai][1][m][1];
                u32x4 w;
                w.x = cvt_pk_bf16(silu_f(g0[0]) * u0[0], silu_f(g0[1]) * u0[1]); w.y = cvt_pk_bf16(silu_f(g0[2]) * u0[2], silu_f(g0[3]) * u0[3]);
                w.z = cvt_pk_bf16(silu_f(g1[0]) * u1[0], silu_f(g1[1]) * u1[1]); w.w = cvt_pk_bf16(silu_f(g1[2]) * u1[2], silu_f(g1[3]) * u1[3]);
                *(u32x4*)rowp = w; }
    }
};
struct EpiResid {
    static constexpr bool PERM = false, AFTER_DRAIN = false;
    const float* baseP; const float* baseS; float* out; const float* mod; int idx; float fac; float* part;
    __device__ __forceinline__ void operator()(const f32x4 (&acc)[2][2][4][2], const Unit& u, int wr, int wc, int fr, int fq) const {
        const int colb = u.pn * BM + wc * 32 + 4 * fq;
        if (u.slab >= 0) {
#pragma unroll
            for (int ai = 0; ai < 2; ++ai)
#pragma unroll
                for (int m = 0; m < 4; ++m) {
                    const int r = u.pm * BM + ai * HALF + wr * 64 + m * 16 + fr;
                    const float* mp = mod + (size_t)(row_batch(r) * NMOD + idx) * D;
                    float* pp = part + ((size_t)u.slab * NS + (r - NP)) * D;
#pragma unroll
                    for (int bj = 0; bj < 2; ++bj)
#pragma unroll
                        for (int n = 0; n < 2; ++n) { const int c = colb + bj * HALF + n * 16; const f32x4 mv = *(const f32x4*)(mp + c);
                            *(f32x4*)(pp + c) = (mv * fac) * acc[ai][bj][m][n]; }
                    if (m & 1) asm volatile("" ::: "memory"); }
            return;
        }
#pragma unroll
        for (int ai = 0; ai < 2; ++ai)
#pragma unroll
            for (int m = 0; m < 4; ++m) {
                const int r = u.pm * BM + ai * HALF + wr * 64 + m * 16 + fr;
                const float* bp = (r < NP) ? baseP + (size_t)r * D : baseS + (size_t)(r - NP) * D;
                const float* mp = mod + (size_t)(row_batch(r) * NMOD + idx) * D;
                float* op = out + (size_t)r * D;
#pragma unroll
                for (int bj = 0; bj < 2; ++bj)
#pragma unroll
                    for (int n = 0; n < 2; ++n) { const int c = colb + bj * HALF + n * 16;
                        const f32x4 bs = *(const f32x4*)(bp + c); const f32x4 mv = *(const f32x4*)(mp + c);
                        *(f32x4*)(op + c) = bs + (mv * fac) * acc[ai][bj][m][n]; }
                if (m & 1) asm volatile("" ::: "memory"); }
    }
};

template <class Epi, class Sched, bool ALIGN_EPI = false, bool SP2 = false>
__device__ __forceinline__ void gemm_phase(PG8_LAS unsigned char* lds, const Gemm g, const Sched& S, const Epi& E) {
    const int tid = threadIdx.x, wid = __builtin_amdgcn_readfirstlane(tid >> 6), lane = tid & 63, wr = wid >> 2, wc = wid & 3, fr = lane & 15, fq = lane >> 4;
    const int K = g.K;
    unsigned voffA[2], voffB[2];
#pragma unroll
    for (int i = 0; i < 2; ++i) { int R, C; stage_rc(tid * 16 + i * 8192, R, C); const int Rb = Epi::PERM ? ((R & ~31) + perm32(R & 31)) : R;
        voffA[i] = (unsigned)(R * K + C) * 2u; voffB[i] = (unsigned)(Rb * K + C) * 2u; }
    const size_t kstep = (size_t)(BK * 2);
    const size_t hstep = (size_t)HALF * K * 2;
    const size_t tstep = 2 * hstep;
    const unsigned ldsw = (unsigned)wid * 1024u;
    const int aoff = lds_byte(wr * 64 + fr, fq * 8), boff = lds_byte(wc * 32 + fr, fq * 8);
#define PG8_SA(b, h) (((b) * 2 + (h)) * HTB)
#define PG8_SB(b, h) ((4 + (b) * 2 + (h)) * HTB)
#define PG8_STAGE(bufoff, gbase, voff) do { _Pragma("unroll") for (int _i = 0; _i < 2; ++_i) \
        __builtin_amdgcn_global_load_lds((const unsigned*)((const char*)(gbase) + (voff)[_i]), (PG8_LAS unsigned*)(lds + (bufoff) + ldsw + _i * 8192), 16, 0, 0); } while (0)
#define PG8_LDA(dst, b, h) do { _Pragma("unroll") for (int m = 0; m < 4; ++m) _Pragma("unroll") for (int k = 0; k < 2; ++k) dst[m][k] = *(const PG8_LAS bf16x8*)(lds + PG8_SA(b, h) + aoff + m * 2048 + k * 1024); } while (0)
#define PG8_LDB(dst, b, h) do { _Pragma("unroll") for (int n = 0; n < 2; ++n) _Pragma("unroll") for (int k = 0; k < 2; ++k) dst[n][k] = *(const PG8_LAS bf16x8*)(lds + PG8_SB(b, h) + boff + n * 2048 + k * 1024); } while (0)
#define PG8_MMA(ai, bj, At, Bt) do { __builtin_amdgcn_s_setprio(1); _Pragma("unroll") for (int m = 0; m < 4; ++m) _Pragma("unroll") for (int n = 0; n < 2; ++n) _Pragma("unroll") for (int k = 0; k < 2; ++k) \
        acc[ai][bj][m][n] = __builtin_amdgcn_mfma_f32_16x16x32_bf16(Bt[n][k], At[m][k], acc[ai][bj][m][n], 0, 0, 0); __builtin_amdgcn_s_setprio(0); } while (0)
#define PG8_WAIT_V(n) asm volatile("s_waitcnt vmcnt(" #n ")" ::: "memory")
#define PG8_WAIT_L(n) asm volatile("s_waitcnt lgkmcnt(" #n ")" ::: "memory")
#define PG8_BAR __builtin_amdgcn_s_barrier()
#define PG8_SCHED __builtin_amdgcn_sched_barrier(0)
    Unit cur, nxt; int ui = 0;
    if (!S.next(0, cur)) return;
    f32x4 acc[2][2][4][2];
#pragma unroll
    for (int a = 0; a < 2; ++a)
#pragma unroll
        for (int b = 0; b < 2; ++b)
#pragma unroll
            for (int m = 0; m < 4; ++m)
#pragma unroll
                for (int n = 0; n < 2; ++n) acc[a][b][m][n] = (f32x4){0.f, 0.f, 0.f, 0.f};
    bf16x8 At[4][2], B0[2][2], B1[2][2];
    const char* cA = (const char*)g.A + (size_t)cur.pm * tstep + (size_t)cur.kt0 * kstep; const char* cB = (const char*)g.Bt + (size_t)cur.pn * tstep + (size_t)cur.kt0 * kstep;
    S.a_ready(cur);
    if constexpr (SP2) {
        PG8_STAGE(PG8_SB(0, 0), cB, voffB); PG8_STAGE(PG8_SB(0, 1), cB + hstep, voffB); PG8_STAGE(PG8_SA(0, 0), cA, voffA); PG8_STAGE(PG8_SA(0, 1), cA + hstep, voffA);
        if (wr == 1) PG8_BAR;
        PG8_WAIT_V(2); PG8_BAR;
        PG8_STAGE(PG8_SB(1, 0), cB + kstep, voffB); PG8_STAGE(PG8_SA(1, 0), cA + kstep, voffA); PG8_STAGE(PG8_SB(1, 1), cB + hstep + kstep, voffB);
        PG8_WAIT_V(6); PG8_BAR;
    } else {
        PG8_STAGE(PG8_SB(0, 0), cB, voffB); PG8_STAGE(PG8_SA(0, 0), cA, voffA); PG8_STAGE(PG8_SB(0, 1), cB + hstep, voffB); PG8_STAGE(PG8_SA(0, 1), cA + hstep, voffA);
        if (wr == 1) PG8_BAR;
        PG8_WAIT_V(4); PG8_BAR;
        PG8_STAGE(PG8_SB(1, 0), cB + kstep, voffB); PG8_STAGE(PG8_SA(1, 0), cA + kstep, voffA); PG8_STAGE(PG8_SB(1, 1), cB + hstep + kstep, voffB);
        PG8_WAIT_V(6); PG8_BAR;
    }
    for (;;) {
        const bool has_next = S.next(ui + 1, nxt);
        const char* nA = has_next ? (const char*)g.A + (size_t)nxt.pm * tstep + (size_t)nxt.kt0 * kstep : cA; const char* nB = has_next ? (const char*)g.Bt + (size_t)nxt.pn * tstep + (size_t)nxt.kt0 * kstep : cB;
        const int nt = cur.nkt;
        for (int t = 0; t < nt; t += 2) {
            const bool last = (t == nt - 2);
            const char* a1 = cA + (size_t)(t + 1) * kstep;
            const char* a2 = last ? nA : cA + (size_t)(t + 2) * kstep; const char* b2 = last ? nB : cB + (size_t)(t + 2) * kstep;
            const char* a3 = a2 + kstep; const char* b3 = b2 + kstep;
            if (last && has_next) S.a_ready(nxt);
            if constexpr (SP2) {
            PG8_LDB(B0, 0, 0); PG8_LDB(B1, 0, 1); PG8_SCHED; PG8_LDA(At, 0, 0); PG8_STAGE(PG8_SA(1, 1), a1 + hstep, voffA);
            PG8_WAIT_V(8); PG8_WAIT_L(0); PG8_BAR; PG8_MMA(0, 0, At, B0); PG8_MMA(0, 1, At, B1); PG8_BAR; PG8_SCHED;
            PG8_LDA(At, 0, 1); PG8_STAGE(PG8_SB(0, 0), b2, voffB); PG8_STAGE(PG8_SB(0, 1), b2 + hstep, voffB); PG8_STAGE(PG8_SA(0, 0), a2, voffA);
            PG8_WAIT_V(8); PG8_WAIT_L(0); PG8_BAR; PG8_MMA(1, 0, At, B0); PG8_MMA(1, 1, At, B1); PG8_BAR; PG8_SCHED;
            PG8_LDB(B0, 1, 0); PG8_LDB(B1, 1, 1); PG8_SCHED; PG8_LDA(At, 1, 0); PG8_STAGE(PG8_SA(0, 1), a2 + hstep, voffA);
            PG8_WAIT_V(8); PG8_WAIT_L(0); PG8_BAR; PG8_MMA(0, 0, At, B0); PG8_MMA(0, 1, At, B1); PG8_BAR; PG8_SCHED;
            PG8_LDA(At, 1, 1); PG8_STAGE(PG8_SB(1, 0), b3, voffB); PG8_STAGE(PG8_SB(1, 1), b3 + hstep, voffB); PG8_STAGE(PG8_SA(1, 0), a3, voffA);
            PG8_WAIT_V(8); PG8_WAIT_L(0); PG8_BAR; PG8_MMA(1, 0, At, B0); PG8_MMA(1, 1, At, B1); PG8_BAR; PG8_SCHED;
            } else {
            PG8_LDB(B0, 0, 0); PG8_SCHED; PG8_LDA(At, 0, 0); PG8_STAGE(PG8_SA(1, 1), a1 + hstep, voffA);
            PG8_WAIT_L(8); PG8_BAR; PG8_WAIT_L(0); PG8_MMA(0, 0, At, B0); PG8_BAR; PG8_SCHED;
            PG8_LDB(B1, 0, 1); PG8_STAGE(PG8_SB(0, 0), b2, voffB);
            PG8_BAR; PG8_WAIT_L(0); PG8_MMA(0, 1, At, B1); PG8_BAR;
            PG8_LDA(At, 0, 1); PG8_STAGE(PG8_SA(0, 0), a2, voffA);
            PG8_BAR; PG8_WAIT_L(0); PG8_MMA(1, 0, At, B0); PG8_BAR; PG8_SCHED;
            PG8_STAGE(PG8_SB(0, 1), b2 + hstep, voffB);
            PG8_WAIT_V(6); PG8_BAR; PG8_MMA(1, 1, At, B1); PG8_BAR;
            PG8_LDB(B0, 1, 0); PG8_SCHED; PG8_LDA(At, 1, 0); PG8_STAGE(PG8_SA(0, 1), a2 + hstep, voffA);
            PG8_WAIT_L(8); PG8_BAR; PG8_WAIT_L(0); PG8_MMA(0, 0, At, B0); PG8_BAR; PG8_SCHED;
            PG8_LDB(B1, 1, 1); PG8_STAGE(PG8_SB(1, 0), b3, voffB);
            PG8_BAR; PG8_WAIT_L(0); PG8_MMA(0, 1, At, B1); PG8_BAR;
            PG8_LDA(At, 1, 1); PG8_STAGE(PG8_SA(1, 0), a3, voffA);
            PG8_BAR; PG8_WAIT_L(0); PG8_MMA(1, 0, At, B0); PG8_BAR; PG8_SCHED;
            PG8_STAGE(PG8_SB(1, 1), b3 + hstep, voffB);
            PG8_WAIT_V(6); PG8_BAR; PG8_MMA(1, 1, At, B1); PG8_BAR;
            }
        }
        if constexpr (ALIGN_EPI) { if (wr == 0) PG8_BAR; }
        if constexpr (!Epi::AFTER_DRAIN) { E(acc, cur, wr, wc, fr, fq); S.done(cur); }
        if (!has_next) break;
#pragma unroll
        for (int a = 0; a < 2; ++a)
#pragma unroll
            for (int b = 0; b < 2; ++b)
#pragma unroll
                for (int m = 0; m < 4; ++m)
#pragma unroll
                    for (int n = 0; n < 2; ++n) acc[a][b][m][n] = (f32x4){0.f, 0.f, 0.f, 0.f};
        cur = nxt; cA = nA; cB = nB; ++ui;
        if constexpr (ALIGN_EPI) { if (wr == 1) PG8_BAR; }
    }
    PG8_WAIT_V(0);
    if constexpr (!ALIGN_EPI) { if (wr == 0) PG8_BAR; }
    PG8_BAR;
    if constexpr (Epi::AFTER_DRAIN) { E.fused(acc, cur, wr, wc, fr, fq, lds, wid, lane); S.done(cur); }
#undef PG8_SA
#undef PG8_SB
#undef PG8_STAGE
#undef PG8_LDA
#undef PG8_LDB
#undef PG8_MMA
#undef PG8_WAIT_V
#undef PG8_WAIT_L
#undef PG8_BAR
#undef PG8_SCHED
}
}
#ifndef PG8_SP2
#define PG8_SP2 true
#endif
#ifndef PG8_ALIGN
#define PG8_ALIGN true
#endif

constexpr int NWAVES = 8;
constexpr int N_PHASES = 13;
constexpr size_t MiB = 1u << 20;
constexpr size_t WS_MOD = 1 * MiB;
constexpr size_t WS_AGG = 6 * MiB, WS_WG = 7 * MiB;
constexpr size_t WS_W1GU = 8 * MiB, WS_W1D = 20 * MiB, WS_WMI = 26 * MiB, WS_WMO = 31 * MiB, WS_W2GU = 33 * MiB, WS_W2D = 45 * MiB;
constexpr size_t WS_XN = 52 * MiB;
constexpr size_t WS_H = 86 * MiB;
constexpr size_t WS_PART = 186 * MiB;
constexpr size_t WS_END = 202 * MiB;
constexpr size_t O_YP = 0, O_YS = (size_t)NP * D, O_CP = O_YS + (size_t)NS * D, O_HP = O_CP + 8 * 3 * 512, O_SP = O_HP + 8 * 512,
                 O_CS = O_SP + 8 * 2 * 512, O_HS = O_CS + 128 * 3 * 512, O_SS = O_HS + 128 * 512, O_END = O_SS + 128 * 2 * 512;
constexpr int LDS_BYTES = 147456;

#define LAS __attribute__((address_space(3)))
typedef unsigned short bf16;
typedef unsigned v4u __attribute__((ext_vector_type(4)));
typedef float f32x4 __attribute__((ext_vector_type(4)));
typedef short bf16x8 __attribute__((ext_vector_type(8)));
#define LDS_WAIT() asm volatile("s_waitcnt lgkmcnt(0)" ::: "memory")
__device__ __forceinline__ unsigned f2bf(float f) { unsigned u = __builtin_bit_cast(unsigned, f); return (u + 0x7fffu + ((u >> 16) & 1u)) >> 16; }
__device__ __forceinline__ unsigned pk2(float lo, float hi) { return f2bf(lo) | (f2bf(hi) << 16); }
__device__ __forceinline__ float bf2f(unsigned short h) { return __builtin_bit_cast(float, (unsigned)h << 16); }
__device__ __forceinline__ float bflo(unsigned w) { return __builtin_bit_cast(float, w << 16); }
__device__ __forceinline__ float bfhi(unsigned w) { return __builtin_bit_cast(float, w & 0xffff0000u); }
__device__ __forceinline__ void unpack8(const v4u v, float (&o)[8]) { o[0] = bflo(v.x); o[1] = bfhi(v.x); o[2] = bflo(v.y); o[3] = bfhi(v.y); o[4] = bflo(v.z); o[5] = bfhi(v.z); o[6] = bflo(v.w); o[7] = bfhi(v.w); }
__device__ __forceinline__ v4u pack8(const float (&o)[8]) { v4u v; v.x = pk2(o[0], o[1]); v.y = pk2(o[2], o[3]); v.z = pk2(o[4], o[5]); v.w = pk2(o[6], o[7]); return v; }
__device__ __forceinline__ void ld8f(const float* p, float (&o)[8]) { const f32x4 a = *(const f32x4*)p, b = *(const f32x4*)(p + 4); o[0] = a.x; o[1] = a.y; o[2] = a.z; o[3] = a.w; o[4] = b.x; o[5] = b.y; o[6] = b.z; o[7] = b.w; }
__device__ __forceinline__ void st8f(float* p, const float (&o)[8]) { *(f32x4*)p = (f32x4){o[0], o[1], o[2], o[3]}; *(f32x4*)(p + 4) = (f32x4){o[4], o[5], o[6], o[7]}; }
__device__ __forceinline__ float sigmoid_f(float x) { return __builtin_amdgcn_rcpf(1.0f + __builtin_amdgcn_exp2f(x * -1.44269504089f)); }
__device__ __forceinline__ float wave_sum(float v) {
#pragma unroll
    for (int o = 1; o < 64; o <<= 1) v += __shfl_xor(v, o);
    return v;
}

struct Frame {
    LAS unsigned char* lds;
    int tid, lane, wave, G;
    const float* in[29];
    float* out;
    float* mod; float* agg; float* part;
    bf16 *W1GU, *W1D, *WMI, *WMO, *W2GU, *W2D, *XN, *U, *H, *Z, *WG;
};

__device__ __forceinline__ void p0_transpose_item(const float* W, int K, int N, bf16* WT, int mode, LAS float* scr, int item, int lane) {
    const int nblk = N / 32, kb = item / nblk, nb = item % nblk, k0 = 64 * kb, n0 = 32 * nb;
    const int rbase = (mode == 0) ? n0 : (256 * (n0 >> 7) + (n0 & 127) + (mode == 2 ? 128 : 0));
#pragma unroll 8
    for (int i = 0; i < 32; ++i) { const int kk = 2 * i + (lane >> 5); scr[kk * 33 + (lane & 31)] = W[(size_t)(k0 + kk) * N + n0 + (lane & 31)]; }
    LDS_WAIT(); asm volatile("" ::: "memory");
    const int c = lane & 7;
#pragma unroll
    for (int j = 0; j < 4; ++j) { const int n = (lane >> 3) + 8 * j; const LAS float* s = scr + (8 * c) * 33 + n;
        v4u o; o.x = pk2(s[0 * 33], s[1 * 33]); o.y = pk2(s[2 * 33], s[3 * 33]); o.z = pk2(s[4 * 33], s[5 * 33]); o.w = pk2(s[6 * 33], s[7 * 33]);
        *(v4u*)(WT + (size_t)(rbase + n) * K + k0 + 8 * c) = o; }
    LDS_WAIT(); asm volatile("" ::: "memory");
}
__device__ __forceinline__ void p0_prologue(Frame& F) {
    {
        const float* cP = F.in[5]; const float* cS = F.in[6]; const float* wada = F.in[7]; const float* bada = F.in[8];
        const int fr = F.lane & 15, fq = F.lane >> 4, w = F.wave;
        LAS float* red = (LAS float*)F.lds;
        for (int it = blockIdx.x; it < 576; it += F.G) {
            const int n0 = it * 16;
            f32x4 acc[9];
#pragma unroll
            for (int mt = 0; mt < 9; ++mt) acc[mt] = (f32x4){0.f, 0.f, 0.f, 0.f};
#pragma unroll 1
            for (int kk = 0; kk < 4; ++kk) {
                const int k0 = 128 * w + 32 * kk + 8 * fq;
                float bv[8];
#pragma unroll
                for (int j = 0; j < 8; ++j) bv[j] = wada[(size_t)(k0 + j) * (NMOD * D) + n0 + fr];
                const v4u bp = pack8(bv); const bf16x8 bfrag = __builtin_bit_cast(bf16x8, bp);
#pragma unroll
                for (int mt = 0; mt < 9; ++mt) {
                    const int row = 16 * mt + fr;
                    float av[8];
                    if (row < NBATCH) { const float* cp = (row < 8) ? cP + (size_t)row * D : cS + (size_t)(row - 8) * D; ld8f(cp + k0, av);
#pragma unroll
                        for (int j = 0; j < 8; ++j) av[j] = av[j] * sigmoid_f(av[j]); }
                    else {
#pragma unroll
                        for (int j = 0; j < 8; ++j) av[j] = 0.f; }
                    const v4u ap = pack8(av); const bf16x8 afrag = __builtin_bit_cast(bf16x8, ap);
                    acc[mt] = __builtin_amdgcn_mfma_f32_16x16x32_bf16(afrag, bfrag, acc[mt], 0, 0, 0);
                }
            }
#pragma unroll
            for (int mt = 0; mt < 9; ++mt)
#pragma unroll
                for (int i = 0; i < 4; ++i) red[(w * 144 + 16 * mt + 4 * fq + i) * 16 + fr] = acc[mt][i];
            __syncthreads();
            for (int o = F.tid; o < NBATCH * 16; o += NWAVES * 64) {
                const int row = o >> 4, c = o & 15; float s = bada[n0 + c];
#pragma unroll
                for (int ww = 0; ww < 8; ++ww) s += red[(ww * 144 + row) * 16 + c];
                F.mod[(size_t)row * (NMOD * D) + n0 + c] = s;
            }
            __syncthreads();
        }
    }
    LAS float* scr = (LAS float*)(F.lds + F.wave * 16384);
    const int gw = blockIdx.x * NWAVES + F.wave, NGW = F.G * NWAVES;
    constexpr int I_GU = (D / 64) * (FF / 32), I_DN = (FF / 64) * (D / 32), I_MI = (D / 64) * (DIN / 32), I_MO = (D / 64) * (D / 32);
    constexpr int NITEMS = 6 * I_GU + I_MI + I_MO;
    static_assert(I_GU == I_DN, "item counts");
    for (int it = gw; it < NITEMS; it += NGW) {
        int r = it;
        if (r < I_GU) { p0_transpose_item(F.in[10], D, FF, F.W1GU, 1, scr, r, F.lane); continue; } r -= I_GU;
        if (r < I_GU) { p0_transpose_item(F.in[11], D, FF, F.W1GU, 2, scr, r, F.lane); continue; } r -= I_GU;
        if (r < I_DN) { p0_transpose_item(F.in[12], FF, D, F.W1D, 0, scr, r, F.lane); continue; } r -= I_DN;
        if (r < I_MI) { p0_transpose_item(F.in[14], D, DIN, F.WMI, 0, scr, r, F.lane); continue; } r -= I_MI;
        if (r < I_MO) { p0_transpose_item(F.in[23], D, D, F.WMO, 0, scr, r, F.lane); continue; } r -= I_MO;
        if (r < I_GU) { p0_transpose_item(F.in[25], D, FF, F.W2GU, 1, scr, r, F.lane); continue; } r -= I_GU;
        if (r < I_GU) { p0_transpose_item(F.in[26], D, FF, F.W2GU, 2, scr, r, F.lane); continue; } r -= I_GU;
        p0_transpose_item(F.in[27], FF, D, F.W2D, 0, scr, r, F.lane);
    }
    for (int o = blockIdx.x * (NWAVES * 64) + F.tid; o < 2 * 32768; o += F.G * NWAVES * 64) {
        const int g = o >> 15, r = o & 32767, h = r >> 12, n = (r >> 6) & 63, k = r & 63;
        const float* w = g ? F.in[19] : F.in[17];
        F.WG[o] = (bf16)f2bf(w[(h * 64 + k) * 64 + n]);
    }
}

__device__ __forceinline__ void norm_pass(Frame& F, const float* srcP, const float* srcS, const float* gain, int ishift, int iscale, int nsplit) {
    const int gw = blockIdx.x * NWAVES + F.wave, NGW = F.G * NWAVES;
    for (int m = gw; m < M; m += NGW) {
        const float* xrow = (m < NP) ? srcP + (size_t)m * D : srcS + (size_t)(m - NP) * D;
        const int b = row_batch(m);
        const f32x4* xr = (const f32x4*)xrow + F.lane;
        const f32x4* gr = (const f32x4*)gain + F.lane;
        const f32x4* sh = (const f32x4*)(F.mod + (size_t)(b * NMOD + ishift) * D) + F.lane;
        const f32x4* sc = (const f32x4*)(F.mod + (size_t)(b * NMOD + iscale) * D) + F.lane;
        f32x4 v[4]; float s = 0.f;
#pragma unroll
        for (int j = 0; j < 4; ++j) v[j] = xr[64 * j];
        if (m >= NP && nsplit > 0) {
            for (int sp = 0; sp < nsplit; ++sp) { const f32x4* pr = (const f32x4*)(F.part + ((size_t)sp * NS + (m - NP)) * D) + F.lane;
#pragma unroll
                for (int j = 0; j < 4; ++j) v[j] += pr[64 * j]; }
            f32x4* orow = (f32x4*)(F.out + (size_t)m * D) + F.lane;
#pragma unroll
            for (int j = 0; j < 4; ++j) orow[64 * j] = v[j];
        }
#pragma unroll
        for (int j = 0; j < 4; ++j) s += (v[j].x * v[j].x + v[j].y * v[j].y) + (v[j].z * v[j].z + v[j].w * v[j].w);
        const float rstd = 1.0f / sqrtf(wave_sum(s) * (1.f / D) + EPS);
        unsigned long long* o8 = (unsigned long long*)(F.XN + (size_t)m * D) + F.lane;
#pragma unroll
        for (int j = 0; j < 4; ++j) { const f32x4 g = gr[64 * j], a = sh[64 * j], c = sc[64 * j];
            const f32x4 o = (v[j] * rstd) * g * (c + 1.0f) + a;
            o8[64 * j] = (unsigned long long)pk2(o.x, o.y) | ((unsigned long long)pk2(o.z, o.w) << 32); }
    }
}
__device__ __forceinline__ void final_norm(Frame& F, int nsplit) {
    const int gw = blockIdx.x * NWAVES + F.wave, NGW = F.G * NWAVES;
    const f32x4* gr = (const f32x4*)F.in[28] + F.lane;
    for (int m = gw; m < M; m += NGW) {
        f32x4* xr = (f32x4*)(F.out + (size_t)m * D) + F.lane;
        f32x4 v[4]; float s = 0.f;
#pragma unroll
        for (int j = 0; j < 4; ++j) v[j] = xr[64 * j];
        if (m >= NP) {
            for (int sp = 0; sp < nsplit; ++sp) { const f32x4* pr = (const f32x4*)(F.part + ((size_t)sp * NS + (m - NP)) * D) + F.lane;
#pragma unroll
                for (int j = 0; j < 4; ++j) v[j] += pr[64 * j]; }
        }
#pragma unroll
        for (int j = 0; j < 4; ++j) s += (v[j].x * v[j].x + v[j].y * v[j].y) + (v[j].z * v[j].z + v[j].w * v[j].w);
        const float rstd = 1.0f / sqrtf(wave_sum(s) * (1.f / D) + EPS);
#pragma unroll
        for (int j = 0; j < 4; ++j) xr[64 * j] = (v[j] * rstd) * gr[64 * j];
    }
}

#ifndef NEG_EXPM1
#define NEG_EXPM1(x) (-expm1f(x))
#endif
constexpr int RS = 1040;
constexpr int XL_OFF = 0, XC_OFF = 67 * RS;
static_assert(XC_OFF % 16 == 0 && XC_OFF + 64 * RS <= LDS_BYTES, "mixer LDS map");
template <int PASS>
__device__ __forceinline__ void mixer_mid(Frame& F) {
    const int tid = F.tid, lane = F.lane, fr = lane & 15, fq = lane >> 4;
    LAS unsigned char* lds = F.lds;
    const bf16* Z = F.Z;
    const float* st_conv = F.in[2]; const float* st_h = F.in[3]; const float* st_sc = F.in[4];
    for (int unit = blockIdx.x; unit < 264; unit += F.G) {
        const bool samp = unit >= 256;
        const int row0 = unit * 64;
        const int b = unit >> 5, chunk = unit & 31;
        const int seq0 = (unit - 256) * 16;
        if (PASS == 1) {
            const int ch0 = (tid & 63) * 8, r = tid >> 6;
            const float* wsc = F.in[22];
            float w0[8], w1[8], w2[8]; ld8f(wsc + ch0, w0); ld8f(wsc + 512 + ch0, w1); ld8f(wsc + 1024 + ch0, w2);
            float u2[8], u1[8];
#pragma unroll
            for (int j = 0; j < 8; ++j) { u2[j] = 0.f; u1[j] = 0.f; }
            if (!samp && (r > 0 || chunk > 0)) {
                const bf16* zr = Z + (size_t)(row0 + 8 * r - 2) * DIN + ch0;
                float c[8], v[8];
                unpack8(*(const v4u*)(zr + 1536), c); unpack8(*(const v4u*)(zr + 2048), v);
#pragma unroll
                for (int j = 0; j < 8; ++j) u2[j] = c[j] * v[j];
                unpack8(*(const v4u*)(zr + DIN + 1536), c); unpack8(*(const v4u*)(zr + DIN + 2048), v);
#pragma unroll
                for (int j = 0; j < 8; ++j) u1[j] = c[j] * v[j];
            }
#pragma unroll
            for (int t = 0; t < 8; ++t) {
                const int tok = 8 * r + t; const int seq = seq0 + (tok >> 2);
                if (samp && (t & 3) == 0) { ld8f(st_sc + (size_t)(seq * 2 + 0) * 512 + ch0, u2); ld8f(st_sc + (size_t)(seq * 2 + 1) * 512 + ch0, u1); }
                const bf16* zr = Z + (size_t)(row0 + tok) * DIN + ch0;
                float bs[8], c[8], v[8], u0[8], o[8];
                unpack8(*(const v4u*)(zr + 1024), bs); unpack8(*(const v4u*)(zr + 1536), c); unpack8(*(const v4u*)(zr + 2048), v);
#pragma unroll
                for (int j = 0; j < 8; ++j) { u0[j] = c[j] * v[j]; o[j] = bs[j] * (w0[j] * u2[j] + w1[j] * u1[j] + w2[j] * u0[j]); }
                *(v4u*)(F.U + (size_t)(row0 + tok) * D + 512 + ch0) = pack8(o);
                if (samp) { if ((t & 3) >= 2) st8f(F.out + O_SS + (size_t)(seq * 2 + ((t & 3) - 2)) * 512 + ch0, u0); }
                else if (chunk == 31 && tok >= 62) st8f(F.out + O_SP + (size_t)(b * 2 + (tok - 62)) * 512 + ch0, u0);
#pragma unroll
                for (int j = 0; j < 8; ++j) { u2[j] = u1[j]; u1[j] = u0[j]; }
            }
            if (samp) continue;
        }
        for (int p = tid; p < 67 * 64; p += NWAVES * 64) {
            const int hr = p >> 6, c16 = p & 63, tok = hr - 3;
            v4u v = (v4u){0u, 0u, 0u, 0u};
            const bool valid = samp ? (tok >= 0) : (tok >= 0 || chunk > 0);
            if (valid) v = *(const v4u*)(Z + (size_t)(row0 + tok) * DIN + c16 * 8);
            *(LAS v4u*)(lds + XL_OFF + hr * RS + c16 * 16) = v;
        }
        __syncthreads();
        {
            const int ch0 = (tid & 63) * 8, r = tid >> 6;
            const float* wc = F.in[15]; const float* bc = F.in[16];
            float w0[8], w1[8], w2[8], w3[8], bb[8];
            ld8f(wc + ch0, w0); ld8f(wc + 512 + ch0, w1); ld8f(wc + 1024 + ch0, w2); ld8f(wc + 1536 + ch0, w3); ld8f(bc + ch0, bb);
            float x3[8], x2[8], x1[8];
            unpack8(*(const LAS v4u*)(lds + XL_OFF + (8 * r + 0) * RS + ch0 * 2), x3);
            unpack8(*(const LAS v4u*)(lds + XL_OFF + (8 * r + 1) * RS + ch0 * 2), x2);
            unpack8(*(const LAS v4u*)(lds + XL_OFF + (8 * r + 2) * RS + ch0 * 2), x1);
#pragma unroll
            for (int t = 0; t < 8; ++t) {
                const int tok = 8 * r + t; const int seq = seq0 + (tok >> 2);
                if (samp && (t & 3) == 0) { ld8f(st_conv + (size_t)(seq * 3 + 0) * 512 + ch0, x3); ld8f(st_conv + (size_t)(seq * 3 + 1) * 512 + ch0, x2); ld8f(st_conv + (size_t)(seq * 3 + 2) * 512 + ch0, x1); }
                float x0[8], o[8];
                unpack8(*(const LAS v4u*)(lds + XL_OFF + (tok + 3) * RS + ch0 * 2), x0);
#pragma unroll
                for (int j = 0; j < 8; ++j) o[j] = bb[j] + w3[j] * x0[j] + w2[j] * x1[j] + w1[j] * x2[j] + w0[j] * x3[j];
                *(LAS v4u*)(lds + XC_OFF + tok * RS + ch0 * 2) = pack8(o);
                if (PASS == 2) {
                    if (samp) { if ((t & 3) >= 1) st8f(F.out + O_CS + (size_t)(seq * 3 + ((t & 3) - 1)) * 512 + ch0, x0); }
                    else if (chunk == 31 && tok >= 61) st8f(F.out + O_CP + (size_t)(b * 3 + (tok - 61)) * 512 + ch0, x0);
                }
#pragma unroll
                for (int j = 0; j < 8; ++j) { x3[j] = x2[j]; x2[j] = x1[j]; x1[j] = x0[j]; }
            }
        }
        __syncthreads();
        if (PASS == 2) {
            for (int p = tid; p < 64 * 64; p += NWAVES * 64) {
                const int tok = p >> 6, c16 = p & 63;
                *(LAS v4u*)(lds + XL_OFF + tok * RS + c16 * 16) = *(const v4u*)(Z + (size_t)(row0 + tok) * DIN + 512 + c16 * 8);
            }
            __syncthreads();
        }
        {
            const int chb = 64 * F.wave;
            const bf16* wga = F.WG + (size_t)F.wave * 4096; const bf16* wgx = F.WG + 32768 + (size_t)F.wave * 4096;
            bf16x8 wa[4][2], wx[4][2];
#pragma unroll
            for (int nt = 0; nt < 4; ++nt)
#pragma unroll
                for (int kk = 0; kk < 2; ++kk) { const int o = (16 * nt + fr) * 64 + 32 * kk + 8 * fq;
                    wa[nt][kk] = *(const bf16x8*)(wga + o); wx[nt][kk] = *(const bf16x8*)(wgx + o); }
            float ba[4], bx[4], cl[4], hc[4], Ac[4];
#pragma unroll
            for (int nt = 0; nt < 4; ++nt) { const int ch = chb + 16 * nt + fr; ba[nt] = F.in[18][ch]; bx[nt] = F.in[20][ch];
                cl[nt] = -8.0f * log1pf(__expf(-F.in[21][ch])); hc[nt] = 0.f; Ac[nt] = 1.f; }
            if (PASS == 2 && !samp) {
                for (int jc = 0; jc < chunk; ++jc) {
#pragma unroll
                    for (int nt = 0; nt < 4; ++nt) { const int ch = chb + 16 * nt + fr; const float* ap = F.agg + (size_t)((b * 32 + jc) * 2) * 512 + ch;
                        hc[nt] = ap[0] * hc[nt] + ap[512]; }
                }
            }
#pragma unroll 1
            for (int mt = 0; mt < 4; ++mt) {
                bf16x8 xa[2];
#pragma unroll
                for (int kk = 0; kk < 2; ++kk) xa[kk] = *(const LAS bf16x8*)(lds + XC_OFF + (16 * mt + fr) * RS + (chb + 32 * kk + 8 * fq) * 2);
                f32x4 accA[4], accX[4];
#pragma unroll
                for (int nt = 0; nt < 4; ++nt) { accA[nt] = (f32x4){0.f, 0.f, 0.f, 0.f}; accX[nt] = (f32x4){0.f, 0.f, 0.f, 0.f};
#pragma unroll
                    for (int kk = 0; kk < 2; ++kk) { accA[nt] = __builtin_amdgcn_mfma_f32_16x16x32_bf16(xa[kk], wa[nt][kk], accA[nt], 0, 0, 0);
                        accX[nt] = __builtin_amdgcn_mfma_f32_16x16x32_bf16(xa[kk], wx[nt][kk], accX[nt], 0, 0, 0); } }
#pragma unroll
                for (int nt = 0; nt < 4; ++nt) {
                    const int ch = chb + 16 * nt + fr;
                    float P[4], Hh[4];
#pragma unroll
                    for (int i = 0; i < 4; ++i) {
                        const int tok = 16 * mt + 4 * fq + i;
                        const float xcv = bf2f(*(const LAS unsigned short*)(lds + XC_OFF + tok * RS + ch * 2));
                        const float rg = sigmoid_f(accA[nt][i] + ba[nt]), ig = sigmoid_f(accX[nt][i] + bx[nt]);
                        const float la = cl[nt] * rg;
                        const float a = __expf(la), mult = sqrtf(NEG_EXPM1(2.0f * la));
                        const float bvv = mult * (ig * xcv);
                        if (i == 0) { P[0] = a; Hh[0] = bvv; } else { P[i] = a * P[i - 1]; Hh[i] = a * Hh[i - 1] + bvv; }
                    }
                    float hin;
                    if (samp) { hin = st_h[(size_t)(seq0 + 4 * mt + fq) * 512 + ch]; }
                    else {
                        float Ai = P[3], Bi = Hh[3];
                        float Au = __shfl_up(Ai, 16), Bu = __shfl_up(Bi, 16);
                        if (fq >= 1) { Bi = Ai * Bu + Bi; Ai = Au * Ai; }
                        Au = __shfl_up(Ai, 32); Bu = __shfl_up(Bi, 32);
                        if (fq >= 2) { Bi = Ai * Bu + Bi; Ai = Au * Ai; }
                        float Ae = __shfl_up(Ai, 16), Be = __shfl_up(Bi, 16);
                        if (fq == 0) { Ae = 1.f; Be = 0.f; }
                        hin = Ae * hc[nt] + Be;
                        const float At = __shfl(Ai, fr + 48), Bt = __shfl(Bi, fr + 48);
                        hc[nt] = At * hc[nt] + Bt;
                        if (PASS == 1) Ac[nt] *= At;
                    }
                    if (PASS == 2) {
                        float hv[4];
#pragma unroll
                        for (int i = 0; i < 4; ++i) {
                            const int tok = 16 * mt + 4 * fq + i;
                            hv[i] = P[i] * hin + Hh[i];
                            const float g = bf2f(*(const LAS unsigned short*)(lds + XL_OFF + tok * RS + ch * 2));
                            const float y2 = 1.5957691216f * (g + 0.044715f * g * g * g);
                            const float o = hv[i] * (g * sigmoid_f(y2));
                            *(LAS unsigned short*)(lds + XC_OFF + tok * RS + ch * 2) = (unsigned short)f2bf(o);
                        }
                        if (samp) F.out[O_HS + (size_t)(seq0 + 4 * mt + fq) * 512 + ch] = hv[3];
                        else if (chunk == 31 && mt == 3 && fq == 3) F.out[O_HP + (size_t)b * 512 + ch] = hv[3];
                    }
                }
            }
            if (PASS == 1 && fq == 0) {
#pragma unroll
                for (int nt = 0; nt < 4; ++nt) { const int ch = chb + 16 * nt + fr; float* ap = F.agg + (size_t)((b * 32 + chunk) * 2) * 512 + ch; ap[0] = Ac[nt]; ap[512] = hc[nt]; }
            }
        }
        __syncthreads();
        if (PASS == 2) {
            for (int p = tid; p < 64 * 64; p += NWAVES * 64) {
                const int tok = p >> 6, c16 = p & 63;
                *(v4u*)(F.U + (size_t)(row0 + tok) * D + c16 * 8) = *(const LAS v4u*)(lds + XC_OFF + tok * RS + c16 * 16);
            }
        }
    }
}

struct Args { const float* in[29]; float* out; unsigned char* ws; int ph_lo, ph_hi; };
__global__ void __launch_bounds__(NWAVES * 64, 2) fwd_kernel(Args args) {
    extern __shared__ __attribute__((aligned(16))) unsigned char lds_raw[];
    Frame F;
    F.lds = (LAS unsigned char*)lds_raw;
    F.tid = threadIdx.x; F.lane = F.tid & 63; F.wave = __builtin_amdgcn_readfirstlane(F.tid >> 6); F.G = gridDim.x;
#pragma unroll
    for (int i = 0; i < 29; ++i) F.in[i] = args.in[i];
    F.out = args.out;
    unsigned char* ws = args.ws;
    F.mod = (float*)(ws + WS_MOD); F.agg = (float*)(ws + WS_AGG); F.part = (float*)(ws + WS_PART);
    F.W1GU = (bf16*)(ws + WS_W1GU); F.W1D = (bf16*)(ws + WS_W1D); F.WMI = (bf16*)(ws + WS_WMI); F.WMO = (bf16*)(ws + WS_WMO); F.W2GU = (bf16*)(ws + WS_W2GU); F.W2D = (bf16*)(ws + WS_W2D);
    F.WG = (bf16*)(ws + WS_WG); F.XN = (bf16*)(ws + WS_XN); F.U = F.XN; F.H = (bf16*)(ws + WS_H); F.Z = F.H;
    const int lo = args.ph_lo, hi = args.ph_hi;
#ifndef PH_MASK
#define PH_MASK 0x1FFF
#endif
#define IN(k) (((PH_MASK >> (k)) & 1) && lo <= (k) && (k) < hi)
#define SEAM(k) do { if (IN(k) && IN((k) + 1)) cg::this_grid().sync(); } while (0)

    constexpr int SPLIT_DN = 8, SPLIT_MO = 4;
    if (IN(0)) { p0_prologue(F); } SEAM(0);
    if (IN(1)) { norm_pass(F, F.in[0], F.in[1], F.in[9], 0, 1, 0); } SEAM(1);
    if (IN(2)) { pg8::Gemm g{F.XN, F.W1GU, M, 2 * FF, D}; pg8::StaticOrder S; S.init(M, 2 * FF, D, F.G, (int)blockIdx.x);
        pg8::EpiSwiglu E{F.H, FF}; pg8::gemm_phase<pg8::EpiSwiglu, pg8::StaticOrder, PG8_ALIGN, PG8_SP2>(F.lds, g, S, E); } SEAM(2);
    if (IN(3)) { pg8::Gemm g{F.H, F.W1D, M, D, FF}; pg8::SplitOrder S; S.init(FF, SPLIT_DN, F.G, (int)blockIdx.x);
        pg8::EpiResid E{F.in[0], F.in[1], F.out, F.mod, 2, 0.5f, F.part}; pg8::gemm_phase<pg8::EpiResid, pg8::SplitOrder, PG8_ALIGN, PG8_SP2>(F.lds, g, S, E); } SEAM(3);
    if (IN(4)) { norm_pass(F, F.out, F.in[1], F.in[13], 3, 4, SPLIT_DN); } SEAM(4);
    if (IN(5)) { pg8::Gemm g{F.XN, F.WMI, M, DIN, D}; pg8::StaticOrder S; S.init(M, DIN, D, F.G, (int)blockIdx.x);
        pg8::EpiBf16 E{F.Z, DIN}; pg8::gemm_phase<pg8::EpiBf16, pg8::StaticOrder, PG8_ALIGN, PG8_SP2>(F.lds, g, S, E); } SEAM(5);
    if (IN(6)) { mixer_mid<1>(F); } SEAM(6);
    if (IN(7)) { mixer_mid<2>(F); } SEAM(7);
    if (IN(8)) { pg8::Gemm g{F.U, F.WMO, M, D, D}; pg8::SplitOrder S; S.init(D, SPLIT_MO, F.G, (int)blockIdx.x);
        pg8::EpiResid E{F.out, F.out + (size_t)NP * D, F.out, F.mod, 5, 1.0f, F.part}; pg8::gemm_phase<pg8::EpiResid, pg8::SplitOrder, PG8_ALIGN, PG8_SP2>(F.lds, g, S, E); } SEAM(8);
    if (IN(9)) { norm_pass(F, F.out, F.out + (size_t)NP * D, F.in[24], 6, 7, SPLIT_MO); } SEAM(9);
    if (IN(10)) { pg8::Gemm g{F.XN, F.W2GU, M, 2 * FF, D}; pg8::StaticOrder S; S.init(M, 2 * FF, D, F.G, (int)blockIdx.x);
        pg8::EpiSwiglu E{F.H, FF}; pg8::gemm_phase<pg8::EpiSwiglu, pg8::StaticOrder, PG8_ALIGN, PG8_SP2>(F.lds, g, S, E); } SEAM(10);
    if (IN(11)) { pg8::Gemm g{F.H, F.W2D, M, D, FF}; pg8::SplitOrder S; S.init(FF, SPLIT_DN, F.G, (int)blockIdx.x);
        pg8::EpiResid E{F.out, F.out + (size_t)NP * D, F.out, F.mod, 8, 0.5f, F.part}; pg8::gemm_phase<pg8::EpiResid, pg8::SplitOrder, PG8_ALIGN, PG8_SP2>(F.lds, g, S, E); } SEAM(11);
    if (IN(12)) { final_norm(F, SPLIT_DN); }
#undef IN
#undef SEAM
}

extern "C" void kernel_launch(void* const* d_in, const int* in_sizes, int n_in, void* d_out, int out_size, void* d_ws, size_t ws_size, hipStream_t stream) {
    static int grid = 0;
    if (grid == 0) {
        if (n_in != 29 || in_sizes[0] != NP * D || (size_t)out_size != O_END || ws_size < WS_END) {
            fprintf(stderr, "kernel_launch: unexpected shapes: n_in %d in0 %d out %d ws %zu\n", n_in, n_in > 0 ? in_sizes[0] : -1, out_size, ws_size); grid = -1; return; }
        int dev = 0, cus = 0, per_cu = 0;
        (void)hipGetDevice(&dev); (void)hipDeviceGetAttribute(&cus, hipDeviceAttributeMultiprocessorCount, dev);
        if (hipFuncSetAttribute((const void*)fwd_kernel, hipFuncAttributeMaxDynamicSharedMemorySize, LDS_BYTES) != hipSuccess) { fprintf(stderr, "kernel_launch: hipFuncSetAttribute failed\n"); grid = -1; return; }
        if (hipOccupancyMaxActiveBlocksPerMultiprocessor(&per_cu, (const void*)fwd_kernel, NWAVES * 64, LDS_BYTES) != hipSuccess || per_cu < 1) { fprintf(stderr, "kernel_launch: occupancy query says %d\n", per_cu); per_cu = 1; }
        (void)hipGetLastError();
        grid = cus * per_cu;
        fprintf(stderr, "kernel_launch: cus %d per_cu %d grid %d\n", cus, per_cu, grid);
    }
    if (grid < 0) return;
    Args a{};
    for (int i = 0; i < 29; ++i) a.in[i] = (const float*)d_in[i];
    a.out = (float*)d_out; a.ws = (unsigned char*)d_ws;
#if MK_N_LAUNCHES == 1
    a.ph_lo = 0; a.ph_hi = N_PHASES;
    void* kargs[] = {&a};
    hipError_t e = hipLaunchCooperativeKernel((const void*)fwd_kernel, dim3(grid), dim3(NWAVES * 64), kargs, LDS_BYTES, stream);
    if (e != hipSuccess) fprintf(stderr, "kernel_launch: cooperative launch failed: %s (grid %d)\n", hipGetErrorString(e), grid);
#else
    for (int li = 0; li < N_PHASES; ++li) {
        a.ph_lo = li; a.ph_hi = li + 1;
        hipLaunchKernelGGL(fwd_kernel, dim3(grid), dim3(NWAVES * 64), LDS_BYTES, stream, a);
    }
#endif
}
```

```cpp
#include <hip/hip_runtime.h>
#include <hip/hip_cooperative_groups.h>
#include <cstdio>
#include <cstdint>
namespace cg = cooperative_groups;

#ifndef MK_N_LAUNCHES
#define MK_N_LAUNCHES 1
#endif

constexpr int D = 1024, NP = 16384, NS = 512, M = NP + NS, FF = 3072, DIN = 2560, DL = 512;
constexpr int TP = 2048, NBATCH = 136, NMOD = 9;
constexpr float EPS = 1e-6f;
__device__ __forceinline__ int row_batch(int r) { return r < NP ? (r >> 11) : 8 + ((r - NP) >> 2); }

namespace pg8 {
#define PG8_LAS __attribute__((address_space(3)))
typedef unsigned short bf16_t;
typedef short bf16x8 __attribute__((ext_vector_type(8)));
typedef float f32x4 __attribute__((ext_vector_type(4)));
typedef unsigned u32x4 __attribute__((ext_vector_type(4)));
constexpr int BM = 256, BK = 64, HALF = 128, HTB = HALF * BK * 2  , STAGE_BYTES = 8 * HTB, NXCD = 8, WGM = 8;

__host__ __device__ __forceinline__ int lds_byte(int r, int c) { const int st = (r >> 4) * 2 + (c >> 5), rr = r & 15, cc = c & 31, ob = rr * 64 + cc * 2; return st * 1024 + (ob ^ (((ob >> 9) & 1) << 5)); }
__host__ __device__ __forceinline__ void stage_rc(int b, int& R, int& C) { const int st = b / 1024, sb = b % 1024, swz = sb ^ (((sb >> 9) & 1) << 5); R = (st >> 1) * 16 + swz / 64; C = (st & 1) * 32 + (swz % 64) / 2; }
__host__ __device__ __forceinline__ int perm32(int rho) { const int n = rho >> 4, i = rho & 15; return 8 * (i >> 2) + 4 * n + (i & 3); }

struct Unit { int pm, pn, kt0, nkt, slab; };
struct Gemm { const bf16_t* A; const bf16_t* Bt; int M, N, K; };

struct StaticOrder {
    int nM, nN, nwg, G, c, nkt;
    __host__ __device__ void init(int M, int N, int K, int G_, int c_) { nM = M / BM; nN = N / BM; nwg = nM * nN; G = G_; c = c_; nkt = K / BK; }
    __host__ __device__ __forceinline__ bool next(int i, Unit& u) const {
        const long L = (long)i * G + c; if (L >= nwg) return false;
        int wgid = (int)L; { const int q = nwg / NXCD, r = nwg % NXCD, xcd = wgid % NXCD, off = wgid / NXCD; wgid = (xcd < r ? xcd * (q + 1) : r * (q + 1) + (xcd - r) * q) + off; }
        const int nig = WGM * nN, gid = wgid / nig, fm = gid * WGM, gsz = (nM - fm) < WGM ? (nM - fm) : WGM;
        u.pm = fm + ((wgid % nig) % gsz); u.pn = (wgid % nig) / gsz; u.kt0 = 0; u.nkt = nkt; u.slab = -1; return true;
    }
    __device__ __forceinline__ void a_ready(const Unit&) const {}
    __device__ __forceinline__ void done(const Unit&) const {}
};
struct SplitOrder {
    StaticOrder P; int G, c, S, nkt;
    __host__ __device__ void init(int K, int S_, int G_, int c_) { P.init(64 * BM, 4 * BM, K, 1, 0); G = G_; c = c_; S = S_; nkt = K / BK; }
    __host__ __device__ __forceinline__ bool next(int i, Unit& u) const {
        const int L = i * G + c;
        if (L >= 256 + 8 * S) return false;
        const bool pr = L < 256; const int r = L - 256, t = r & 7, s = r >> 3, ns = nkt / S;
        const int w = (L & 7) * 32 + (L >> 3);
        u.pm = pr ? ((w >> 5) * 8 + (w & 7)) : 64 + (t >> 2); u.pn = pr ? ((w & 31) >> 3) : (t & 3);
        u.kt0 = pr ? 0 : s * ns; u.nkt = pr ? nkt : ns; u.slab = pr ? -1 : s; return true;
    }
    __device__ __forceinline__ void a_ready(const Unit&) const {}
    __device__ __forceinline__ void done(const Unit&) const {}
};


__device__ __forceinline__ unsigned cvt_pk_bf16(float lo, float hi) { unsigned r; asm volatile("v_cvt_pk_bf16_f32 %0, %1, %2" : "=v"(r) : "v"(lo), "v"(hi)); return r; }
__device__ __forceinline__ float silu_f(float g) { return g * __builtin_amdgcn_rcpf(1.0f + __builtin_amdgcn_exp2f(g * -1.44269504089f)); }

struct EpiBf16 {
    static constexpr bool PERM = true, AFTER_DRAIN = false;
    bf16_t* O; int ldc;
    __device__ __forceinline__ void operator()(const f32x4 (&acc)[2][2][4][2], const Unit& u, int wr, int wc, int fr, int fq) const {
        const int row0 = u.pm * BM + wr * 64 + fr; const int col0 = u.pn * BM + wc * 32 + 8 * fq;
#pragma unroll
        for (int ai = 0; ai < 2; ++ai)
#pragma unroll
            for (int m = 0; m < 4; ++m) { bf16_t* rowp = O + (size_t)(row0 + ai * HALF + m * 16) * ldc + col0;
#pragma unroll
                for (int bj = 0; bj < 2; ++bj) { const f32x4 v0 = acc[ai][bj][m][0], v1 = acc[ai][bj][m][1];
                    u32x4 w; w.x = cvt_pk_bf16(v0[0], v0[1]); w.y = cvt_pk_bf16(v0[2], v0[3]); w.z = cvt_pk_bf16(v1[0], v1[1]); w.w = cvt_pk_bf16(v1[2], v1[3]);
                    *(u32x4*)(rowp + bj * HALF) = w; } }
    }
};
struct EpiSwiglu {
    static constexpr bool PERM = true, AFTER_DRAIN = false;
    bf16_t* O; int ldc;
    __device__ __forceinline__ void operator()(const f32x4 (&acc)[2][2][4][2], const Unit& u, int wr, int wc, int fr, int fq) const {
        const int row0 = u.pm * BM + wr * 64 + fr; const int col0 = u.pn * HALF + wc * 32 + 8 * fq;
#pragma unroll
        for (int ai = 0; ai < 2; ++ai)
#pragma unroll
            for (int m = 0; m < 4; ++m) { bf16_t* rowp = O + (size_t)(row0 + ai * HALF + m * 16) * ldc + col0;
                const f32x4 g0 = acc[ai][0][m][0], g1 = acc[ai][0][m][1], u0 = acc[ai][1][m][0], u1 = acc[ai][1][m][1];
                u32x4 w;
                w.x = cvt_pk_bf16(silu_f(g0[0]) * u0[0], silu_f(g0[1]) * u0[1]); w.y = cvt_pk_bf16(silu_f(g0[2]) * u0[2], silu_f(g0[3]) * u0[3]);
                w.z = cvt_pk_bf16(silu_f(g1[0]) * u1[0], silu_f(g1[1]) * u1[1]); w.w = cvt_pk_bf16(silu_f(g1[2]) * u1[2], silu_f(g1[3]) * u1[3]);
                *(u32x4*)rowp = w; }
    }
};
struct EpiResid {
    static constexpr bool PERM = false, AFTER_DRAIN = false;
    const float* baseP; const float* baseS; float* out; const float* mod; int idx; float fac; float* part;
    __device__ __forceinline__ void operator()(const f32x4 (&acc)[2][2][4][2], const Unit& u, int wr, int wc, int fr, int fq) const {
        const int colb = u.pn * BM + wc * 32 + 4 * fq;
        if (u.slab >= 0) {
#pragma unroll
            for (int ai = 0; ai < 2; ++ai)
#pragma unroll
                for (int m = 0; m < 4; ++m) {
                    const int r = u.pm * BM + ai * HALF + wr * 64 + m * 16 + fr;
                    const float* mp = mod + (size_t)(row_batch(r) * NMOD + idx) * D;
                    float* pp = part + ((size_t)u.slab * NS + (r - NP)) * D;
#pragma unroll
                    for (int bj = 0; bj < 2; ++bj)
#pragma unroll
                        for (int n = 0; n < 2; ++n) { const int c = colb + bj * HALF + n * 16; const f32x4 mv = *(const f32x4*)(mp + c);
                            *(f32x4*)(pp + c) = (mv * fac) * acc[ai][bj][m][n]; }
                    if (m & 1) asm volatile("" ::: "memory"); }
            return;
        }
#pragma unroll
        for (int ai = 0; ai < 2; ++ai)
#pragma unroll
            for (int m = 0; m < 4; ++m) {
                const int r = u.pm * BM + ai * HALF + wr * 64 + m * 16 + fr;
                const float* bp = (r < NP) ? baseP + (size_t)r * D : baseS + (size_t)(r - NP) * D;
                const float* mp = mod + (size_t)(row_batch(r) * NMOD + idx) * D;
                float* op = out + (size_t)r * D;
#pragma unroll
                for (int bj = 0; bj < 2; ++bj)
#pragma unroll
                    for (int n = 0; n < 2; ++n) { const int c = colb + bj * HALF + n * 16;
                        const f32x4 bs = *(const f32x4*)(bp + c); const f32x4 mv = *(const f32x4*)(mp + c);
                        *(f32x4*)(op + c) = bs + (mv * fac) * acc[ai][bj][m][n]; }
                if (m & 1) asm volatile("" ::: "memory"); }
    }
};

template <class Epi, class Sched, bool ALIGN_EPI = false, bool SP2 = false>
__device__ __forceinline__ void gemm_phase(PG8_LAS unsigned char* lds, const Gemm g, const Sched& S, const Epi& E) {
    const int tid = threadIdx.x, wid = __builtin_amdgcn_readfirstlane(tid >> 6), lane = tid & 63, wr = wid >> 2, wc = wid & 3, fr = lane & 15, fq = lane >> 4;
    const int K = g.K;
    unsigned voffA[2], voffB[2];
#pragma unroll
    for (int i = 0; i < 2; ++i) { int R, C; stage_rc(tid * 16 + i * 8192, R, C); const int Rb = Epi::PERM ? ((R & ~31) + perm32(R & 31)) : R;
        voffA[i] = (unsigned)(R * K + C) * 2u; voffB[i] = (unsigned)(Rb * K + C) * 2u; }
    const size_t kstep = (size_t)(BK * 2);
    const size_t hstep = (size_t)HALF * K * 2;
    const size_t tstep = 2 * hstep;
    const unsigned ldsw = (unsigned)wid * 1024u;
    const int aoff = lds_byte(wr * 64 + fr, fq * 8), boff = lds_byte(wc * 32 + fr, fq * 8);
#define PG8_SA(b, h) (((b) * 2 + (h)) * HTB)
#define PG8_SB(b, h) ((4 + (b) * 2 + (h)) * HTB)
#define PG8_STAGE(bufoff, gbase, voff) do { _Pragma("unroll") for (int _i = 0; _i < 2; ++_i) \
        __builtin_amdgcn_global_load_lds((const unsigned*)((const char*)(gbase) + (voff)[_i]), (PG8_LAS unsigned*)(lds + (bufoff) + ldsw + _i * 8192), 16, 0, 0); } while (0)
#define PG8_LDA(dst, b, h) do { _Pragma("unroll") for (int m = 0; m < 4; ++m) _Pragma("unroll") for (int k = 0; k < 2; ++k) dst[m][k] = *(const PG8_LAS bf16x8*)(lds + PG8_SA(b, h) + aoff + m * 2048 + k * 1024); } while (0)
#define PG8_LDB(dst, b, h) do { _Pragma("unroll") for (int n = 0; n < 2; ++n) _Pragma("unroll") for (int k = 0; k < 2; ++k) dst[n][k] = *(const PG8_LAS bf16x8*)(lds + PG8_SB(b, h) + boff + n * 2048 + k * 1024); } while (0)
#define PG8_MMA(ai, bj, At, Bt) do { __builtin_amdgcn_s_setprio(1); _Pragma("unroll") for (int m = 0; m < 4; ++m) _Pragma("unroll") for (int n = 0; n < 2; ++n) _Pragma("unroll") for (int k = 0; k < 2; ++k) \
        acc[ai][bj][m][n] = __builtin_amdgcn_mfma_f32_16x16x32_bf16(Bt[n][k], At[m][k], acc[ai][bj][m][n], 0, 0, 0); __builtin_amdgcn_s_setprio(0); } while (0)
#define PG8_WAIT_V(n) asm volatile("s_waitcnt vmcnt(" #n ")" ::: "memory")
#define PG8_WAIT_L(n) asm volatile("s_waitcnt lgkmcnt(" #n ")" ::: "memory")
#define PG8_BAR __builtin_amdgcn_s_barrier()
#define PG8_SCHED __builtin_amdgcn_sched_barrier(0)
    Unit cur, nxt; int ui = 0;
    if (!S.next(0, cur)) return;
    f32x4 acc[2][2][4][2];
#pragma unroll
    for (int a = 0; a < 2; ++a)
#pragma unroll
        for (int b = 0; b < 2; ++b)
#pragma unroll
            for (int m = 0; m < 4; ++m)
#pragma unroll
                for (int n = 0; n < 2; ++n) acc[a][b][m][n] = (f32x4){0.f, 0.f, 0.f, 0.f};
    bf16x8 At[4][2], B0[2][2], B1[2][2];
    const char* cA = (const char*)g.A + (size_t)cur.pm * tstep + (size_t)cur.kt0 * kstep; const char* cB = (const char*)g.Bt + (size_t)cur.pn * tstep + (size_t)cur.kt0 * kstep;
    S.a_ready(cur);
    if constexpr (SP2) {
        PG8_STAGE(PG8_SB(0, 0), cB, voffB); PG8_STAGE(PG8_SB(0, 1), cB + hstep, voffB); PG8_STAGE(PG8_SA(0, 0), cA, voffA); PG8_STAGE(PG8_SA(0, 1), cA + hstep, voffA);
        if (wr == 1) PG8_BAR;
        PG8_WAIT_V(2); PG8_BAR;
        PG8_STAGE(PG8_SB(1, 0), cB + kstep, voffB); PG8_STAGE(PG8_SA(1, 0), cA + kstep, voffA); PG8_STAGE(PG8_SB(1, 1), cB + hstep + kstep, voffB);
        PG8_WAIT_V(6); PG8_BAR;
    } else {
        PG8_STAGE(PG8_SB(0, 0), cB, voffB); PG8_STAGE(PG8_SA(0, 0), cA, voffA); PG8_STAGE(PG8_SB(0, 1), cB + hstep, voffB); PG8_STAGE(PG8_SA(0, 1), cA + hstep, voffA);
        if (wr == 1) PG8_BAR;
        PG8_WAIT_V(4); PG8_BAR;
        PG8_STAGE(PG8_SB(1, 0), cB + kstep, voffB); PG8_STAGE(PG8_SA(1, 0), cA + kstep, voffA); PG8_STAGE(PG8_SB(1, 1), cB + hstep + kstep, voffB);
        PG8_WAIT_V(6); PG8_BAR;
    }
    for (;;) {
        const bool has_next = S.next(ui + 1, nxt);
        const char* nA = has_next ? (const char*)g.A + (size_t)nxt.pm * tstep + (size_t)nxt.kt0 * kstep : cA; const char* nB = has_next ? (const char*)g.Bt + (size_t)nxt.pn * tstep + (size_t)nxt.kt0 * kstep : cB;
        const int nt = cur.nkt;
        for (int t = 0; t < nt; t += 2) {
            const bool last = (t == nt - 2);
            const char* a1 = cA + (size_t)(t + 1) * kstep;
            const char* a2 = last ? nA : cA + (size_t)(t + 2) * kstep; const char* b2 = last ? nB : cB + (size_t)(t + 2) * kstep;
            const char* a3 = a2 + kstep; const char* b3 = b2 + kstep;
            if (last && has_next) S.a_ready(nxt);
            if constexpr (SP2) {
            PG8_LDB(B0, 0, 0); PG8_LDB(B1, 0, 1); PG8_SCHED; PG8_LDA(At, 0, 0); PG8_STAGE(PG8_SA(1, 1), a1 + hstep, voffA);
            PG8_WAIT_V(8); PG8_WAIT_L(0); PG8_BAR; PG8_MMA(0, 0, At, B0); PG8_MMA(0, 1, At, B1); PG8_BAR; PG8_SCHED;
            PG8_LDA(At, 0, 1); PG8_STAGE(PG8_SB(0, 0), b2, voffB); PG8_STAGE(PG8_SB(0, 1), b2 + hstep, voffB); PG8_STAGE(PG8_SA(0, 0), a2, voffA);
            PG8_WAIT_V(8); PG8_WAIT_L(0); PG8_BAR; PG8_MMA(1, 0, At, B0); PG8_MMA(1, 1, At, B1); PG8_BAR; PG8_SCHED;
            PG8_LDB(B0, 1, 0); PG8_LDB(B1, 1, 1); PG8_SCHED; PG8_LDA(At, 1, 0); PG8_STAGE(PG8_SA(0, 1), a2 + hstep, voffA);
            PG8_WAIT_V(8); PG8_WAIT_L(0); PG8_BAR; PG8_MMA(0, 0, At, B0); PG8_MMA(0, 1, At, B1); PG8_BAR; PG8_SCHED;
            PG8_LDA(At, 1, 1); PG8_STAGE(PG8_SB(1, 0), b3, voffB); PG8_STAGE(PG8_SB(1, 1), b3 + hstep, voffB); PG8_STAGE(PG8_SA(1, 0), a3, voffA);
            PG8_WAIT_V(8); PG8_WAIT_L(0); PG8_BAR; PG8_MMA(1, 0, At, B0); PG8_MMA(1, 1, At, B1); PG8_BAR; PG8_SCHED;
            } else {
            PG8_LDB(B0, 0, 0); PG8_SCHED; PG8_LDA(At, 0, 0); PG8_STAGE(PG8_SA(1, 1), a1 + hstep, voffA);
            PG8_WAIT_L(8); PG8_BAR; PG8_WAIT_L(0); PG8_MMA(0, 0, At, B0); PG8_BAR; PG8_SCHED;
            PG8_LDB(B1, 0, 1); PG8_STAGE(PG8_SB(0, 0), b2, voffB);
            PG8_BAR; PG8_WAIT_L(0); PG8_MMA(0, 1, At, B1); PG8_BAR;
            PG8_LDA(At, 0, 1); PG8_STAGE(PG8_SA(0, 0), a2, voffA);
            PG8_BAR; PG8_WAIT_L(0); PG8_MMA(1, 0, At, B0); PG8_BAR; PG8_SCHED;
            PG8_STAGE(PG8_SB(0, 1), b2 + hstep, voffB);
            PG8_WAIT_V(6); PG8_BAR; PG8_MMA(1, 1, At, B1); PG8_BAR;
            PG8_LDB(B0, 1, 0); PG8_SCHED; PG8_LDA(At, 1, 0); PG8_STAGE(PG8_SA(0, 1), a2 + hstep, voffA);
            PG8_WAIT_L(8); PG8_BAR; PG8_WAIT_L(0); PG8_MMA(0, 0, At, B0); PG8_BAR; PG8_SCHED;
            PG8_LDB(B1, 1, 1); PG8_STAGE(PG8_SB(1, 0), b3, voffB);
            PG8_BAR; PG8_WAIT_L(0); PG8_MMA(0, 1, At, B1); PG8_BAR;
            PG8_LDA(At, 1, 1); PG8_STAGE(PG8_SA(1, 0), a3, voffA);
            PG8_BAR; PG8_WAIT_L(0); PG8_MMA(1, 0, At, B0); PG8_BAR; PG8_SCHED;
            PG8_STAGE(PG8_SB(1, 1), b3 + hstep, voffB);
            PG8_WAIT_V(6); PG8_BAR; PG8_MMA(1, 1, At, B1); PG8_BAR;
            }
        }
        if constexpr (ALIGN_EPI) { if (wr == 0) PG8_BAR; }
        if constexpr (!Epi::AFTER_DRAIN) { E(acc, cur, wr, wc, fr, fq); S.done(cur); }
        if (!has_next) break;
#pragma unroll
        for (int a = 0; a < 2; ++a)
#pragma unroll
            for (int b = 0; b < 2; ++b)
#pragma unroll
                for (int m = 0; m < 4; ++m)
#pragma unroll
                    for (int n = 0; n < 2; ++n) acc[a][b][m][n] = (f32x4){0.f, 0.f, 0.f, 0.f};
        cur = nxt; cA = nA; cB = nB; ++ui;
        if constexpr (ALIGN_EPI) { if (wr == 1) PG8_BAR; }
    }
    PG8_WAIT_V(0);
    if constexpr (!ALIGN_EPI) { if (wr == 0) PG8_BAR; }
    PG8_BAR;
    if constexpr (Epi::AFTER_DRAIN) { E.fused(acc, cur, wr, wc, fr, fq, lds, wid, lane); S.done(cur); }
#undef PG8_SA
#undef PG8_SB
#undef PG8_STAGE
#undef PG8_LDA
#undef PG8_LDB
#undef PG8_MMA
#undef PG8_WAIT_V
#undef PG8_WAIT_L
#undef PG8_BAR
#undef PG8_SCHED
}
}
#ifndef PG8_SP2
#define PG8_SP2 true
#endif
#ifndef PG8_ALIGN
#define PG8_ALIGN true
#endif

constexpr int NWAVES = 8;
constexpr int N_PHASES = 13;
constexpr size_t MiB = 1u << 20;
constexpr size_t WS_CTL = 0, CTL_ZERO_BYTES = 16384;
constexpr size_t WS_MOD = 1 * MiB;
constexpr size_t WS_AGG = 6 * MiB, WS_WG = 7 * MiB;
constexpr size_t WS_W1GU = 8 * MiB, WS_W1D = 20 * MiB, WS_WMI = 26 * MiB, WS_WMO = 31 * MiB, WS_W2GU = 33 * MiB, WS_W2D = 45 * MiB;
constexpr size_t WS_XN = 52 * MiB;
constexpr size_t WS_H = 86 * MiB;
constexpr size_t WS_PART = 186 * MiB;
constexpr size_t WS_END = 202 * MiB;
constexpr size_t O_YP = 0, O_YS = (size_t)NP * D, O_CP = O_YS + (size_t)NS * D, O_HP = O_CP + 8 * 3 * 512, O_SP = O_HP + 8 * 512,
                 O_CS = O_SP + 8 * 2 * 512, O_HS = O_CS + 128 * 3 * 512, O_SS = O_HS + 128 * 512, O_END = O_SS + 128 * 2 * 512;
constexpr int LDS_BYTES = 147456, MISC_OFF = LDS_BYTES - 16;

#define LAS __attribute__((address_space(3)))
typedef unsigned short bf16;
typedef unsigned v4u __attribute__((ext_vector_type(4)));
typedef float f32x4 __attribute__((ext_vector_type(4)));
typedef short bf16x8 __attribute__((ext_vector_type(8)));
#define LDS_WAIT() asm volatile("s_waitcnt lgkmcnt(0)" ::: "memory")
__device__ __forceinline__ unsigned f2bf(float f) { unsigned u = __builtin_bit_cast(unsigned, f); return (u + 0x7fffu + ((u >> 16) & 1u)) >> 16; }
__device__ __forceinline__ unsigned pk2(float lo, float hi) { return f2bf(lo) | (f2bf(hi) << 16); }
__device__ __forceinline__ float bf2f(unsigned short h) { return __builtin_bit_cast(float, (unsigned)h << 16); }
__device__ __forceinline__ float bflo(unsigned w) { return __builtin_bit_cast(float, w << 16); }
__device__ __forceinline__ float bfhi(unsigned w) { return __builtin_bit_cast(float, w & 0xffff0000u); }
__device__ __forceinline__ void unpack8(const v4u v, float (&o)[8]) { o[0] = bflo(v.x); o[1] = bfhi(v.x); o[2] = bflo(v.y); o[3] = bfhi(v.y); o[4] = bflo(v.z); o[5] = bfhi(v.z); o[6] = bflo(v.w); o[7] = bfhi(v.w); }
__device__ __forceinline__ v4u pack8(const float (&o)[8]) { v4u v; v.x = pk2(o[0], o[1]); v.y = pk2(o[2], o[3]); v.z = pk2(o[4], o[5]); v.w = pk2(o[6], o[7]); return v; }
__device__ __forceinline__ void ld8f(const float* p, float (&o)[8]) { const f32x4 a = *(const f32x4*)p, b = *(const f32x4*)(p + 4); o[0] = a.x; o[1] = a.y; o[2] = a.z; o[3] = a.w; o[4] = b.x; o[5] = b.y; o[6] = b.z; o[7] = b.w; }
__device__ __forceinline__ void st8f(float* p, const float (&o)[8]) { *(f32x4*)p = (f32x4){o[0], o[1], o[2], o[3]}; *(f32x4*)(p + 4) = (f32x4){o[4], o[5], o[6], o[7]}; }
__device__ __forceinline__ float sigmoid_f(float x) { return __builtin_amdgcn_rcpf(1.0f + __builtin_amdgcn_exp2f(x * -1.44269504089f)); }
__device__ __forceinline__ float wave_sum(float v) {
#pragma unroll
    for (int o = 1; o < 64; o <<= 1) v += __shfl_xor(v, o);
    return v;
}

#define RLX_AGENT __ATOMIC_RELAXED, __HIP_MEMORY_SCOPE_AGENT
#define XB_TMO      128
#define XB_XCNT(j)  (256  + 64 * (j))
#define XB_XSUB(j)  (1280 + 64 * (j))
#define XB_XGEN(j)  (2304 + 64 * (j))
#define XB_TOP      3328
#define XB_TOPGEN   3392
#define XCD_BAR_WORDS 3456
#define XB_SPIN_CAP (1u << 18)

__device__ __forceinline__ unsigned xb_ld(unsigned* p)              { return __hip_atomic_load(p, __ATOMIC_RELAXED, __HIP_MEMORY_SCOPE_AGENT); }
__device__ __forceinline__ unsigned xb_add(unsigned* p, unsigned v) { return __hip_atomic_fetch_add(p, v, __ATOMIC_RELAXED, __HIP_MEMORY_SCOPE_AGENT); }
__device__ __forceinline__ unsigned xb_xcc_id() { return (unsigned)__builtin_amdgcn_s_getreg((3 << 11) | 20) & 0xFu; }
#define XB_SPIN(cond, bar) do { unsigned _sp = 0; while (cond) { __builtin_amdgcn_s_sleep(1); \
    if ((++_sp & 255u) == 0u) { if (xb_ld(&(bar)[XB_TMO])) break; if (_sp > XB_SPIN_CAP) { atomicAdd(&(bar)[XB_TMO], 1u); break; } } } } while (0)

struct XcdBarrier {
    unsigned* bar; unsigned x;
    volatile LAS unsigned* st;
};

__device__ __forceinline__ XcdBarrier xcd_barrier_post(unsigned* bar, volatile LAS unsigned* st) {
    XcdBarrier b; b.bar = bar; b.x = xb_xcc_id(); b.st = st;
    if (threadIdx.x == 0) (void)xb_add(&bar[XB_XCNT(b.x)], 1u);
    return b;
}
__device__ __forceinline__ void xcd_barrier_complete(unsigned* bar, unsigned x, unsigned& nloc, unsigned& nx) {
    const unsigned G = gridDim.x * gridDim.y * gridDim.z;
    unsigned sum, cnt, mine, sp = 0u;
    for (;;) {
        sum = 0u; cnt = 0u; mine = 0u;
#pragma unroll
        for (unsigned j = 0; j < 16; ++j) { const unsigned c = xb_ld(&bar[XB_XCNT(j)]); sum += c; cnt += (c > 0u) ? 1u : 0u; mine = (j == x) ? c : mine; }
        if (sum == G) break;
        __builtin_amdgcn_s_sleep(1);
        if ((++sp & 255u) == 0u) { if (xb_ld(&bar[XB_TMO])) break; if (sp > XB_SPIN_CAP) { atomicAdd(&bar[XB_TMO], 1u); break; } }
    }
    nloc = mine > 0u ? mine : 1u; nx = cnt > 0u ? cnt : 1u;
}

__device__ __forceinline__ void xcd_barrier(const XcdBarrier& b) {
    asm volatile("s_waitcnt vmcnt(0)" ::: "memory");
    __syncthreads();
    if (threadIdx.x == 0) {
        unsigned* bar = b.bar;
        __builtin_amdgcn_s_waitcnt(0);
        unsigned nloc = b.st[0], nx = b.st[1];
        if (nloc == 0u) { xcd_barrier_complete(bar, b.x, nloc, nx); b.st[0] = nloc; b.st[1] = nx; }
        const unsigned old = xb_add(&bar[XB_XSUB(b.x)], 1u);
        const unsigned gen = old / nloc;
        if (old + 1u == (gen + 1u) * nloc) {
            __builtin_amdgcn_fence(__ATOMIC_RELEASE, "agent");
            asm volatile("s_waitcnt vmcnt(0)" ::: "memory");
            const unsigned og = xb_add(&bar[XB_TOP], 1u);
            const unsigned tg = og / nx;
            if (og + 1u == (tg + 1u) * nx) xb_add(&bar[XB_TOPGEN], 1u);
            else XB_SPIN(xb_ld(&bar[XB_TOPGEN]) == tg, bar);
            __builtin_amdgcn_fence(__ATOMIC_ACQUIRE, "agent");
            xb_add(&bar[XB_XGEN(b.x)], 1u);
            asm volatile("s_waitcnt vmcnt(0)" ::: "memory");
        } else {
            XB_SPIN(xb_ld(&bar[XB_XGEN(b.x)]) == gen, bar);
            __builtin_amdgcn_fence(__ATOMIC_ACQUIRE, "agent");
            asm volatile("s_waitcnt vmcnt(0)" ::: "memory");
        }
    }
    __syncthreads();
}

struct Frame {
    LAS unsigned char* lds;
    int tid, lane, wave, G;
    const float* in[29];
    float* out;
    float* mod; float* agg; float* part;
    bf16 *W1GU, *W1D, *WMI, *WMO, *W2GU, *W2D, *XN, *U, *H, *Z, *WG;
};

__device__ __forceinline__ void p0_transpose_item(const float* W, int K, int N, bf16* WT, int mode, LAS float* scr, int item, int lane) {
    const int nblk = N / 32, kb = item / nblk, nb = item % nblk, k0 = 64 * kb, n0 = 32 * nb;
    const int rbase = (mode == 0) ? n0 : (256 * (n0 >> 7) + (n0 & 127) + (mode == 2 ? 128 : 0));
#pragma unroll 8
    for (int i = 0; i < 32; ++i) { const int kk = 2 * i + (lane >> 5); scr[kk * 33 + (lane & 31)] = W[(size_t)(k0 + kk) * N + n0 + (lane & 31)]; }
    LDS_WAIT(); asm volatile("" ::: "memory");
    const int c = lane & 7;
#pragma unroll
    for (int j = 0; j < 4; ++j) { const int n = (lane >> 3) + 8 * j; const LAS float* s = scr + (8 * c) * 33 + n;
        v4u o; o.x = pk2(s[0 * 33], s[1 * 33]); o.y = pk2(s[2 * 33], s[3 * 33]); o.z = pk2(s[4 * 33], s[5 * 33]); o.w = pk2(s[6 * 33], s[7 * 33]);
        *(v4u*)(WT + (size_t)(rbase + n) * K + k0 + 8 * c) = o; }
    LDS_WAIT(); asm volatile("" ::: "memory");
}
__device__ __forceinline__ void p0_prologue(Frame& F) {
    {
        const float* cP = F.in[5]; const float* cS = F.in[6]; const float* wada = F.in[7]; const float* bada = F.in[8];
        const int fr = F.lane & 15, fq = F.lane >> 4, w = F.wave;
        LAS float* red = (LAS float*)F.lds;
        for (int it = blockIdx.x; it < 576; it += F.G) {
            const int n0 = it * 16;
            f32x4 acc[9];
#pragma unroll
            for (int mt = 0; mt < 9; ++mt) acc[mt] = (f32x4){0.f, 0.f, 0.f, 0.f};
#pragma unroll 1
            for (int kk = 0; kk < 4; ++kk) {
                const int k0 = 128 * w + 32 * kk + 8 * fq;
                float bv[8];
#pragma unroll
                for (int j = 0; j < 8; ++j) bv[j] = wada[(size_t)(k0 + j) * (NMOD * D) + n0 + fr];
                const v4u bp = pack8(bv); const bf16x8 bfrag = __builtin_bit_cast(bf16x8, bp);
#pragma unroll
                for (int mt = 0; mt < 9; ++mt) {
                    const int row = 16 * mt + fr;
                    float av[8];
                    if (row < NBATCH) { const float* cp = (row < 8) ? cP + (size_t)row * D : cS + (size_t)(row - 8) * D; ld8f(cp + k0, av);
#pragma unroll
                        for (int j = 0; j < 8; ++j) av[j] = av[j] * sigmoid_f(av[j]); }
                    else {
#pragma unroll
                        for (int j = 0; j < 8; ++j) av[j] = 0.f; }
                    const v4u ap = pack8(av); const bf16x8 afrag = __builtin_bit_cast(bf16x8, ap);
                    acc[mt] = __builtin_amdgcn_mfma_f32_16x16x32_bf16(afrag, bfrag, acc[mt], 0, 0, 0);
                }
            }
#pragma unroll
            for (int mt = 0; mt < 9; ++mt)
#pragma unroll
                for (int i = 0; i < 4; ++i) red[(w * 144 + 16 * mt + 4 * fq + i) * 16 + fr] = acc[mt][i];
            __syncthreads();
            for (int o = F.tid; o < NBATCH * 16; o += NWAVES * 64) {
                const int row = o >> 4, c = o & 15; float s = bada[n0 + c];
#pragma unroll
                for (int ww = 0; ww < 8; ++ww) s += red[(ww * 144 + row) * 16 + c];
                F.mod[(size_t)row * (NMOD * D) + n0 + c] = s;
            }
            __syncthreads();
        }
    }
    LAS float* scr = (LAS float*)(F.lds + F.wave * 16384);
    const int gw = blockIdx.x * NWAVES + F.wave, NGW = F.G * NWAVES;
    constexpr int I_GU = (D / 64) * (FF / 32), I_DN = (FF / 64) * (D / 32), I_MI = (D / 64) * (DIN / 32), I_MO = (D / 64) * (D / 32);
    constexpr int NITEMS = 6 * I_GU + I_MI + I_MO;
    static_assert(I_GU == I_DN, "item counts");
    for (int it = gw; it < NITEMS; it += NGW) {
        int r = it;
        if (r < I_GU) { p0_transpose_item(F.in[10], D, FF, F.W1GU, 1, scr, r, F.lane); continue; } r -= I_GU;
        if (r < I_GU) { p0_transpose_item(F.in[11], D, FF, F.W1GU, 2, scr, r, F.lane); continue; } r -= I_GU;
        if (r < I_DN) { p0_transpose_item(F.in[12], FF, D, F.W1D, 0, scr, r, F.lane); continue; } r -= I_DN;
        if (r < I_MI) { p0_transpose_item(F.in[14], D, DIN, F.WMI, 0, scr, r, F.lane); continue; } r -= I_MI;
        if (r < I_MO) { p0_transpose_item(F.in[23], D, D, F.WMO, 0, scr, r, F.lane); continue; } r -= I_MO;
        if (r < I_GU) { p0_transpose_item(F.in[25], D, FF, F.W2GU, 1, scr, r, F.lane); continue; } r -= I_GU;
        if (r < I_GU) { p0_transpose_item(F.in[26], D, FF, F.W2GU, 2, scr, r, F.lane); continue; } r -= I_GU;
        p0_transpose_item(F.in[27], FF, D, F.W2D, 0, scr, r, F.lane);
    }
    for (int o = blockIdx.x * (NWAVES * 64) + F.tid; o < 2 * 32768; o += F.G * NWAVES * 64) {
        const int g = o >> 15, r = o & 32767, h = r >> 12, n = (r >> 6) & 63, k = r & 63;
        const float* w = g ? F.in[19] : F.in[17];
        F.WG[o] = (bf16)f2bf(w[(h * 64 + k) * 64 + n]);
    }
}

__device__ __forceinline__ void norm_pass(Frame& F, const float* srcP, const float* srcS, const float* gain, int ishift, int iscale, int nsplit) {
    const int gw = blockIdx.x * NWAVES + F.wave, NGW = F.G * NWAVES;
    for (int m = gw; m < M; m += NGW) {
        const float* xrow = (m < NP) ? srcP + (size_t)m * D : srcS + (size_t)(m - NP) * D;
        const int b = row_batch(m);
        const f32x4* xr = (const f32x4*)xrow + F.lane;
        const f32x4* gr = (const f32x4*)gain + F.lane;
        const f32x4* sh = (const f32x4*)(F.mod + (size_t)(b * NMOD + ishift) * D) + F.lane;
        const f32x4* sc = (const f32x4*)(F.mod + (size_t)(b * NMOD + iscale) * D) + F.lane;
        f32x4 v[4]; float s = 0.f;
#pragma unroll
        for (int j = 0; j < 4; ++j) v[j] = xr[64 * j];
        if (m >= NP && nsplit > 0) {
            for (int sp = 0; sp < nsplit; ++sp) { const f32x4* pr = (const f32x4*)(F.part + ((size_t)sp * NS + (m - NP)) * D) + F.lane;
#pragma unroll
                for (int j = 0; j < 4; ++j) v[j] += pr[64 * j]; }
            f32x4* orow = (f32x4*)(F.out + (size_t)m * D) + F.lane;
#pragma unroll
            for (int j = 0; j < 4; ++j) orow[64 * j] = v[j];
        }
#pragma unroll
        for (int j = 0; j < 4; ++j) s += (v[j].x * v[j].x + v[j].y * v[j].y) + (v[j].z * v[j].z + v[j].w * v[j].w);
        const float rstd = 1.0f / sqrtf(wave_sum(s) * (1.f / D) + EPS);
        unsigned long long* o8 = (unsigned long long*)(F.XN + (size_t)m * D) + F.lane;
#pragma unroll
        for (int j = 0; j < 4; ++j) { const f32x4 g = gr[64 * j], a = sh[64 * j], c = sc[64 * j];
            const f32x4 o = (v[j] * rstd) * g * (c + 1.0f) + a;
            o8[64 * j] = (unsigned long long)pk2(o.x, o.y) | ((unsigned long long)pk2(o.z, o.w) << 32); }
    }
}
__device__ __forceinline__ void final_norm(Frame& F, int nsplit) {
    const int gw = blockIdx.x * NWAVES + F.wave, NGW = F.G * NWAVES;
    const f32x4* gr = (const f32x4*)F.in[28] + F.lane;
    for (int m = gw; m < M; m += NGW) {
        f32x4* xr = (f32x4*)(F.out + (size_t)m * D) + F.lane;
        f32x4 v[4]; float s = 0.f;
#pragma unroll
        for (int j = 0; j < 4; ++j) v[j] = xr[64 * j];
        if (m >= NP) {
            for (int sp = 0; sp < nsplit; ++sp) { const f32x4* pr = (const f32x4*)(F.part + ((size_t)sp * NS + (m - NP)) * D) + F.lane;
#pragma unroll
                for (int j = 0; j < 4; ++j) v[j] += pr[64 * j]; }
        }
#pragma unroll
        for (int j = 0; j < 4; ++j) s += (v[j].x * v[j].x + v[j].y * v[j].y) + (v[j].z * v[j].z + v[j].w * v[j].w);
        const float rstd = 1.0f / sqrtf(wave_sum(s) * (1.f / D) + EPS);
#pragma unroll
        for (int j = 0; j < 4; ++j) xr[64 * j] = (v[j] * rstd) * gr[64 * j];
    }
}

#ifndef NEG_EXPM1
#define NEG_EXPM1(x) (-expm1f(x))
#endif
constexpr int RS = 1040;
constexpr int XL_OFF = 0, XC_OFF = 67 * RS;
static_assert(XC_OFF % 16 == 0 && XC_OFF + 64 * RS <= LDS_BYTES, "mixer LDS map");
template <int PASS>
__device__ __forceinline__ void mixer_mid(Frame& F) {
    const int tid = F.tid, lane = F.lane, fr = lane & 15, fq = lane >> 4;
    LAS unsigned char* lds = F.lds;
    const bf16* Z = F.Z;
    const float* st_conv = F.in[2]; const float* st_h = F.in[3]; const float* st_sc = F.in[4];
    for (int unit = blockIdx.x; unit < 264; unit += F.G) {
        const bool samp = unit >= 256;
        const int row0 = unit * 64;
        const int b = unit >> 5, chunk = unit & 31;
        const int seq0 = (unit - 256) * 16;
        if (PASS == 1) {
            const int ch0 = (tid & 63) * 8, r = tid >> 6;
            const float* wsc = F.in[22];
            float w0[8], w1[8], w2[8]; ld8f(wsc + ch0, w0); ld8f(wsc + 512 + ch0, w1); ld8f(wsc + 1024 + ch0, w2);
            float u2[8], u1[8];
#pragma unroll
            for (int j = 0; j < 8; ++j) { u2[j] = 0.f; u1[j] = 0.f; }
            if (!samp && (r > 0 || chunk > 0)) {
                const bf16* zr = Z + (size_t)(row0 + 8 * r - 2) * DIN + ch0;
                float c[8], v[8];
                unpack8(*(const v4u*)(zr + 1536), c); unpack8(*(const v4u*)(zr + 2048), v);
#pragma unroll
                for (int j = 0; j < 8; ++j) u2[j] = c[j] * v[j];
                unpack8(*(const v4u*)(zr + DIN + 1536), c); unpack8(*(const v4u*)(zr + DIN + 2048), v);
#pragma unroll
                for (int j = 0; j < 8; ++j) u1[j] = c[j] * v[j];
            }
#pragma unroll
            for (int t = 0; t < 8; ++t) {
                const int tok = 8 * r + t; const int seq = seq0 + (tok >> 2);
                if (samp && (t & 3) == 0) { ld8f(st_sc + (size_t)(seq * 2 + 0) * 512 + ch0, u2); ld8f(st_sc + (size_t)(seq * 2 + 1) * 512 + ch0, u1); }
                const bf16* zr = Z + (size_t)(row0 + tok) * DIN + ch0;
                float bs[8], c[8], v[8], u0[8], o[8];
                unpack8(*(const v4u*)(zr + 1024), bs); unpack8(*(const v4u*)(zr + 1536), c); unpack8(*(const v4u*)(zr + 2048), v);
#pragma unroll
                for (int j = 0; j < 8; ++j) { u0[j] = c[j] * v[j]; o[j] = bs[j] * (w0[j] * u2[j] + w1[j] * u1[j] + w2[j] * u0[j]); }
                *(v4u*)(F.U + (size_t)(row0 + tok) * D + 512 + ch0) = pack8(o);
                if (samp) { if ((t & 3) >= 2) st8f(F.out + O_SS + (size_t)(seq * 2 + ((t & 3) - 2)) * 512 + ch0, u0); }
                else if (chunk == 31 && tok >= 62) st8f(F.out + O_SP + (size_t)(b * 2 + (tok - 62)) * 512 + ch0, u0);
#pragma unroll
                for (int j = 0; j < 8; ++j) { u2[j] = u1[j]; u1[j] = u0[j]; }
            }
            if (samp) continue;
        }
        for (int p = tid; p < 67 * 64; p += NWAVES * 64) {
            const int hr = p >> 6, c16 = p & 63, tok = hr - 3;
            v4u v = (v4u){0u, 0u, 0u, 0u};
            const bool valid = samp ? (tok >= 0) : (tok >= 0 || chunk > 0);
            if (valid) v = *(const v4u*)(Z + (size_t)(row0 + tok) * DIN + c16 * 8);
            *(LAS v4u*)(lds + XL_OFF + hr * RS + c16 * 16) = v;
        }
        __syncthreads();
        {
            const int ch0 = (tid & 63) * 8, r = tid >> 6;
            const float* wc = F.in[15]; const float* bc = F.in[16];
            float w0[8], w1[8], w2[8], w3[8], bb[8];
            ld8f(wc + ch0, w0); ld8f(wc + 512 + ch0, w1); ld8f(wc + 1024 + ch0, w2); ld8f(wc + 1536 + ch0, w3); ld8f(bc + ch0, bb);
            float x3[8], x2[8], x1[8];
            unpack8(*(const LAS v4u*)(lds + XL_OFF + (8 * r + 0) * RS + ch0 * 2), x3);
            unpack8(*(const LAS v4u*)(lds + XL_OFF + (8 * r + 1) * RS + ch0 * 2), x2);
            unpack8(*(const LAS v4u*)(lds + XL_OFF + (8 * r + 2) * RS + ch0 * 2), x1);
#pragma unroll
            for (int t = 0; t < 8; ++t) {
                const int tok = 8 * r + t; const int seq = seq0 + (tok >> 2);
                if (samp && (t & 3) == 0) { ld8f(st_conv + (size_t)(seq * 3 + 0) * 512 + ch0, x3); ld8f(st_conv + (size_t)(seq * 3 + 1) * 512 + ch0, x2); ld8f(st_conv + (size_t)(seq * 3 + 2) * 512 + ch0, x1); }
                float x0[8], o[8];
                unpack8(*(const LAS v4u*)(lds + XL_OFF + (tok + 3) * RS + ch0 * 2), x0);
#pragma unroll
                for (int j = 0; j < 8; ++j) o[j] = bb[j] + w3[j] * x0[j] + w2[j] * x1[j] + w1[j] * x2[j] + w0[j] * x3[j];
                *(LAS v4u*)(lds + XC_OFF + tok * RS + ch0 * 2) = pack8(o);
                if (PASS == 2) {
                    if (samp) { if ((t & 3) >= 1) st8f(F.out + O_CS + (size_t)(seq * 3 + ((t & 3) - 1)) * 512 + ch0, x0); }
                    else if (chunk == 31 && tok >= 61) st8f(F.out + O_CP + (size_t)(b * 3 + (tok - 61)) * 512 + ch0, x0);
                }
#pragma unroll
                for (int j = 0; j < 8; ++j) { x3[j] = x2[j]; x2[j] = x1[j]; x1[j] = x0[j]; }
            }
        }
        __syncthreads();
        if (PASS == 2) {
            for (int p = tid; p < 64 * 64; p += NWAVES * 64) {
                const int tok = p >> 6, c16 = p & 63;
                *(LAS v4u*)(lds + XL_OFF + tok * RS + c16 * 16) = *(const v4u*)(Z + (size_t)(row0 + tok) * DIN + 512 + c16 * 8);
            }
            __syncthreads();
        }
        {
            const int chb = 64 * F.wave;
            const bf16* wga = F.WG + (size_t)F.wave * 4096; const bf16* wgx = F.WG + 32768 + (size_t)F.wave * 4096;
            bf16x8 wa[4][2], wx[4][2];
#pragma unroll
            for (int nt = 0; nt < 4; ++nt)
#pragma unroll
                for (int kk = 0; kk < 2; ++kk) { const int o = (16 * nt + fr) * 64 + 32 * kk + 8 * fq;
                    wa[nt][kk] = *(const bf16x8*)(wga + o); wx[nt][kk] = *(const bf16x8*)(wgx + o); }
            float ba[4], bx[4], cl[4], hc[4], Ac[4];
#pragma unroll
            for (int nt = 0; nt < 4; ++nt) { const int ch = chb + 16 * nt + fr; ba[nt] = F.in[18][ch]; bx[nt] = F.in[20][ch];
                cl[nt] = -8.0f * log1pf(__expf(-F.in[21][ch])); hc[nt] = 0.f; Ac[nt] = 1.f; }
            if (PASS == 2 && !samp) {
                for (int jc = 0; jc < chunk; ++jc) {
#pragma unroll
                    for (int nt = 0; nt < 4; ++nt) { const int ch = chb + 16 * nt + fr; const float* ap = F.agg + (size_t)((b * 32 + jc) * 2) * 512 + ch;
                        hc[nt] = ap[0] * hc[nt] + ap[512]; }
                }
            }
#pragma unroll 1
            for (int mt = 0; mt < 4; ++mt) {
                bf16x8 xa[2];
#pragma unroll
                for (int kk = 0; kk < 2; ++kk) xa[kk] = *(const LAS bf16x8*)(lds + XC_OFF + (16 * mt + fr) * RS + (chb + 32 * kk + 8 * fq) * 2);
                f32x4 accA[4], accX[4];
#pragma unroll
                for (int nt = 0; nt < 4; ++nt) { accA[nt] = (f32x4){0.f, 0.f, 0.f, 0.f}; accX[nt] = (f32x4){0.f, 0.f, 0.f, 0.f};
#pragma unroll
                    for (int kk = 0; kk < 2; ++kk) { accA[nt] = __builtin_amdgcn_mfma_f32_16x16x32_bf16(xa[kk], wa[nt][kk], accA[nt], 0, 0, 0);
                        accX[nt] = __builtin_amdgcn_mfma_f32_16x16x32_bf16(xa[kk], wx[nt][kk], accX[nt], 0, 0, 0); } }
#pragma unroll
                for (int nt = 0; nt < 4; ++nt) {
                    const int ch = chb + 16 * nt + fr;
                    float P[4], Hh[4];
#pragma unroll
                    for (int i = 0; i < 4; ++i) {
                        const int tok = 16 * mt + 4 * fq + i;
                        const float xcv = bf2f(*(const LAS unsigned short*)(lds + XC_OFF + tok * RS + ch * 2));
                        const float rg = sigmoid_f(accA[nt][i] + ba[nt]), ig = sigmoid_f(accX[nt][i] + bx[nt]);
                        const float la = cl[nt] * rg;
                        const float a = __expf(la), mult = sqrtf(NEG_EXPM1(2.0f * la));
                        const float bvv = mult * (ig * xcv);
                        if (i == 0) { P[0] = a; Hh[0] = bvv; } else { P[i] = a * P[i - 1]; Hh[i] = a * Hh[i - 1] + bvv; }
                    }
                    float hin;
                    if (samp) { hin = st_h[(size_t)(seq0 + 4 * mt + fq) * 512 + ch]; }
                    else {
                        float Ai = P[3], Bi = Hh[3];
                        float Au = __shfl_up(Ai, 16), Bu = __shfl_up(Bi, 16);
                        if (fq >= 1) { Bi = Ai * Bu + Bi; Ai = Au * Ai; }
                        Au = __shfl_up(Ai, 32); Bu = __shfl_up(Bi, 32);
                        if (fq >= 2) { Bi = Ai * Bu + Bi; Ai = Au * Ai; }
                        float Ae = __shfl_up(Ai, 16), Be = __shfl_up(Bi, 16);
                        if (fq == 0) { Ae = 1.f; Be = 0.f; }
                        hin = Ae * hc[nt] + Be;
                        const float At = __shfl(Ai, fr + 48), Bt = __shfl(Bi, fr + 48);
                        hc[nt] = At * hc[nt] + Bt;
                        if (PASS == 1) Ac[nt] *= At;
                    }
                    if (PASS == 2) {
                        float hv[4];
#pragma unroll
                        for (int i = 0; i < 4; ++i) {
                            const int tok = 16 * mt + 4 * fq + i;
                            hv[i] = P[i] * hin + Hh[i];
                            const float g = bf2f(*(const LAS unsigned short*)(lds + XL_OFF + tok * RS + ch * 2));
                            const float y2 = 1.5957691216f * (g + 0.044715f * g * g * g);
                            const float o = hv[i] * (g * sigmoid_f(y2));
                            *(LAS unsigned short*)(lds + XC_OFF + tok * RS + ch * 2) = (unsigned short)f2bf(o);
                        }
                        if (samp) F.out[O_HS + (size_t)(seq0 + 4 * mt + fq) * 512 + ch] = hv[3];
                        else if (chunk == 31 && mt == 3 && fq == 3) F.out[O_HP + (size_t)b * 512 + ch] = hv[3];
                    }
                }
            }
            if (PASS == 1 && fq == 0) {
#pragma unroll
                for (int nt = 0; nt < 4; ++nt) { const int ch = chb + 16 * nt + fr; float* ap = F.agg + (size_t)((b * 32 + chunk) * 2) * 512 + ch; ap[0] = Ac[nt]; ap[512] = hc[nt]; }
            }
        }
        __syncthreads();
        if (PASS == 2) {
            for (int p = tid; p < 64 * 64; p += NWAVES * 64) {
                const int tok = p >> 6, c16 = p & 63;
                *(v4u*)(F.U + (size_t)(row0 + tok) * D + c16 * 8) = *(const LAS v4u*)(lds + XC_OFF + tok * RS + c16 * 16);
            }
        }
    }
}

struct Args { const float* in[29]; float* out; unsigned char* ws; int ph_lo, ph_hi; };
__global__ void __launch_bounds__(NWAVES * 64, 2) fwd_kernel(Args args) {
    extern __shared__ __attribute__((aligned(16))) unsigned char lds_raw[];
    Frame F;
    F.lds = (LAS unsigned char*)lds_raw;
    F.tid = threadIdx.x; F.lane = F.tid & 63; F.wave = __builtin_amdgcn_readfirstlane(F.tid >> 6); F.G = gridDim.x;
#pragma unroll
    for (int i = 0; i < 29; ++i) F.in[i] = args.in[i];
    F.out = args.out;
    unsigned char* ws = args.ws;
    F.mod = (float*)(ws + WS_MOD); F.agg = (float*)(ws + WS_AGG); F.part = (float*)(ws + WS_PART);
    F.W1GU = (bf16*)(ws + WS_W1GU); F.W1D = (bf16*)(ws + WS_W1D); F.WMI = (bf16*)(ws + WS_WMI); F.WMO = (bf16*)(ws + WS_WMO); F.W2GU = (bf16*)(ws + WS_W2GU); F.W2D = (bf16*)(ws + WS_W2D);
    F.WG = (bf16*)(ws + WS_WG); F.XN = (bf16*)(ws + WS_XN); F.U = F.XN; F.H = (bf16*)(ws + WS_H); F.Z = F.H;
    if (F.tid < 4) ((LAS unsigned*)(F.lds + MISC_OFF))[F.tid] = 0u;
    __syncthreads();
    XcdBarrier bar = xcd_barrier_post((unsigned*)(ws + WS_CTL), (volatile LAS unsigned*)(F.lds + MISC_OFF));
    const int lo = args.ph_lo, hi = args.ph_hi;
#ifndef PH_MASK
#define PH_MASK 0x1FFF
#endif
#define IN(k) (((PH_MASK >> (k)) & 1) && lo <= (k) && (k) < hi)
#ifndef REP_MASK
#define REP_MASK 0
#endif
#define REP(k) for (int rep_ = 0; rep_ < (((REP_MASK) >> (k)) & 1) + 1; ++rep_) if (rep_ == 0 || (xcd_barrier(bar), true))
#define SEAM(k) do { if (IN(k) && IN((k) + 1)) { if ((k) == 0) cg::this_grid().sync(); else xcd_barrier(bar); } } while (0)

    constexpr int SPLIT_DN = 8, SPLIT_MO = 4;
    if (IN(0)) REP(0) { p0_prologue(F); } SEAM(0);
    if (IN(1)) REP(1) { norm_pass(F, F.in[0], F.in[1], F.in[9], 0, 1, 0); } SEAM(1);
    if (IN(2)) REP(2) { pg8::Gemm g{F.XN, F.W1GU, M, 2 * FF, D}; pg8::StaticOrder S; S.init(M, 2 * FF, D, F.G, (int)blockIdx.x);
        pg8::EpiSwiglu E{F.H, FF}; pg8::gemm_phase<pg8::EpiSwiglu, pg8::StaticOrder, PG8_ALIGN, PG8_SP2>(F.lds, g, S, E); } SEAM(2);
    if (IN(3)) REP(3) { pg8::Gemm g{F.H, F.W1D, M, D, FF}; pg8::SplitOrder S; S.init(FF, SPLIT_DN, F.G, (int)blockIdx.x);
        pg8::EpiResid E{F.in[0], F.in[1], F.out, F.mod, 2, 0.5f, F.part}; pg8::gemm_phase<pg8::EpiResid, pg8::SplitOrder, PG8_ALIGN, PG8_SP2>(F.lds, g, S, E); } SEAM(3);
    if (IN(4)) REP(4) { norm_pass(F, F.out, F.in[1], F.in[13], 3, 4, SPLIT_DN); } SEAM(4);
    if (IN(5)) REP(5) { pg8::Gemm g{F.XN, F.WMI, M, DIN, D}; pg8::StaticOrder S; S.init(M, DIN, D, F.G, (int)blockIdx.x);
        pg8::EpiBf16 E{F.Z, DIN}; pg8::gemm_phase<pg8::EpiBf16, pg8::StaticOrder, PG8_ALIGN, PG8_SP2>(F.lds, g, S, E); } SEAM(5);
    if (IN(6)) REP(6) { mixer_mid<1>(F); } SEAM(6);
    if (IN(7)) REP(7) { mixer_mid<2>(F); } SEAM(7);
    if (IN(8)) REP(8) { pg8::Gemm g{F.U, F.WMO, M, D, D}; pg8::SplitOrder S; S.init(D, SPLIT_MO, F.G, (int)blockIdx.x);
        pg8::EpiResid E{F.out, F.out + (size_t)NP * D, F.out, F.mod, 5, 1.0f, F.part}; pg8::gemm_phase<pg8::EpiResid, pg8::SplitOrder, PG8_ALIGN, PG8_SP2>(F.lds, g, S, E); } SEAM(8);
    if (IN(9)) REP(9) { norm_pass(F, F.out, F.out + (size_t)NP * D, F.in[24], 6, 7, SPLIT_MO); } SEAM(9);
    if (IN(10)) REP(10) { pg8::Gemm g{F.XN, F.W2GU, M, 2 * FF, D}; pg8::StaticOrder S; S.init(M, 2 * FF, D, F.G, (int)blockIdx.x);
        pg8::EpiSwiglu E{F.H, FF}; pg8::gemm_phase<pg8::EpiSwiglu, pg8::StaticOrder, PG8_ALIGN, PG8_SP2>(F.lds, g, S, E); } SEAM(10);
    if (IN(11)) REP(11) { pg8::Gemm g{F.H, F.W2D, M, D, FF}; pg8::SplitOrder S; S.init(FF, SPLIT_DN, F.G, (int)blockIdx.x);
        pg8::EpiResid E{F.out, F.out + (size_t)NP * D, F.out, F.mod, 8, 0.5f, F.part}; pg8::gemm_phase<pg8::EpiResid, pg8::SplitOrder, PG8_ALIGN, PG8_SP2>(F.lds, g, S, E); } SEAM(11);
    if (IN(12)) REP(12) { final_norm(F, SPLIT_DN); }
#undef IN
#undef SEAM
}

extern "C" void kernel_launch(void* const* d_in, const int* in_sizes, int n_in, void* d_out, int out_size, void* d_ws, size_t ws_size, hipStream_t stream) {
    static int grid = 0;
    if (grid == 0) {
        if (n_in != 29 || in_sizes[0] != NP * D || (size_t)out_size != O_END || ws_size < WS_END) {
            fprintf(stderr, "kernel_launch: unexpected shapes: n_in %d in0 %d out %d ws %zu\n", n_in, n_in > 0 ? in_sizes[0] : -1, out_size, ws_size); grid = -1; return; }
        int dev = 0, cus = 0, per_cu = 0;
        (void)hipGetDevice(&dev); (void)hipDeviceGetAttribute(&cus, hipDeviceAttributeMultiprocessorCount, dev);
        if (hipFuncSetAttribute((const void*)fwd_kernel, hipFuncAttributeMaxDynamicSharedMemorySize, LDS_BYTES) != hipSuccess) { fprintf(stderr, "kernel_launch: hipFuncSetAttribute failed\n"); grid = -1; return; }
        if (hipOccupancyMaxActiveBlocksPerMultiprocessor(&per_cu, (const void*)fwd_kernel, NWAVES * 64, LDS_BYTES) != hipSuccess || per_cu < 1) { fprintf(stderr, "kernel_launch: occupancy query says %d\n", per_cu); per_cu = 1; }
        (void)hipGetLastError();
        grid = cus * per_cu;
        fprintf(stderr, "kernel_launch: cus %d per_cu %d grid %d\n", cus, per_cu, grid);
    }
    if (grid < 0) return;
    if (hipMemsetAsync((char*)d_ws + WS_CTL, 0, CTL_ZERO_BYTES, stream) != hipSuccess) { fprintf(stderr, "kernel_launch: memset failed\n"); return; }
    Args a{};
    for (int i = 0; i < 29; ++i) a.in[i] = (const float*)d_in[i];
    a.out = (float*)d_out; a.ws = (unsigned char*)d_ws;
#if MK_N_LAUNCHES == 1
    a.ph_lo = 0; a.ph_hi = N_PHASES;
    void* kargs[] = {&a};
    hipError_t e = hipLaunchCooperativeKernel((const void*)fwd_kernel, dim3(grid), dim3(NWAVES * 64), kargs, LDS_BYTES, stream);
    if (e != hipSuccess) fprintf(stderr, "kernel_launch: cooperative launch failed: %s (grid %d)\n", hipGetErrorString(e), grid);
#else
    for (int li = 0; li < N_PHASES; ++li) {
        a.ph_lo = li; a.ph_hi = li + 1;
        hipLaunchKernelGGL(fwd_kernel, dim3(grid), dim3(NWAVES * 64), LDS_BYTES, stream, a);
    }
#endif
}
```

```cpp
#include <hip/hip_runtime.h>
#include <hip/hip_cooperative_groups.h>
#include <cstdio>
#include <cstdint>
namespace cg = cooperative_groups;

#ifndef MK_N_LAUNCHES
#define MK_N_LAUNCHES 1
#endif

constexpr int D = 1024, NP = 16384, NS = 512, M = NP + NS, FF = 3072, DIN = 2560, DL = 512;
constexpr int TP = 2048, NBATCH = 136, NMOD = 9;
constexpr float EPS = 1e-6f;
__device__ __forceinline__ int row_batch(int r) { return r < NP ? (r >> 11) : 8 + ((r - NP) >> 2); }

namespace pg8 {
#define PG8_LAS __attribute__((address_space(3)))
typedef unsigned short bf16_t;
typedef short bf16x8 __attribute__((ext_vector_type(8)));
typedef float f32x4 __attribute__((ext_vector_type(4)));
typedef unsigned u32x4 __attribute__((ext_vector_type(4)));
constexpr int BM = 256, BK = 64, HALF = 128, HTB = HALF * BK * 2  , STAGE_BYTES = 8 * HTB, NXCD = 8, WGM = 8;

__host__ __device__ __forceinline__ int lds_byte(int r, int c) { const int st = (r >> 4) * 2 + (c >> 5), rr = r & 15, cc = c & 31, ob = rr * 64 + cc * 2; return st * 1024 + (ob ^ (((ob >> 9) & 1) << 5)); }
__host__ __device__ __forceinline__ void stage_rc(int b, int& R, int& C) { const int st = b / 1024, sb = b % 1024, swz = sb ^ (((sb >> 9) & 1) << 5); R = (st >> 1) * 16 + swz / 64; C = (st & 1) * 32 + (swz % 64) / 2; }
__host__ __device__ __forceinline__ int perm32(int rho) { const int n = rho >> 4, i = rho & 15; return 8 * (i >> 2) + 4 * n + (i & 3); }

struct Unit { int pm, pn, kt0, nkt, slab; };
struct Gemm { const bf16_t* A; const bf16_t* Bt; int M, N, K; };

struct StaticOrder {
    int nM, nN, nwg, G, c, nkt;
    __host__ __device__ void init(int M, int N, int K, int G_, int c_) { nM = M / BM; nN = N / BM; nwg = nM * nN; G = G_; c = c_; nkt = K / BK; }
    __host__ __device__ __forceinline__ bool next(int i, Unit& u) const {
        const long L = (long)i * G + c; if (L >= nwg) return false;
        int wgid = (int)L; { const int q = nwg / NXCD, r = nwg % NXCD, xcd = wgid % NXCD, off = wgid / NXCD; wgid = (xcd < r ? xcd * (q + 1) : r * (q + 1) + (xcd - r) * q) + off; }
        const int nig = WGM * nN, gid = wgid / nig, fm = gid * WGM, gsz = (nM - fm) < WGM ? (nM - fm) : WGM;
        u.pm = fm + ((wgid % nig) % gsz); u.pn = (wgid % nig) / gsz; u.kt0 = 0; u.nkt = nkt; u.slab = -1; return true;
    }
    __device__ __forceinline__ void a_ready(const Unit&) const {}
    __device__ __forceinline__ void done(const Unit&) const {}
};
struct SplitOrder {
    StaticOrder P; int G, c, S, nkt;
    __host__ __device__ void init(int K, int S_, int G_, int c_) { P.init(64 * BM, 4 * BM, K, 1, 0); G = G_; c = c_; S = S_; nkt = K / BK; }
    __host__ __device__ __forceinline__ bool next(int i, Unit& u) const {
        const int L = i * G + c;
        if (L >= 256 + 8 * S) return false;
        const bool pr = L < 256; const int r = L - 256, t = r & 7, s = r >> 3, ns = nkt / S;
        const int w = (L & 7) * 32 + (L >> 3);
        u.pm = pr ? ((w >> 5) * 8 + (w & 7)) : 64 + (t >> 2); u.pn = pr ? ((w & 31) >> 3) : (t & 3);
        u.kt0 = pr ? 0 : s * ns; u.nkt = pr ? nkt : ns; u.slab = pr ? -1 : s; return true;
    }
    __device__ __forceinline__ void a_ready(const Unit&) const {}
    __device__ __forceinline__ void done(const Unit&) const {}
};


__device__ __forceinline__ unsigned cvt_pk_bf16(float lo, float hi) { unsigned r; asm volatile("v_cvt_pk_bf16_f32 %0, %1, %2" : "=v"(r) : "v"(lo), "v"(hi)); return r; }
__device__ __forceinline__ float silu_f(float g) { return g * __builtin_amdgcn_rcpf(1.0f + __builtin_amdgcn_exp2f(g * -1.44269504089f)); }

struct EpiBf16 {
    static constexpr bool PERM = true, AFTER_DRAIN = false;
    bf16_t* O; int ldc;
    __device__ __forceinline__ void operator()(const f32x4 (&acc)[2][2][4][2], const Unit& u, int wr, int wc, int fr, int fq) const {
        const int row0 = u.pm * BM + wr * 64 + fr; const int col0 = u.pn * BM + wc * 32 + 8 * fq;
#pragma unroll
        for (int ai = 0; ai < 2; ++ai)
#pragma unroll
            for (int m = 0; m < 4; ++m) { bf16_t* rowp = O + (size_t)(row0 + ai * HALF + m * 16) * ldc + col0;
#pragma unroll
                for (int bj = 0; bj < 2; ++bj) { const f32x4 v0 = acc[ai][bj][m][0], v1 = acc[ai][bj][m][1];
                    u32x4 w; w.x = cvt_pk_bf16(v0[0], v0[1]); w.y = cvt_pk_bf16(v0[2], v0[3]); w.z = cvt_pk_bf16(v1[0], v1[1]); w.w = cvt_pk_bf16(v1[2], v1[3]);
                    *(u32x4*)(rowp + bj * HALF) = w; } }
    }
};
struct EpiSwiglu {
    static constexpr bool PERM = true, AFTER_DRAIN = false;
    bf16_t* O; int ldc;
    __device__ __forceinline__ void operator()(const f32x4 (&acc)[2][2][4][2], const Unit& u, int wr, int wc, int fr, int fq) const {
        const int row0 = u.pm * BM + wr * 64 + fr; const int col0 = u.pn * HALF + wc * 32 + 8 * fq;
#pragma unroll
        for (int ai = 0; ai < 2; ++ai)
#pragma unroll
            for (int m = 0; m < 4; ++m) { bf16_t* rowp = O + (size_t)(row0 + ai * HALF + m * 16) * ldc + col0;
                const f32x4 g0 = acc[ai][0][m][0], g1 = acc[ai][0][m][1], u0 = acc[ai][1][m][0], u1 = acc[ai][1][m][1];
                u32x4 w;
                w.x = cvt_pk_bf16(silu_f(g0[0]) * u0[0], silu_f(g0[1]) * u0[1]); w.y = cvt_pk_bf16(silu_f(g0[2]) * u0[2], silu_f(g0[3]) * u0[3]);
                w.z = cvt_pk_bf16(silu_f(g1[0]) * u1[0], silu_f(g1[1]) * u1[1]); w.w = cvt_pk_bf16(silu_f(g1[2]) * u1[2], silu_f(g1[3]) * u1[3]);
                *(u32x4*)rowp = w; }
    }
};
struct EpiResid {
    static constexpr bool PERM = false, AFTER_DRAIN = false;
    const float* baseP; const float* baseS; float* out; const float* mod; int idx; float fac; float* part;
    __device__ __forceinline__ void operator()(const f32x4 (&acc)[2][2][4][2], const Unit& u, int wr, int wc, int fr, int fq) const {
        const int colb = u.pn * BM + wc * 32 + 4 * fq;
        if (u.slab >= 0) {
#pragma unroll
            for (int ai = 0; ai < 2; ++ai)
#pragma unroll
                for (int m = 0; m < 4; ++m) {
                    const int r = u.pm * BM + ai * HALF + wr * 64 + m * 16 + fr;
                    const float* mp = mod + (size_t)(row_batch(r) * NMOD + idx) * D;
                    float* pp = part + ((size_t)u.slab * NS + (r - NP)) * D;
#pragma unroll
                    for (int bj = 0; bj < 2; ++bj)
#pragma unroll
                        for (int n = 0; n < 2; ++n) { const int c = colb + bj * HALF + n * 16; const f32x4 mv = *(const f32x4*)(mp + c);
                            *(f32x4*)(pp + c) = (mv * fac) * acc[ai][bj][m][n]; }
                    if (m & 1) asm volatile("" ::: "memory"); }
            return;
        }
#pragma unroll
        for (int ai = 0; ai < 2; ++ai)
#pragma unroll
            for (int m = 0; m < 4; ++m) {
                const int r = u.pm * BM + ai * HALF + wr * 64 + m * 16 + fr;
                const float* bp = (r < NP) ? baseP + (size_t)r * D : baseS + (size_t)(r - NP) * D;
                const float* mp = mod + (size_t)(row_batch(r) * NMOD + idx) * D;
                float* op = out + (size_t)r * D;
#pragma unroll
                for (int bj = 0; bj < 2; ++bj)
#pragma unroll
                    for (int n = 0; n < 2; ++n) { const int c = colb + bj * HALF + n * 16;
                        const f32x4 bs = *(const f32x4*)(bp + c); const f32x4 mv = *(const f32x4*)(mp + c);
                        *(f32x4*)(op + c) = bs + (mv * fac) * acc[ai][bj][m][n]; }
                if (m & 1) asm volatile("" ::: "memory"); }
    }
};

template <class Epi, class Sched, bool ALIGN_EPI = false, bool SP2 = false>
__device__ __forceinline__ void gemm_phase(PG8_LAS unsigned char* lds, const Gemm g, const Sched& S, const Epi& E) {
    const int tid = threadIdx.x, wid = __builtin_amdgcn_readfirstlane(tid >> 6), lane = tid & 63, wr = wid >> 2, wc = wid & 3, fr = lane & 15, fq = lane >> 4;
    const int K = g.K;
    unsigned voffA[2], voffB[2];
#pragma unroll
    for (int i = 0; i < 2; ++i) { int R, C; stage_rc(tid * 16 + i * 8192, R, C); const int Rb = Epi::PERM ? ((R & ~31) + perm32(R & 31)) : R;
        voffA[i] = (unsigned)(R * K + C) * 2u; voffB[i] = (unsigned)(Rb * K + C) * 2u; }
    const size_t kstep = (size_t)(BK * 2);
    const size_t hstep = (size_t)HALF * K * 2;
    const size_t tstep = 2 * hstep;
    const unsigned ldsw = (unsigned)wid * 1024u;
    const int aoff = lds_byte(wr * 64 + fr, fq * 8), boff = lds_byte(wc * 32 + fr, fq * 8);
#define PG8_SA(b, h) (((b) * 2 + (h)) * HTB)
#define PG8_SB(b, h) ((4 + (b) * 2 + (h)) * HTB)
#define PG8_STAGE(bufoff, gbase, voff) do { _Pragma("unroll") for (int _i = 0; _i < 2; ++_i) \
        __builtin_amdgcn_global_load_lds((const unsigned*)((const char*)(gbase) + (voff)[_i]), (PG8_LAS unsigned*)(lds + (bufoff) + ldsw + _i * 8192), 16, 0, 0); } while (0)
#define PG8_LDA(dst, b, h) do { _Pragma("unroll") for (int m = 0; m < 4; ++m) _Pragma("unroll") for (int k = 0; k < 2; ++k) dst[m][k] = *(const PG8_LAS bf16x8*)(lds + PG8_SA(b, h) + aoff + m * 2048 + k * 1024); } while (0)
#define PG8_LDB(dst, b, h) do { _Pragma("unroll") for (int n = 0; n < 2; ++n) _Pragma("unroll") for (int k = 0; k < 2; ++k) dst[n][k] = *(const PG8_LAS bf16x8*)(lds + PG8_SB(b, h) + boff + n * 2048 + k * 1024); } while (0)
#define PG8_MMA(ai, bj, At, Bt) do { __builtin_amdgcn_s_setprio(1); _Pragma("unroll") for (int m = 0; m < 4; ++m) _Pragma("unroll") for (int n = 0; n < 2; ++n) _Pragma("unroll") for (int k = 0; k < 2; ++k) \
        acc[ai][bj][m][n] = __builtin_amdgcn_mfma_f32_16x16x32_bf16(Bt[n][k], At[m][k], acc[ai][bj][m][n], 0, 0, 0); __builtin_amdgcn_s_setprio(0); } while (0)
#define PG8_WAIT_V(n) asm volatile("s_waitcnt vmcnt(" #n ")" ::: "memory")
#define PG8_WAIT_L(n) asm volatile("s_waitcnt lgkmcnt(" #n ")" ::: "memory")
#define PG8_BAR __builtin_amdgcn_s_barrier()
#define PG8_SCHED __builtin_amdgcn_sched_barrier(0)
    Unit cur, nxt; int ui = 0;
    if (!S.next(0, cur)) return;
    f32x4 acc[2][2][4][2];
#pragma unroll
    for (int a = 0; a < 2; ++a)
#pragma unroll
        for (int b = 0; b < 2; ++b)
#pragma unroll
            for (int m = 0; m < 4; ++m)
#pragma unroll
                for (int n = 0; n < 2; ++n) acc[a][b][m][n] = (f32x4){0.f, 0.f, 0.f, 0.f};
    bf16x8 At[4][2], B0[2][2], B1[2][2];
    const char* cA = (const char*)g.A + (size_t)cur.pm * tstep + (size_t)cur.kt0 * kstep; const char* cB = (const char*)g.Bt + (size_t)cur.pn * tstep + (size_t)cur.kt0 * kstep;
    S.a_ready(cur);
    if constexpr (SP2) {
        PG8_STAGE(PG8_SB(0, 0), cB, voffB); PG8_STAGE(PG8_SB(0, 1), cB + hstep, voffB); PG8_STAGE(PG8_SA(0, 0), cA, voffA); PG8_STAGE(PG8_SA(0, 1), cA + hstep, voffA);
        if (wr == 1) PG8_BAR;
        PG8_WAIT_V(2); PG8_BAR;
        PG8_STAGE(PG8_SB(1, 0), cB + kstep, voffB); PG8_STAGE(PG8_SA(1, 0), cA + kstep, voffA); PG8_STAGE(PG8_SB(1, 1), cB + hstep + kstep, voffB);
        PG8_WAIT_V(6); PG8_BAR;
    } else {
        PG8_STAGE(PG8_SB(0, 0), cB, voffB); PG8_STAGE(PG8_SA(0, 0), cA, voffA); PG8_STAGE(PG8_SB(0, 1), cB + hstep, voffB); PG8_STAGE(PG8_SA(0, 1), cA + hstep, voffA);
        if (wr == 1) PG8_BAR;
        PG8_WAIT_V(4); PG8_BAR;
        PG8_STAGE(PG8_SB(1, 0), cB + kstep, voffB); PG8_STAGE(PG8_SA(1, 0), cA + kstep, voffA); PG8_STAGE(PG8_SB(1, 1), cB + hstep + kstep, voffB);
        PG8_WAIT_V(6); PG8_BAR;
    }
    for (;;) {
        const bool has_next = S.next(ui + 1, nxt);
        const char* nA = has_next ? (const char*)g.A + (size_t)nxt.pm * tstep + (size_t)nxt.kt0 * kstep : cA; const char* nB = has_next ? (const char*)g.Bt + (size_t)nxt.pn * tstep + (size_t)nxt.kt0 * kstep : cB;
        const int nt = cur.nkt;
        for (int t = 0; t < nt; t += 2) {
            const bool last = (t == nt - 2);
            const char* a1 = cA + (size_t)(t + 1) * kstep;
            const char* a2 = last ? nA : cA + (size_t)(t + 2) * kstep; const char* b2 = last ? nB : cB + (size_t)(t + 2) * kstep;
            const char* a3 = a2 + kstep; const char* b3 = b2 + kstep;
            if (last && has_next) S.a_ready(nxt);
            if constexpr (SP2) {
            PG8_LDB(B0, 0, 0); PG8_LDB(B1, 0, 1); PG8_SCHED; PG8_LDA(At, 0, 0); PG8_STAGE(PG8_SA(1, 1), a1 + hstep, voffA);
            PG8_WAIT_V(8); PG8_WAIT_L(0); PG8_BAR; PG8_MMA(0, 0, At, B0); PG8_MMA(0, 1, At, B1); PG8_BAR; PG8_SCHED;
            PG8_LDA(At, 0, 1); PG8_STAGE(PG8_SB(0, 0), b2, voffB); PG8_STAGE(PG8_SB(0, 1), b2 + hstep, voffB); PG8_STAGE(PG8_SA(0, 0), a2, voffA);
            PG8_WAIT_V(8); PG8_WAIT_L(0); PG8_BAR; PG8_MMA(1, 0, At, B0); PG8_MMA(1, 1, At, B1); PG8_BAR; PG8_SCHED;
            PG8_LDB(B0, 1, 0); PG8_LDB(B1, 1, 1); PG8_SCHED; PG8_LDA(At, 1, 0); PG8_STAGE(PG8_SA(0, 1), a2 + hstep, voffA);
            PG8_WAIT_V(8); PG8_WAIT_L(0); PG8_BAR; PG8_MMA(0, 0, At, B0); PG8_MMA(0, 1, At, B1); PG8_BAR; PG8_SCHED;
            PG8_LDA(At, 1, 1); PG8_STAGE(PG8_SB(1, 0), b3, voffB); PG8_STAGE(PG8_SB(1, 1), b3 + hstep, voffB); PG8_STAGE(PG8_SA(1, 0), a3, voffA);
            PG8_WAIT_V(8); PG8_WAIT_L(0); PG8_BAR; PG8_MMA(1, 0, At, B0); PG8_MMA(1, 1, At, B1); PG8_BAR; PG8_SCHED;
            } else {
            PG8_LDB(B0, 0, 0); PG8_SCHED; PG8_LDA(At, 0, 0); PG8_STAGE(PG8_SA(1, 1), a1 + hstep, voffA);
            PG8_WAIT_L(8); PG8_BAR; PG8_WAIT_L(0); PG8_MMA(0, 0, At, B0); PG8_BAR; PG8_SCHED;
            PG8_LDB(B1, 0, 1); PG8_STAGE(PG8_SB(0, 0), b2, voffB);
            PG8_BAR; PG8_WAIT_L(0); PG8_MMA(0, 1, At, B1); PG8_BAR;
            PG8_LDA(At, 0, 1); PG8_STAGE(PG8_SA(0, 0), a2, voffA);
            PG8_BAR; PG8_WAIT_L(0); PG8_MMA(1, 0, At, B0); PG8_BAR; PG8_SCHED;
            PG8_STAGE(PG8_SB(0, 1), b2 + hstep, voffB);
            PG8_WAIT_V(6); PG8_BAR; PG8_MMA(1, 1, At, B1); PG8_BAR;
            PG8_LDB(B0, 1, 0); PG8_SCHED; PG8_LDA(At, 1, 0); PG8_STAGE(PG8_SA(0, 1), a2 + hstep, voffA);
            PG8_WAIT_L(8); PG8_BAR; PG8_WAIT_L(0); PG8_MMA(0, 0, At, B0); PG8_BAR; PG8_SCHED;
            PG8_LDB(B1, 1, 1); PG8_STAGE(PG8_SB(1, 0), b3, voffB);
            PG8_BAR; PG8_WAIT_L(0); PG8_MMA(0, 1, At, B1); PG8_BAR;
            PG8_LDA(At, 1, 1); PG8_STAGE(PG8_SA(1, 0), a3, voffA);
            PG8_BAR; PG8_WAIT_L(0); PG8_MMA(1, 0, At, B0); PG8_BAR; PG8_SCHED;
            PG8_STAGE(PG8_SB(1, 1), b3 + hstep, voffB);
            PG8_WAIT_V(6); PG8_BAR; PG8_MMA(1, 1, At, B1); PG8_BAR;
            }
        }
        if constexpr (ALIGN_EPI) { if (wr == 0) PG8_BAR; }
        if constexpr (!Epi::AFTER_DRAIN) { E(acc, cur, wr, wc, fr, fq); S.done(cur); }
        if (!has_next) break;
#pragma unroll
        for (int a = 0; a < 2; ++a)
#pragma unroll
            for (int b = 0; b < 2; ++b)
#pragma unroll
                for (int m = 0; m < 4; ++m)
#pragma unroll
                    for (int n = 0; n < 2; ++n) acc[a][b][m][n] = (f32x4){0.f, 0.f, 0.f, 0.f};
        cur = nxt; cA = nA; cB = nB; ++ui;
        if constexpr (ALIGN_EPI) { if (wr == 1) PG8_BAR; }
    }
    PG8_WAIT_V(0);
    if constexpr (!ALIGN_EPI) { if (wr == 0) PG8_BAR; }
    PG8_BAR;
    if constexpr (Epi::AFTER_DRAIN) { E.fused(acc, cur, wr, wc, fr, fq, lds, wid, lane); S.done(cur); }
#undef PG8_SA
#undef PG8_SB
#undef PG8_STAGE
#undef PG8_LDA
#undef PG8_LDB
#undef PG8_MMA
#undef PG8_WAIT_V
#undef PG8_WAIT_L
#undef PG8_BAR
#undef PG8_SCHED
}
}
#ifndef PG8_SP2
#define PG8_SP2 true
#endif
#ifndef PG8_ALIGN
#define PG8_ALIGN true
#endif

constexpr int NWAVES = 8;
constexpr int N_PHASES = 13;
constexpr size_t MiB = 1u << 20;
constexpr size_t WS_CTL = 0, CTL_ZERO_BYTES = 16384;
constexpr size_t WS_MOD = 1 * MiB;
constexpr size_t WS_AGG = 6 * MiB, WS_WG = 7 * MiB;
constexpr size_t WS_W1GU = 8 * MiB, WS_W1D = 20 * MiB, WS_WMI = 26 * MiB, WS_WMO = 31 * MiB, WS_W2GU = 33 * MiB, WS_W2D = 45 * MiB;
constexpr size_t WS_XN = 52 * MiB;
constexpr size_t WS_H = 86 * MiB;
constexpr size_t WS_PART = 186 * MiB;
constexpr size_t WS_END = 202 * MiB;
constexpr size_t O_YP = 0, O_YS = (size_t)NP * D, O_CP = O_YS + (size_t)NS * D, O_HP = O_CP + 8 * 3 * 512, O_SP = O_HP + 8 * 512,
                 O_CS = O_SP + 8 * 2 * 512, O_HS = O_CS + 128 * 3 * 512, O_SS = O_HS + 128 * 512, O_END = O_SS + 128 * 2 * 512;
constexpr int LDS_BYTES = 147456, MISC_OFF = LDS_BYTES - 16;

#define LAS __attribute__((address_space(3)))
typedef unsigned short bf16;
typedef unsigned v4u __attribute__((ext_vector_type(4)));
typedef float f32x4 __attribute__((ext_vector_type(4)));
typedef short bf16x8 __attribute__((ext_vector_type(8)));
#define LDS_WAIT() asm volatile("s_waitcnt lgkmcnt(0)" ::: "memory")
__device__ __forceinline__ unsigned f2bf(float f) { unsigned u = __builtin_bit_cast(unsigned, f); return (u + 0x7fffu + ((u >> 16) & 1u)) >> 16; }
__device__ __forceinline__ unsigned pk2(float lo, float hi) { return f2bf(lo) | (f2bf(hi) << 16); }
__device__ __forceinline__ float bf2f(unsigned short h) { return __builtin_bit_cast(float, (unsigned)h << 16); }
__device__ __forceinline__ float bflo(unsigned w) { return __builtin_bit_cast(float, w << 16); }
__device__ __forceinline__ float bfhi(unsigned w) { return __builtin_bit_cast(float, w & 0xffff0000u); }
__device__ __forceinline__ void unpack8(const v4u v, float (&o)[8]) { o[0] = bflo(v.x); o[1] = bfhi(v.x); o[2] = bflo(v.y); o[3] = bfhi(v.y); o[4] = bflo(v.z); o[5] = bfhi(v.z); o[6] = bflo(v.w); o[7] = bfhi(v.w); }
__device__ __forceinline__ v4u pack8(const float (&o)[8]) { v4u v; v.x = pk2(o[0], o[1]); v.y = pk2(o[2], o[3]); v.z = pk2(o[4], o[5]); v.w = pk2(o[6], o[7]); return v; }
__device__ __forceinline__ void ld8f(const float* p, float (&o)[8]) { const f32x4 a = *(const f32x4*)p, b = *(const f32x4*)(p + 4); o[0] = a.x; o[1] = a.y; o[2] = a.z; o[3] = a.w; o[4] = b.x; o[5] = b.y; o[6] = b.z; o[7] = b.w; }
__device__ __forceinline__ void st8f(float* p, const float (&o)[8]) { *(f32x4*)p = (f32x4){o[0], o[1], o[2], o[3]}; *(f32x4*)(p + 4) = (f32x4){o[4], o[5], o[6], o[7]}; }
__device__ __forceinline__ float sigmoid_f(float x) { return __builtin_amdgcn_rcpf(1.0f + __builtin_amdgcn_exp2f(x * -1.44269504089f)); }
__device__ __forceinline__ float wave_sum(float v) {
#pragma unroll
    for (int o = 1; o < 64; o <<= 1) v += __shfl_xor(v, o);
    return v;
}

#define RLX_AGENT __ATOMIC_RELAXED, __HIP_MEMORY_SCOPE_AGENT
#define XB_TMO      128
#define XB_XCNT(j)  (256  + 64 * (j))
#define XB_XSUB(j)  (1280 + 64 * (j))
#define XB_XGEN(j)  (2304 + 64 * (j))
#define XB_TOP      3328
#define XB_TOPGEN   3392
#define XCD_BAR_WORDS 3456
#define XB_SPIN_CAP (1u << 18)

__device__ __forceinline__ unsigned xb_ld(unsigned* p)              { return __hip_atomic_load(p, __ATOMIC_RELAXED, __HIP_MEMORY_SCOPE_AGENT); }
__device__ __forceinline__ unsigned xb_add(unsigned* p, unsigned v) { return __hip_atomic_fetch_add(p, v, __ATOMIC_RELAXED, __HIP_MEMORY_SCOPE_AGENT); }
__device__ __forceinline__ unsigned xb_xcc_id() { return (unsigned)__builtin_amdgcn_s_getreg((3 << 11) | 20) & 0xFu; }
#define XB_SPIN(cond, bar) do { unsigned _sp = 0; while (cond) { __builtin_amdgcn_s_sleep(1); \
    if ((++_sp & 255u) == 0u) { if (xb_ld(&(bar)[XB_TMO])) break; if (_sp > XB_SPIN_CAP) { atomicAdd(&(bar)[XB_TMO], 1u); break; } } } } while (0)

struct XcdBarrier {
    unsigned* bar; unsigned x;
    volatile LAS unsigned* st;
};

__device__ __forceinline__ XcdBarrier xcd_barrier_post(unsigned* bar, volatile LAS unsigned* st) {
    XcdBarrier b; b.bar = bar; b.x = xb_xcc_id(); b.st = st;
    if (threadIdx.x == 0) (void)xb_add(&bar[XB_XCNT(b.x)], 1u);
    return b;
}
__device__ __forceinline__ void xcd_barrier_complete(unsigned* bar, unsigned x, unsigned& nloc, unsigned& nx) {
    const unsigned G = gridDim.x * gridDim.y * gridDim.z;
    unsigned sum, cnt, mine, sp = 0u;
    for (;;) {
        sum = 0u; cnt = 0u; mine = 0u;
#pragma unroll
        for (unsigned j = 0; j < 16; ++j) { const unsigned c = xb_ld(&bar[XB_XCNT(j)]); sum += c; cnt += (c > 0u) ? 1u : 0u; mine = (j == x) ? c : mine; }
        if (sum == G) break;
        __builtin_amdgcn_s_sleep(1);
        if ((++sp & 255u) == 0u) { if (xb_ld(&bar[XB_TMO])) break; if (sp > XB_SPIN_CAP) { atomicAdd(&bar[XB_TMO], 1u); break; } }
    }
    nloc = mine > 0u ? mine : 1u; nx = cnt > 0u ? cnt : 1u;
}

__device__ __forceinline__ void xcd_barrier(const XcdBarrier& b) {
    asm volatile("s_waitcnt vmcnt(0)" ::: "memory");
    __syncthreads();
    if (threadIdx.x == 0) {
        unsigned* bar = b.bar;
        __builtin_amdgcn_s_waitcnt(0);
        unsigned nloc = b.st[0], nx = b.st[1];
        if (nloc == 0u) { xcd_barrier_complete(bar, b.x, nloc, nx); b.st[0] = nloc; b.st[1] = nx; }
        const unsigned old = xb_add(&bar[XB_XSUB(b.x)], 1u);
        const unsigned gen = old / nloc;
        if (old + 1u == (gen + 1u) * nloc) {
            __builtin_amdgcn_fence(__ATOMIC_RELEASE, "agent");
            asm volatile("s_waitcnt vmcnt(0)" ::: "memory");
            const unsigned og = xb_add(&bar[XB_TOP], 1u);
            const unsigned tg = og / nx;
            if (og + 1u == (tg + 1u) * nx) xb_add(&bar[XB_TOPGEN], 1u);
            else XB_SPIN(xb_ld(&bar[XB_TOPGEN]) == tg, bar);
            __builtin_amdgcn_fence(__ATOMIC_ACQUIRE, "agent");
            xb_add(&bar[XB_XGEN(b.x)], 1u);
            asm volatile("s_waitcnt vmcnt(0)" ::: "memory");
        } else {
            XB_SPIN(xb_ld(&bar[XB_XGEN(b.x)]) == gen, bar);
            __builtin_amdgcn_fence(__ATOMIC_ACQUIRE, "agent");
            asm volatile("s_waitcnt vmcnt(0)" ::: "memory");
        }
    }
    __syncthreads();
}

struct Frame {
    LAS unsigned char* lds;
    int tid, lane, wave, G;
    const float* in[29];
    float* out;
    float* mod; float* agg; float* part;
    bf16 *W1GU, *W1D, *WMI, *WMO, *W2GU, *W2D, *XN, *U, *H, *Z, *WG;
};

__device__ __forceinline__ void p0_transpose_item(const float* W, int K, int N, bf16* WT, int mode, LAS float* scr, int item, int lane) {
    const int nblk = N / 32, kb = item / nblk, nb = item % nblk, k0 = 64 * kb, n0 = 32 * nb;
    const int rbase = (mode == 0) ? n0 : (256 * (n0 >> 7) + (n0 & 127) + (mode == 2 ? 128 : 0));
#pragma unroll 8
    for (int i = 0; i < 32; ++i) { const int kk = 2 * i + (lane >> 5); scr[kk * 33 + (lane & 31)] = W[(size_t)(k0 + kk) * N + n0 + (lane & 31)]; }
    LDS_WAIT(); asm volatile("" ::: "memory");
    const int c = lane & 7;
#pragma unroll
    for (int j = 0; j < 4; ++j) { const int n = (lane >> 3) + 8 * j; const LAS float* s = scr + (8 * c) * 33 + n;
        v4u o; o.x = pk2(s[0 * 33], s[1 * 33]); o.y = pk2(s[2 * 33], s[3 * 33]); o.z = pk2(s[4 * 33], s[5 * 33]); o.w = pk2(s[6 * 33], s[7 * 33]);
        *(v4u*)(WT + (size_t)(rbase + n) * K + k0 + 8 * c) = o; }
    LDS_WAIT(); asm volatile("" ::: "memory");
}
__device__ __forceinline__ void p0_prologue(Frame& F) {
    {
        const float* cP = F.in[5]; const float* cS = F.in[6]; const float* wada = F.in[7]; const float* bada = F.in[8];
        const int fr = F.lane & 15, fq = F.lane >> 4, w = F.wave;
        LAS float* red = (LAS float*)F.lds;
        for (int it = blockIdx.x; it < 576; it += F.G) {
            const int n0 = it * 16;
            f32x4 acc[9];
#pragma unroll
            for (int mt = 0; mt < 9; ++mt) acc[mt] = (f32x4){0.f, 0.f, 0.f, 0.f};
#pragma unroll 1
            for (int kk = 0; kk < 4; ++kk) {
                const int k0 = 128 * w + 32 * kk + 8 * fq;
                float bv[8];
#pragma unroll
                for (int j = 0; j < 8; ++j) bv[j] = wada[(size_t)(k0 + j) * (NMOD * D) + n0 + fr];
                const v4u bp = pack8(bv); const bf16x8 bfrag = __builtin_bit_cast(bf16x8, bp);
#pragma unroll
                for (int mt = 0; mt < 9; ++mt) {
                    const int row = 16 * mt + fr;
                    float av[8];
                    if (row < NBATCH) { const float* cp = (row < 8) ? cP + (size_t)row * D : cS + (size_t)(row - 8) * D; ld8f(cp + k0, av);
#pragma unroll
                        for (int j = 0; j < 8; ++j) av[j] = av[j] * sigmoid_f(av[j]); }
                    else {
#pragma unroll
                        for (int j = 0; j < 8; ++j) av[j] = 0.f; }
                    const v4u ap = pack8(av); const bf16x8 afrag = __builtin_bit_cast(bf16x8, ap);
                    acc[mt] = __builtin_amdgcn_mfma_f32_16x16x32_bf16(afrag, bfrag, acc[mt], 0, 0, 0);
                }
            }
#pragma unroll
            for (int mt = 0; mt < 9; ++mt)
#pragma unroll
                for (int i = 0; i < 4; ++i) red[(w * 144 + 16 * mt + 4 * fq + i) * 16 + fr] = acc[mt][i];
            __syncthreads();
            for (int o = F.tid; o < NBATCH * 16; o += NWAVES * 64) {
                const int row = o >> 4, c = o & 15; float s = bada[n0 + c];
#pragma unroll
                for (int ww = 0; ww < 8; ++ww) s += red[(ww * 144 + row) * 16 + c];
                F.mod[(size_t)row * (NMOD * D) + n0 + c] = s;
            }
            __syncthreads();
        }
    }
    LAS float* scr = (LAS float*)(F.lds + F.wave * 16384);
    const int gw = blockIdx.x * NWAVES + F.wave, NGW = F.G * NWAVES;
    constexpr int I_GU = (D / 64) * (FF / 32), I_DN = (FF / 64) * (D / 32), I_MI = (D / 64) * (DIN / 32), I_MO = (D / 64) * (D / 32);
    constexpr int NITEMS = 6 * I_GU + I_MI + I_MO;
    static_assert(I_GU == I_DN, "item counts");
    for (int it = gw; it < NITEMS; it += NGW) {
        int r = it;
        if (r < I_GU) { p0_transpose_item(F.in[10], D, FF, F.W1GU, 1, scr, r, F.lane); continue; } r -= I_GU;
        if (r < I_GU) { p0_transpose_item(F.in[11], D, FF, F.W1GU, 2, scr, r, F.lane); continue; } r -= I_GU;
        if (r < I_DN) { p0_transpose_item(F.in[12], FF, D, F.W1D, 0, scr, r, F.lane); continue; } r -= I_DN;
        if (r < I_MI) { p0_transpose_item(F.in[14], D, DIN, F.WMI, 0, scr, r, F.lane); continue; } r -= I_MI;
        if (r < I_MO) { p0_transpose_item(F.in[23], D, D, F.WMO, 0, scr, r, F.lane); continue; } r -= I_MO;
        if (r < I_GU) { p0_transpose_item(F.in[25], D, FF, F.W2GU, 1, scr, r, F.lane); continue; } r -= I_GU;
        if (r < I_GU) { p0_transpose_item(F.in[26], D, FF, F.W2GU, 2, scr, r, F.lane); continue; } r -= I_GU;
        p0_transpose_item(F.in[27], FF, D, F.W2D, 0, scr, r, F.lane);
    }
    for (int o = blockIdx.x * (NWAVES * 64) + F.tid; o < 2 * 32768; o += F.G * NWAVES * 64) {
        const int g = o >> 15, r = o & 32767, h = r >> 12, n = (r >> 6) & 63, k = r & 63;
        const float* w = g ? F.in[19] : F.in[17];
        F.WG[o] = (bf16)f2bf(w[(h * 64 + k) * 64 + n]);
    }
}

__device__ __forceinline__ void norm_pass(Frame& F, const float* srcP, const float* srcS, const float* gain, int ishift, int iscale, int nsplit) {
    const int gw = blockIdx.x * NWAVES + F.wave, NGW = F.G * NWAVES;
    const f32x4* gr = (const f32x4*)gain + F.lane;
    f32x4 g[4];
#pragma unroll
    for (int j = 0; j < 4; ++j) g[j] = gr[64 * j];
    for (int m0 = 2 * gw; m0 < M; m0 += 2 * NGW) {
        f32x4 v[2][4];
#pragma unroll
        for (int q = 0; q < 2; ++q) { const int m = m0 + q;
            const f32x4* xr = (const f32x4*)((m < NP) ? srcP + (size_t)m * D : srcS + (size_t)(m - NP) * D) + F.lane;
#pragma unroll
            for (int j = 0; j < 4; ++j) v[q][j] = xr[64 * j]; }
#pragma unroll
        for (int q = 0; q < 2; ++q) { const int m = m0 + q;
            if (m >= NP && nsplit > 0) {
                for (int sp = 0; sp < nsplit; ++sp) { const f32x4* pr = (const f32x4*)(F.part + ((size_t)sp * NS + (m - NP)) * D) + F.lane;
#pragma unroll
                    for (int j = 0; j < 4; ++j) v[q][j] += pr[64 * j]; }
                f32x4* orow = (f32x4*)(F.out + (size_t)m * D) + F.lane;
#pragma unroll
                for (int j = 0; j < 4; ++j) orow[64 * j] = v[q][j];
            }
            const int b = row_batch(m);
            const f32x4* sh = (const f32x4*)(F.mod + (size_t)(b * NMOD + ishift) * D) + F.lane;
            const f32x4* sc = (const f32x4*)(F.mod + (size_t)(b * NMOD + iscale) * D) + F.lane;
            float s = 0.f;
#pragma unroll
            for (int j = 0; j < 4; ++j) s += (v[q][j].x * v[q][j].x + v[q][j].y * v[q][j].y) + (v[q][j].z * v[q][j].z + v[q][j].w * v[q][j].w);
            const float rstd = 1.0f / sqrtf(wave_sum(s) * (1.f / D) + EPS);
            unsigned long long* o8 = (unsigned long long*)(F.XN + (size_t)m * D) + F.lane;
#pragma unroll
            for (int j = 0; j < 4; ++j) { const f32x4 a = sh[64 * j], c = sc[64 * j];
                const f32x4 o = (v[q][j] * rstd) * g[j] * (c + 1.0f) + a;
                o8[64 * j] = (unsigned long long)pk2(o.x, o.y) | ((unsigned long long)pk2(o.z, o.w) << 32); }
        }
    }
}
__device__ __forceinline__ void final_norm(Frame& F, int nsplit) {
    const int gw = blockIdx.x * NWAVES + F.wave, NGW = F.G * NWAVES;
    const f32x4* gr = (const f32x4*)F.in[28] + F.lane;
    f32x4 g[4];
#pragma unroll
    for (int j = 0; j < 4; ++j) g[j] = gr[64 * j];
    for (int m0 = 2 * gw; m0 < M; m0 += 2 * NGW) {
        f32x4 v[2][4];
#pragma unroll
        for (int q = 0; q < 2; ++q) { f32x4* xr = (f32x4*)(F.out + (size_t)(m0 + q) * D) + F.lane;
#pragma unroll
            for (int j = 0; j < 4; ++j) v[q][j] = xr[64 * j]; }
#pragma unroll
        for (int q = 0; q < 2; ++q) { const int m = m0 + q;
            f32x4* xr = (f32x4*)(F.out + (size_t)m * D) + F.lane;
            if (m >= NP) {
                for (int sp = 0; sp < nsplit; ++sp) { const f32x4* pr = (const f32x4*)(F.part + ((size_t)sp * NS + (m - NP)) * D) + F.lane;
#pragma unroll
                    for (int j = 0; j < 4; ++j) v[q][j] += pr[64 * j]; }
            }
            float s = 0.f;
#pragma unroll
            for (int j = 0; j < 4; ++j) s += (v[q][j].x * v[q][j].x + v[q][j].y * v[q][j].y) + (v[q][j].z * v[q][j].z + v[q][j].w * v[q][j].w);
            const float rstd = 1.0f / sqrtf(wave_sum(s) * (1.f / D) + EPS);
#pragma unroll
            for (int j = 0; j < 4; ++j) xr[64 * j] = (v[q][j] * rstd) * g[j];
        }
    }
}

#ifndef NEG_EXPM1
#define NEG_EXPM1(x) (-expm1f(x))
#endif
constexpr int RS = 1040;
constexpr int XL_OFF = 0, XC_OFF = 67 * RS;
static_assert(XC_OFF % 16 == 0 && XC_OFF + 64 * RS <= LDS_BYTES, "mixer LDS map");
constexpr int CARRY_OFF = XC_OFF + 64 * RS;
static_assert(CARRY_OFF % 16 == 0 && CARRY_OFF + 2048 <= MISC_OFF, "mixer LDS map");
__device__ __forceinline__ float neg_expm1(float x, float ex) {
    const float ser = -x * (1.0f + x * (0.5f + x * (0.16666667f + x * 0.041666668f)));
    return x > -0.125f ? ser : 1.0f - ex;
}
template <int PASS>
__device__ __forceinline__ void mixer_mid(Frame& F) {
    const int tid = F.tid, lane = F.lane, fr = lane & 15, fq = lane >> 4;
    LAS unsigned char* lds = F.lds;
    const bf16* Z = F.Z;
    const float* st_conv = F.in[2]; const float* st_h = F.in[3]; const float* st_sc = F.in[4];
    const int nunits = (PASS == 1) ? 264 : 256;
    for (int unit = blockIdx.x; unit < nunits; unit += F.G) {
        const bool samp = unit >= 256;
        const bool full = (PASS == 2) || samp;
        const int row0 = unit * 64;
        const int b = unit >> 5, chunk = unit & 31;
        const int seq0 = (unit - 256) * 16;
        const int chb = 64 * F.wave;
        if (PASS == 2) {
            const float* ap = F.agg + (size_t)(b * 32) * 1024 + tid; float h = 0.f;
            for (int jc = 0; jc < chunk; jc += 8) {
                float A[8], Bv[8];
#pragma unroll
                for (int j = 0; j < 8; ++j) { const bool ok = jc + j < chunk; A[j] = ok ? ap[(size_t)(jc + j) * 1024] : 1.f; Bv[j] = ok ? ap[(size_t)(jc + j) * 1024 + 512] : 0.f; }
#pragma unroll
                for (int j = 0; j < 8; ++j) h = A[j] * h + Bv[j];
            }
            *(LAS float*)(lds + CARRY_OFF + tid * 4) = h;
        }
        for (int p = tid; p < 67 * 64; p += NWAVES * 64) {
            const int hr = p >> 6, c16 = p & 63, tok = hr - 3;
            v4u v = (v4u){0u, 0u, 0u, 0u};
            const bool valid = samp ? (tok >= 0) : (tok >= 0 || chunk > 0);
            if (valid) v = *(const v4u*)(Z + (size_t)(row0 + tok) * DIN + c16 * 8);
            *(LAS v4u*)(lds + XL_OFF + hr * RS + c16 * 16) = v;
        }
        if (PASS == 1) {
            const int ch0 = (tid & 63) * 8, r = tid >> 6;
            const float* wsc = F.in[22];
            float w0[8], w1[8], w2[8]; ld8f(wsc + ch0, w0); ld8f(wsc + 512 + ch0, w1); ld8f(wsc + 1024 + ch0, w2);
            float u2[8], u1[8];
#pragma unroll
            for (int j = 0; j < 8; ++j) { u2[j] = 0.f; u1[j] = 0.f; }
            if (!samp && (r > 0 || chunk > 0)) {
                const bf16* zr = Z + (size_t)(row0 + 8 * r - 2) * DIN + ch0;
                float c[8], v[8];
                unpack8(*(const v4u*)(zr + 1536), c); unpack8(*(const v4u*)(zr + 2048), v);
#pragma unroll
                for (int j = 0; j < 8; ++j) u2[j] = c[j] * v[j];
                unpack8(*(const v4u*)(zr + DIN + 1536), c); unpack8(*(const v4u*)(zr + DIN + 2048), v);
#pragma unroll
                for (int j = 0; j < 8; ++j) u1[j] = c[j] * v[j];
            }
#pragma unroll
            for (int t = 0; t < 8; ++t) {
                const int tok = 8 * r + t; const int seq = seq0 + (tok >> 2);
                if (samp && (t & 3) == 0) { ld8f(st_sc + (size_t)(seq * 2 + 0) * 512 + ch0, u2); ld8f(st_sc + (size_t)(seq * 2 + 1) * 512 + ch0, u1); }
                const bf16* zr = Z + (size_t)(row0 + tok) * DIN + ch0;
                float bs[8], c[8], v[8], u0[8], o[8];
                unpack8(*(const v4u*)(zr + 1024), bs); unpack8(*(const v4u*)(zr + 1536), c); unpack8(*(const v4u*)(zr + 2048), v);
#pragma unroll
                for (int j = 0; j < 8; ++j) { u0[j] = c[j] * v[j]; o[j] = bs[j] * (w0[j] * u2[j] + w1[j] * u1[j] + w2[j] * u0[j]); }
                *(v4u*)(F.U + (size_t)(row0 + tok) * D + 512 + ch0) = pack8(o);
                if (samp) { if ((t & 3) >= 2) st8f(F.out + O_SS + (size_t)(seq * 2 + ((t & 3) - 2)) * 512 + ch0, u0); }
                else if (chunk == 31 && tok >= 62) st8f(F.out + O_SP + (size_t)(b * 2 + (tok - 62)) * 512 + ch0, u0);
#pragma unroll
                for (int j = 0; j < 8; ++j) { u2[j] = u1[j]; u1[j] = u0[j]; }
            }
        }
        __syncthreads();
        {
            const int ch0 = (tid & 63) * 8, r = tid >> 6;
            const float* wc = F.in[15]; const float* bc = F.in[16];
            float w0[8], w1[8], w2[8], w3[8], bb[8];
            ld8f(wc + ch0, w0); ld8f(wc + 512 + ch0, w1); ld8f(wc + 1024 + ch0, w2); ld8f(wc + 1536 + ch0, w3); ld8f(bc + ch0, bb);
            float x3[8], x2[8], x1[8];
            unpack8(*(const LAS v4u*)(lds + XL_OFF + (8 * r + 0) * RS + ch0 * 2), x3);
            unpack8(*(const LAS v4u*)(lds + XL_OFF + (8 * r + 1) * RS + ch0 * 2), x2);
            unpack8(*(const LAS v4u*)(lds + XL_OFF + (8 * r + 2) * RS + ch0 * 2), x1);
#pragma unroll 2
            for (int t = 0; t < 8; ++t) {
                const int tok = 8 * r + t; const int seq = seq0 + (tok >> 2);
                if (samp && (t & 3) == 0) { ld8f(st_conv + (size_t)(seq * 3 + 0) * 512 + ch0, x3); ld8f(st_conv + (size_t)(seq * 3 + 1) * 512 + ch0, x2); ld8f(st_conv + (size_t)(seq * 3 + 2) * 512 + ch0, x1); }
                float x0[8], o[8];
                unpack8(*(const LAS v4u*)(lds + XL_OFF + (tok + 3) * RS + ch0 * 2), x0);
#pragma unroll
                for (int j = 0; j < 8; ++j) o[j] = bb[j] + w3[j] * x0[j] + w2[j] * x1[j] + w1[j] * x2[j] + w0[j] * x3[j];
                *(LAS v4u*)(lds + XC_OFF + tok * RS + ch0 * 2) = pack8(o);
                if (full) {
                    if (samp) { if ((t & 3) >= 1) st8f(F.out + O_CS + (size_t)(seq * 3 + ((t & 3) - 1)) * 512 + ch0, x0); }
                    else if (chunk == 31 && tok >= 61) st8f(F.out + O_CP + (size_t)(b * 3 + (tok - 61)) * 512 + ch0, x0);
                }
#pragma unroll
                for (int j = 0; j < 8; ++j) { x3[j] = x2[j]; x2[j] = x1[j]; x1[j] = x0[j]; }
            }
        }
        __syncthreads();
        bf16x8 wa[4][2], wx[4][2];
        float ba[4], bx[4], cl2[4];
        {
            const bf16* wga = F.WG + (size_t)F.wave * 4096; const bf16* wgx = F.WG + 32768 + (size_t)F.wave * 4096;
#pragma unroll
            for (int nt = 0; nt < 4; ++nt) {
#pragma unroll
                for (int kk = 0; kk < 2; ++kk) { const int o = (16 * nt + fr) * 64 + 32 * kk + 8 * fq;
                    wa[nt][kk] = *(const bf16x8*)(wga + o); wx[nt][kk] = *(const bf16x8*)(wgx + o); }
                const int ch = chb + 16 * nt + fr; ba[nt] = F.in[18][ch]; bx[nt] = F.in[20][ch];
                cl2[nt] = (-8.0f * 1.44269504089f) * log1pf(__expf(-F.in[21][ch]));
            }
        }
        if (full) {
#pragma unroll
            for (int i = 0; i < 8; ++i) { const int p = tid + 512 * i, tok = p >> 6, c16 = p & 63;
                *(LAS v4u*)(lds + XL_OFF + tok * RS + c16 * 16) = *(const v4u*)(Z + (size_t)(row0 + tok) * DIN + 512 + c16 * 8); }
            __syncthreads();
        }
        {
            float hc[4], Ac[4];
#pragma unroll
            for (int nt = 0; nt < 4; ++nt) { hc[nt] = (PASS == 2) ? *(const LAS float*)(lds + CARRY_OFF + (chb + 16 * nt + fr) * 4) : 0.f; Ac[nt] = 1.f; }
#pragma unroll 1
            for (int mt = 0; mt < 4; ++mt) {
                bf16x8 xa[2];
#pragma unroll
                for (int kk = 0; kk < 2; ++kk) xa[kk] = *(const LAS bf16x8*)(lds + XC_OFF + (16 * mt + fr) * RS + (chb + 32 * kk + 8 * fq) * 2);
                f32x4 accA[4], accX[4];
#pragma unroll
                for (int nt = 0; nt < 4; ++nt) { accA[nt] = (f32x4){0.f, 0.f, 0.f, 0.f}; accX[nt] = (f32x4){0.f, 0.f, 0.f, 0.f};
#pragma unroll
                    for (int kk = 0; kk < 2; ++kk) { accA[nt] = __builtin_amdgcn_mfma_f32_16x16x32_bf16(xa[kk], wa[nt][kk], accA[nt], 0, 0, 0);
                        accX[nt] = __builtin_amdgcn_mfma_f32_16x16x32_bf16(xa[kk], wx[nt][kk], accX[nt], 0, 0, 0); } }
#pragma unroll
                for (int nt = 0; nt < 4; ++nt) {
                    const int ch = chb + 16 * nt + fr;
                    float P[4], Hh[4];
#pragma unroll
                    for (int i = 0; i < 4; ++i) {
                        const int tok = 16 * mt + 4 * fq + i;
                        const float xcv = bf2f(*(const LAS unsigned short*)(lds + XC_OFF + tok * RS + ch * 2));
                        const float rg = sigmoid_f(accA[nt][i] + ba[nt]), ig = sigmoid_f(accX[nt][i] + bx[nt]);
                        const float l2 = cl2[nt] * rg;
                        const float a = __builtin_amdgcn_exp2f(l2), mult = __builtin_amdgcn_sqrtf(neg_expm1(l2 * (2.0f * 0.69314718056f), a * a));
                        const float bvv = mult * (ig * xcv);
                        if (i == 0) { P[0] = a; Hh[0] = bvv; } else { P[i] = a * P[i - 1]; Hh[i] = a * Hh[i - 1] + bvv; }
                    }
                    float hin;
                    if (samp) { hin = st_h[(size_t)(seq0 + 4 * mt + fq) * 512 + ch]; }
                    else {
                        float Ai = P[3], Bi = Hh[3];
                        float Au = __shfl_up(Ai, 16), Bu = __shfl_up(Bi, 16);
                        if (fq >= 1) { Bi = Ai * Bu + Bi; Ai = Au * Ai; }
                        Au = __shfl_up(Ai, 32); Bu = __shfl_up(Bi, 32);
                        if (fq >= 2) { Bi = Ai * Bu + Bi; Ai = Au * Ai; }
                        float Ae = __shfl_up(Ai, 16), Be = __shfl_up(Bi, 16);
                        if (fq == 0) { Ae = 1.f; Be = 0.f; }
                        hin = Ae * hc[nt] + Be;
                        const float At = __shfl(Ai, fr + 48), Bt = __shfl(Bi, fr + 48);
                        hc[nt] = At * hc[nt] + Bt;
                        if (PASS == 1) Ac[nt] *= At;
                    }
                    if (full) {
                        float hv[4];
#pragma unroll
                        for (int i = 0; i < 4; ++i) {
                            const int tok = 16 * mt + 4 * fq + i;
                            hv[i] = P[i] * hin + Hh[i];
                            const float g = bf2f(*(const LAS unsigned short*)(lds + XL_OFF + tok * RS + ch * 2));
                            const float y2 = 1.5957691216f * (g + 0.044715f * g * g * g);
                            const float o = hv[i] * (g * sigmoid_f(y2));
                            *(LAS unsigned short*)(lds + XC_OFF + tok * RS + ch * 2) = (unsigned short)f2bf(o);
                        }
                        if (samp) F.out[O_HS + (size_t)(seq0 + 4 * mt + fq) * 512 + ch] = hv[3];
                        else if (chunk == 31 && mt == 3 && fq == 3) F.out[O_HP + (size_t)b * 512 + ch] = hv[3];
                    }
                    __builtin_amdgcn_sched_barrier(0);
                }
            }
            if (PASS == 1 && !samp && fq == 0) {
#pragma unroll
                for (int nt = 0; nt < 4; ++nt) { const int ch = chb + 16 * nt + fr; float* ap = F.agg + (size_t)((b * 32 + chunk) * 2) * 512 + ch; ap[0] = Ac[nt]; ap[512] = hc[nt]; }
            }
        }
        __syncthreads();
        if (full) {
            for (int p = tid; p < 64 * 64; p += NWAVES * 64) {
                const int tok = p >> 6, c16 = p & 63;
                *(v4u*)(F.U + (size_t)(row0 + tok) * D + c16 * 8) = *(const LAS v4u*)(lds + XC_OFF + tok * RS + c16 * 16);
            }
        }
    }
}

struct Args { const float* in[29]; float* out; unsigned char* ws; int ph_lo, ph_hi; };
__global__ void __launch_bounds__(NWAVES * 64, 2) fwd_kernel(Args args) {
    extern __shared__ __attribute__((aligned(16))) unsigned char lds_raw[];
    Frame F;
    F.lds = (LAS unsigned char*)lds_raw;
    F.tid = threadIdx.x; F.lane = F.tid & 63; F.wave = __builtin_amdgcn_readfirstlane(F.tid >> 6); F.G = gridDim.x;
#pragma unroll
    for (int i = 0; i < 29; ++i) F.in[i] = args.in[i];
    F.out = args.out;
    unsigned char* ws = args.ws;
    F.mod = (float*)(ws + WS_MOD); F.agg = (float*)(ws + WS_AGG); F.part = (float*)(ws + WS_PART);
    F.W1GU = (bf16*)(ws + WS_W1GU); F.W1D = (bf16*)(ws + WS_W1D); F.WMI = (bf16*)(ws + WS_WMI); F.WMO = (bf16*)(ws + WS_WMO); F.W2GU = (bf16*)(ws + WS_W2GU); F.W2D = (bf16*)(ws + WS_W2D);
    F.WG = (bf16*)(ws + WS_WG); F.XN = (bf16*)(ws + WS_XN); F.U = F.XN; F.H = (bf16*)(ws + WS_H); F.Z = F.H;
    if (F.tid < 4) ((LAS unsigned*)(F.lds + MISC_OFF))[F.tid] = 0u;
    __syncthreads();
    XcdBarrier bar = xcd_barrier_post((unsigned*)(ws + WS_CTL), (volatile LAS unsigned*)(F.lds + MISC_OFF));
    const int lo = args.ph_lo, hi = args.ph_hi;
#ifndef PH_MASK
#define PH_MASK 0x1FFF
#endif
#define IN(k) (((PH_MASK >> (k)) & 1) && lo <= (k) && (k) < hi)
#ifndef REP_MASK
#define REP_MASK 0
#endif
#define REP(k) for (int rep_ = 0; rep_ < (((REP_MASK) >> (k)) & 1) + 1; ++rep_) if (rep_ == 0 || (xcd_barrier(bar), true))
#define SEAM(k) do { if (IN(k) && IN((k) + 1)) { if (lo < 0) cg::this_grid().sync(); else xcd_barrier(bar); } } while (0)

    constexpr int SPLIT_DN = 8, SPLIT_MO = 4;
    if (IN(0)) REP(0) { p0_prologue(F); } SEAM(0);
    if (IN(1)) REP(1) { norm_pass(F, F.in[0], F.in[1], F.in[9], 0, 1, 0); } SEAM(1);
    if (IN(2)) REP(2) { pg8::Gemm g{F.XN, F.W1GU, M, 2 * FF, D}; pg8::StaticOrder S; S.init(M, 2 * FF, D, F.G, (int)blockIdx.x);
        pg8::EpiSwiglu E{F.H, FF}; pg8::gemm_phase<pg8::EpiSwiglu, pg8::StaticOrder, PG8_ALIGN, PG8_SP2>(F.lds, g, S, E); } SEAM(2);
    if (IN(3)) REP(3) { pg8::Gemm g{F.H, F.W1D, M, D, FF}; pg8::SplitOrder S; S.init(FF, SPLIT_DN, F.G, (int)blockIdx.x);
        pg8::EpiResid E{F.in[0], F.in[1], F.out, F.mod, 2, 0.5f, F.part}; pg8::gemm_phase<pg8::EpiResid, pg8::SplitOrder, PG8_ALIGN, PG8_SP2>(F.lds, g, S, E); } SEAM(3);
    if (IN(4)) REP(4) { norm_pass(F, F.out, F.in[1], F.in[13], 3, 4, SPLIT_DN); } SEAM(4);
    if (IN(5)) REP(5) { pg8::Gemm g{F.XN, F.WMI, M, DIN, D}; pg8::StaticOrder S; S.init(M, DIN, D, F.G, (int)blockIdx.x);
        pg8::EpiBf16 E{F.Z, DIN}; pg8::gemm_phase<pg8::EpiBf16, pg8::StaticOrder, PG8_ALIGN, PG8_SP2>(F.lds, g, S, E); } SEAM(5);
    if (IN(6)) REP(6) { mixer_mid<1>(F); } SEAM(6);
    if (IN(7)) REP(7) { mixer_mid<2>(F); } SEAM(7);
    if (IN(8)) REP(8) { pg8::Gemm g{F.U, F.WMO, M, D, D}; pg8::SplitOrder S; S.init(D, SPLIT_MO, F.G, (int)blockIdx.x);
        pg8::EpiResid E{F.out, F.out + (size_t)NP * D, F.out, F.mod, 5, 1.0f, F.part}; pg8::gemm_phase<pg8::EpiResid, pg8::SplitOrder, PG8_ALIGN, PG8_SP2>(F.lds, g, S, E); } SEAM(8);
    if (IN(9)) REP(9) { norm_pass(F, F.out, F.out + (size_t)NP * D, F.in[24], 6, 7, SPLIT_MO); } SEAM(9);
    if (IN(10)) REP(10) { pg8::Gemm g{F.XN, F.W2GU, M, 2 * FF, D}; pg8::StaticOrder S; S.init(M, 2 * FF, D, F.G, (int)blockIdx.x);
        pg8::EpiSwiglu E{F.H, FF}; pg8::gemm_phase<pg8::EpiSwiglu, pg8::StaticOrder, PG8_ALIGN, PG8_SP2>(F.lds, g, S, E); } SEAM(10);
    if (IN(11)) REP(11) { pg8::Gemm g{F.H, F.W2D, M, D, FF}; pg8::SplitOrder S; S.init(FF, SPLIT_DN, F.G, (int)blockIdx.x);
        pg8::EpiResid E{F.out, F.out + (size_t)NP * D, F.out, F.mod, 8, 0.5f, F.part}; pg8::gemm_phase<pg8::EpiResid, pg8::SplitOrder, PG8_ALIGN, PG8_SP2>(F.lds, g, S, E); } SEAM(11);
    if (IN(12)) REP(12) { final_norm(F, SPLIT_DN); }
#undef IN
#undef SEAM
}

extern "C" void kernel_launch(void* const* d_in, const int* in_sizes, int n_in, void* d_out, int out_size, void* d_ws, size_t ws_size, hipStream_t stream) {
    static int grid = 0;
    if (grid == 0) {
        if (n_in != 29 || in_sizes[0] != NP * D || (size_t)out_size != O_END || ws_size < WS_END) {
            fprintf(stderr, "kernel_launch: unexpected shapes: n_in %d in0 %d out %d ws %zu\n", n_in, n_in > 0 ? in_sizes[0] : -1, out_size, ws_size); grid = -1; return; }
        int dev = 0, cus = 0, per_cu = 0;
        (void)hipGetDevice(&dev); (void)hipDeviceGetAttribute(&cus, hipDeviceAttributeMultiprocessorCount, dev);
        if (hipFuncSetAttribute((const void*)fwd_kernel, hipFuncAttributeMaxDynamicSharedMemorySize, LDS_BYTES) != hipSuccess) { fprintf(stderr, "kernel_launch: hipFuncSetAttribute failed\n"); grid = -1; return; }
        if (hipOccupancyMaxActiveBlocksPerMultiprocessor(&per_cu, (const void*)fwd_kernel, NWAVES * 64, LDS_BYTES) != hipSuccess || per_cu < 1) { fprintf(stderr, "kernel_launch: occupancy query says %d\n", per_cu); per_cu = 1; }
        (void)hipGetLastError();
        grid = cus * per_cu;
        fprintf(stderr, "kernel_launch: cus %d per_cu %d grid %d\n", cus, per_cu, grid);
    }
    if (grid < 0) return;
    if (hipMemsetAsync((char*)d_ws + WS_CTL, 0, CTL_ZERO_BYTES, stream) != hipSuccess) { fprintf(stderr, "kernel_launch: memset failed\n"); return; }
    Args a{};
    for (int i = 0; i < 29; ++i) a.in[i] = (const float*)d_in[i];
    a.out = (float*)d_out; a.ws = (unsigned char*)d_ws;
#if MK_N_LAUNCHES == 1
    a.ph_lo = 0; a.ph_hi = N_PHASES;
    void* kargs[] = {&a};
    hipError_t e = hipLaunchCooperativeKernel((const void*)fwd_kernel, dim3(grid), dim3(NWAVES * 64), kargs, LDS_BYTES, stream);
    if (e != hipSuccess) fprintf(stderr, "kernel_launch: cooperative launch failed: %s (grid %d)\n", hipGetErrorString(e), grid);
#else
    for (int li = 0; li < N_PHASES; ++li) {
        a.ph_lo = li; a.ph_hi = li + 1;
        hipLaunchKernelGGL(fwd_kernel, dim3(grid), dim3(NWAVES * 64), LDS_BYTES, stream, a);
    }
#endif
}
```

```cpp
#include <hip/hip_runtime.h>
#include <hip/hip_cooperative_groups.h>
#include <cstdio>
#include <cstdint>
namespace cg = cooperative_groups;

#ifndef MK_N_LAUNCHES
#define MK_N_LAUNCHES 1
#endif

constexpr int D = 1024, NP = 16384, NS = 512, M = NP + NS, FF = 3072, DIN = 2560, DL = 512;
constexpr int TP = 2048, NBATCH = 136, NMOD = 9;
constexpr float EPS = 1e-6f;
__device__ __forceinline__ int row_batch(int r) { return r < NP ? (r >> 11) : 8 + ((r - NP) >> 2); }

namespace pg8 {
#define PG8_LAS __attribute__((address_space(3)))
typedef unsigned short bf16_t;
typedef short bf16x8 __attribute__((ext_vector_type(8)));
typedef float f32x4 __attribute__((ext_vector_type(4)));
typedef unsigned u32x4 __attribute__((ext_vector_type(4)));
constexpr int BM = 256, BK = 64, HALF = 128, HTB = HALF * BK * 2  , STAGE_BYTES = 8 * HTB, NXCD = 8, WGM = 8;

__host__ __device__ __forceinline__ int lds_byte(int r, int c) { const int st = (r >> 4) * 2 + (c >> 5), rr = r & 15, cc = c & 31, ob = rr * 64 + cc * 2; return st * 1024 + (ob ^ (((ob >> 9) & 1) << 5)); }
__host__ __device__ __forceinline__ void stage_rc(int b, int& R, int& C) { const int st = b / 1024, sb = b % 1024, swz = sb ^ (((sb >> 9) & 1) << 5); R = (st >> 1) * 16 + swz / 64; C = (st & 1) * 32 + (swz % 64) / 2; }
__host__ __device__ __forceinline__ int perm32(int rho) { const int n = rho >> 4, i = rho & 15; return 8 * (i >> 2) + 4 * n + (i & 3); }

struct Unit { int pm, pn, kt0, nkt, slab; };
struct Gemm { const bf16_t* A; const bf16_t* Bt; int M, N, K; };

struct StaticOrder {
    int nM, nN, nwg, G, c, nkt;
    __host__ __device__ void init(int M, int N, int K, int G_, int c_) { nM = M / BM; nN = N / BM; nwg = nM * nN; G = G_; c = c_; nkt = K / BK; }
    __host__ __device__ __forceinline__ bool next(int i, Unit& u) const {
        const long L = (long)i * G + c; if (L >= nwg) return false;
        int wgid = (int)L; { const int q = nwg / NXCD, r = nwg % NXCD, xcd = wgid % NXCD, off = wgid / NXCD; wgid = (xcd < r ? xcd * (q + 1) : r * (q + 1) + (xcd - r) * q) + off; }
        const int nig = WGM * nN, gid = wgid / nig, fm = gid * WGM, gsz = (nM - fm) < WGM ? (nM - fm) : WGM;
        u.pm = fm + ((wgid % nig) % gsz); u.pn = (wgid % nig) / gsz; u.kt0 = 0; u.nkt = nkt; u.slab = -1; return true;
    }
    __device__ __forceinline__ void a_ready(const Unit&) const {}
    __device__ __forceinline__ void done(const Unit&) const {}
};
struct SplitOrder {
    StaticOrder P; int G, c, S, nkt;
    __host__ __device__ void init(int K, int S_, int G_, int c_) { P.init(64 * BM, 4 * BM, K, 1, 0); G = G_; c = c_; S = S_; nkt = K / BK; }
    __host__ __device__ __forceinline__ bool next(int i, Unit& u) const {
        const int L = i * G + c;
        if (L >= 256 + 8 * S) return false;
        const bool pr = L < 256; const int r = L - 256, t = r & 7, s = r >> 3, ns = nkt / S;
        const int w = (L & 7) * 32 + (L >> 3);
        u.pm = pr ? ((w >> 5) * 8 + (w & 7)) : 64 + (t >> 2); u.pn = pr ? ((w & 31) >> 3) : (t & 3);
        u.kt0 = pr ? 0 : s * ns; u.nkt = pr ? nkt : ns; u.slab = pr ? -1 : s; return true;
    }
    __device__ __forceinline__ void a_ready(const Unit&) const {}
    __device__ __forceinline__ void done(const Unit&) const {}
};


__device__ __forceinline__ unsigned cvt_pk_bf16(float lo, float hi) { unsigned r; asm volatile("v_cvt_pk_bf16_f32 %0, %1, %2" : "=v"(r) : "v"(lo), "v"(hi)); return r; }
__device__ __forceinline__ float silu_f(float g) { return g * __builtin_amdgcn_rcpf(1.0f + __builtin_amdgcn_exp2f(g * -1.44269504089f)); }

struct EpiBf16 {
    static constexpr bool PERM = true, AFTER_DRAIN = false;
    bf16_t* O; int ldc;
    __device__ __forceinline__ void operator()(const f32x4 (&acc)[2][2][4][2], const Unit& u, int wr, int wc, int fr, int fq) const {
        const int row0 = u.pm * BM + wr * 64 + fr; const int col0 = u.pn * BM + wc * 32 + 8 * fq;
#pragma unroll
        for (int ai = 0; ai < 2; ++ai)
#pragma unroll
            for (int m = 0; m < 4; ++m) { bf16_t* rowp = O + (size_t)(row0 + ai * HALF + m * 16) * ldc + col0;
#pragma unroll
                for (int bj = 0; bj < 2; ++bj) { const f32x4 v0 = acc[ai][bj][m][0], v1 = acc[ai][bj][m][1];
                    u32x4 w; w.x = cvt_pk_bf16(v0[0], v0[1]); w.y = cvt_pk_bf16(v0[2], v0[3]); w.z = cvt_pk_bf16(v1[0], v1[1]); w.w = cvt_pk_bf16(v1[2], v1[3]);
                    *(u32x4*)(rowp + bj * HALF) = w; } }
    }
};
struct EpiSwiglu {
    static constexpr bool PERM = true, AFTER_DRAIN = false;
    bf16_t* O; int ldc;
    __device__ __forceinline__ void operator()(const f32x4 (&acc)[2][2][4][2], const Unit& u, int wr, int wc, int fr, int fq) const {
        const int row0 = u.pm * BM + wr * 64 + fr; const int col0 = u.pn * HALF + wc * 32 + 8 * fq;
#pragma unroll
        for (int ai = 0; ai < 2; ++ai)
#pragma unroll
            for (int m = 0; m < 4; ++m) { bf16_t* rowp = O + (size_t)(row0 + ai * HALF + m * 16) * ldc + col0;
                const f32x4 g0 = acc[ai][0][m][0], g1 = acc[ai][0][m][1], u0 = acc[ai][1][m][0], u1 = acc[ai][1][m][1];
                u32x4 w;
                w.x = cvt_pk_bf16(silu_f(g0[0]) * u0[0], silu_f(g0[1]) * u0[1]); w.y = cvt_pk_bf16(silu_f(g0[2]) * u0[2], silu_f(g0[3]) * u0[3]);
                w.z = cvt_pk_bf16(silu_f(g1[0]) * u1[0], silu_f(g1[1]) * u1[1]); w.w = cvt_pk_bf16(silu_f(g1[2]) * u1[2], silu_f(g1[3]) * u1[3]);
                *(u32x4*)rowp = w; }
    }
};
struct EpiResid {
    static constexpr bool PERM = false, AFTER_DRAIN = false;
    const float* baseP; const float* baseS; float* out; const float* mod; int idx; float fac; float* part;
    __device__ __forceinline__ void operator()(const f32x4 (&acc)[2][2][4][2], const Unit& u, int wr, int wc, int fr, int fq) const {
        const int colb = u.pn * BM + wc * 32 + 4 * fq;
        if (u.slab >= 0) {
#pragma unroll
            for (int ai = 0; ai < 2; ++ai)
#pragma unroll
                for (int m = 0; m < 4; ++m) {
                    const int r = u.pm * BM + ai * HALF + wr * 64 + m * 16 + fr;
                    const float* mp = mod + (size_t)(row_batch(r) * NMOD + idx) * D;
                    float* pp = part + ((size_t)u.slab * NS + (r - NP)) * D;
#pragma unroll
                    for (int bj = 0; bj < 2; ++bj)
#pragma unroll
                        for (int n = 0; n < 2; ++n) { const int c = colb + bj * HALF + n * 16; const f32x4 mv = *(const f32x4*)(mp + c);
                            *(f32x4*)(pp + c) = (mv * fac) * acc[ai][bj][m][n]; }
                    if (m & 1) asm volatile("" ::: "memory"); }
            return;
        }
#pragma unroll
        for (int ai = 0; ai < 2; ++ai)
#pragma unroll
            for (int m = 0; m < 4; ++m) {
                const int r = u.pm * BM + ai * HALF + wr * 64 + m * 16 + fr;
                const float* bp = (r < NP) ? baseP + (size_t)r * D : baseS + (size_t)(r - NP) * D;
                const float* mp = mod + (size_t)(row_batch(r) * NMOD + idx) * D;
                float* op = out + (size_t)r * D;
#pragma unroll
                for (int bj = 0; bj < 2; ++bj)
#pragma unroll
                    for (int n = 0; n < 2; ++n) { const int c = colb + bj * HALF + n * 16;
                        const f32x4 bs = *(const f32x4*)(bp + c); const f32x4 mv = *(const f32x4*)(mp + c);
                        *(f32x4*)(op + c) = bs + (mv * fac) * acc[ai][bj][m][n]; }
                if (m & 1) asm volatile("" ::: "memory"); }
    }
};

template <class Epi, class Sched, bool ALIGN_EPI = false, bool SP2 = false>
__device__ __forceinline__ void gemm_phase(PG8_LAS unsigned char* lds, const Gemm g, const Sched& S, const Epi& E) {
    const int tid = threadIdx.x, wid = __builtin_amdgcn_readfirstlane(tid >> 6), lane = tid & 63, wr = wid >> 2, wc = wid & 3, fr = lane & 15, fq = lane >> 4;
    const int K = g.K;
    unsigned voffA[2], voffB[2];
#pragma unroll
    for (int i = 0; i < 2; ++i) { int R, C; stage_rc(tid * 16 + i * 8192, R, C); const int Rb = Epi::PERM ? ((R & ~31) + perm32(R & 31)) : R;
        voffA[i] = (unsigned)(R * K + C) * 2u; voffB[i] = (unsigned)(Rb * K + C) * 2u; }
    const size_t kstep = (size_t)(BK * 2);
    const size_t hstep = (size_t)HALF * K * 2;
    const size_t tstep = 2 * hstep;
    const unsigned ldsw = (unsigned)wid * 1024u;
    const int aoff = lds_byte(wr * 64 + fr, fq * 8), boff = lds_byte(wc * 32 + fr, fq * 8);
#define PG8_SA(b, h) (((b) * 2 + (h)) * HTB)
#define PG8_SB(b, h) ((4 + (b) * 2 + (h)) * HTB)
#define PG8_STAGE(bufoff, gbase, voff) do { _Pragma("unroll") for (int _i = 0; _i < 2; ++_i) \
        __builtin_amdgcn_global_load_lds((const unsigned*)((const char*)(gbase) + (voff)[_i]), (PG8_LAS unsigned*)(lds + (bufoff) + ldsw + _i * 8192), 16, 0, 0); } while (0)
#define PG8_LDA(dst, b, h) do { _Pragma("unroll") for (int m = 0; m < 4; ++m) _Pragma("unroll") for (int k = 0; k < 2; ++k) dst[m][k] = *(const PG8_LAS bf16x8*)(lds + PG8_SA(b, h) + aoff + m * 2048 + k * 1024); } while (0)
#define PG8_LDB(dst, b, h) do { _Pragma("unroll") for (int n = 0; n < 2; ++n) _Pragma("unroll") for (int k = 0; k < 2; ++k) dst[n][k] = *(const PG8_LAS bf16x8*)(lds + PG8_SB(b, h) + boff + n * 2048 + k * 1024); } while (0)
#define PG8_MMA(ai, bj, At, Bt) do { __builtin_amdgcn_s_setprio(1); _Pragma("unroll") for (int m = 0; m < 4; ++m) _Pragma("unroll") for (int n = 0; n < 2; ++n) _Pragma("unroll") for (int k = 0; k < 2; ++k) \
        acc[ai][bj][m][n] = __builtin_amdgcn_mfma_f32_16x16x32_bf16(Bt[n][k], At[m][k], acc[ai][bj][m][n], 0, 0, 0); __builtin_amdgcn_s_setprio(0); } while (0)
#define PG8_WAIT_V(n) asm volatile("s_waitcnt vmcnt(" #n ")" ::: "memory")
#define PG8_WAIT_L(n) asm volatile("s_waitcnt lgkmcnt(" #n ")" ::: "memory")
#define PG8_BAR __builtin_amdgcn_s_barrier()
#define PG8_SCHED __builtin_amdgcn_sched_barrier(0)
    Unit cur, nxt; int ui = 0;
    if (!S.next(0, cur)) return;
    f32x4 acc[2][2][4][2];
#pragma unroll
    for (int a = 0; a < 2; ++a)
#pragma unroll
        for (int b = 0; b < 2; ++b)
#pragma unroll
            for (int m = 0; m < 4; ++m)
#pragma unroll
                for (int n = 0; n < 2; ++n) acc[a][b][m][n] = (f32x4){0.f, 0.f, 0.f, 0.f};
    bf16x8 At[4][2], B0[2][2], B1[2][2];
    const char* cA = (const char*)g.A + (size_t)cur.pm * tstep + (size_t)cur.kt0 * kstep; const char* cB = (const char*)g.Bt + (size_t)cur.pn * tstep + (size_t)cur.kt0 * kstep;
    S.a_ready(cur);
    if constexpr (SP2) {
        PG8_STAGE(PG8_SB(0, 0), cB, voffB); PG8_STAGE(PG8_SB(0, 1), cB + hstep, voffB); PG8_STAGE(PG8_SA(0, 0), cA, voffA); PG8_STAGE(PG8_SA(0, 1), cA + hstep, voffA);
        if (wr == 1) PG8_BAR;
        PG8_WAIT_V(2); PG8_BAR;
        PG8_STAGE(PG8_SB(1, 0), cB + kstep, voffB); PG8_STAGE(PG8_SA(1, 0), cA + kstep, voffA); PG8_STAGE(PG8_SB(1, 1), cB + hstep + kstep, voffB);
        PG8_WAIT_V(6); PG8_BAR;
    } else {
        PG8_STAGE(PG8_SB(0, 0), cB, voffB); PG8_STAGE(PG8_SA(0, 0), cA, voffA); PG8_STAGE(PG8_SB(0, 1), cB + hstep, voffB); PG8_STAGE(PG8_SA(0, 1), cA + hstep, voffA);
        if (wr == 1) PG8_BAR;
        PG8_WAIT_V(4); PG8_BAR;
        PG8_STAGE(PG8_SB(1, 0), cB + kstep, voffB); PG8_STAGE(PG8_SA(1, 0), cA + kstep, voffA); PG8_STAGE(PG8_SB(1, 1), cB + hstep + kstep, voffB);
        PG8_WAIT_V(6); PG8_BAR;
    }
    for (;;) {
        const bool has_next = S.next(ui + 1, nxt);
        const char* nA = has_next ? (const char*)g.A + (size_t)nxt.pm * tstep + (size_t)nxt.kt0 * kstep : cA; const char* nB = has_next ? (const char*)g.Bt + (size_t)nxt.pn * tstep + (size_t)nxt.kt0 * kstep : cB;
        const int nt = cur.nkt;
        for (int t = 0; t < nt; t += 2) {
            const bool last = (t == nt - 2);
            const char* a1 = cA + (size_t)(t + 1) * kstep;
            const char* a2 = last ? nA : cA + (size_t)(t + 2) * kstep; const char* b2 = last ? nB : cB + (size_t)(t + 2) * kstep;
            const char* a3 = a2 + kstep; const char* b3 = b2 + kstep;
            if (last && has_next) S.a_ready(nxt);
            if constexpr (SP2) {
            PG8_LDB(B0, 0, 0); PG8_LDB(B1, 0, 1); PG8_SCHED; PG8_LDA(At, 0, 0); PG8_STAGE(PG8_SA(1, 1), a1 + hstep, voffA);
            PG8_WAIT_V(8); PG8_WAIT_L(0); PG8_BAR; PG8_MMA(0, 0, At, B0); PG8_MMA(0, 1, At, B1); PG8_BAR; PG8_SCHED;
            PG8_LDA(At, 0, 1); PG8_STAGE(PG8_SB(0, 0), b2, voffB); PG8_STAGE(PG8_SB(0, 1), b2 + hstep, voffB); PG8_STAGE(PG8_SA(0, 0), a2, voffA);
            PG8_WAIT_V(8); PG8_WAIT_L(0); PG8_BAR; PG8_MMA(1, 0, At, B0); PG8_MMA(1, 1, At, B1); PG8_BAR; PG8_SCHED;
            PG8_LDB(B0, 1, 0); PG8_LDB(B1, 1, 1); PG8_SCHED; PG8_LDA(At, 1, 0); PG8_STAGE(PG8_SA(0, 1), a2 + hstep, voffA);
            PG8_WAIT_V(8); PG8_WAIT_L(0); PG8_BAR; PG8_MMA(0, 0, At, B0); PG8_MMA(0, 1, At, B1); PG8_BAR; PG8_SCHED;
            PG8_LDA(At, 1, 1); PG8_STAGE(PG8_SB(1, 0), b3, voffB); PG8_STAGE(PG8_SB(1, 1), b3 + hstep, voffB); PG8_STAGE(PG8_SA(1, 0), a3, voffA);
            PG8_WAIT_V(8); PG8_WAIT_L(0); PG8_BAR; PG8_MMA(1, 0, At, B0); PG8_MMA(1, 1, At, B1); PG8_BAR; PG8_SCHED;
            } else {
            PG8_LDB(B0, 0, 0); PG8_SCHED; PG8_LDA(At, 0, 0); PG8_STAGE(PG8_SA(1, 1), a1 + hstep, voffA);
            PG8_WAIT_L(8); PG8_BAR; PG8_WAIT_L(0); PG8_MMA(0, 0, At, B0); PG8_BAR; PG8_SCHED;
            PG8_LDB(B1, 0, 1); PG8_STAGE(PG8_SB(0, 0), b2, voffB);
            PG8_BAR; PG8_WAIT_L(0); PG8_MMA(0, 1, At, B1); PG8_BAR;
            PG8_LDA(At, 0, 1); PG8_STAGE(PG8_SA(0, 0), a2, voffA);
            PG8_BAR; PG8_WAIT_L(0); PG8_MMA(1, 0, At, B0); PG8_BAR; PG8_SCHED;
            PG8_STAGE(PG8_SB(0, 1), b2 + hstep, voffB);
            PG8_WAIT_V(6); PG8_BAR; PG8_MMA(1, 1, At, B1); PG8_BAR;
            PG8_LDB(B0, 1, 0); PG8_SCHED; PG8_LDA(At, 1, 0); PG8_STAGE(PG8_SA(0, 1), a2 + hstep, voffA);
            PG8_WAIT_L(8); PG8_BAR; PG8_WAIT_L(0); PG8_MMA(0, 0, At, B0); PG8_BAR; PG8_SCHED;
            PG8_LDB(B1, 1, 1); PG8_STAGE(PG8_SB(1, 0), b3, voffB);
            PG8_BAR; PG8_WAIT_L(0); PG8_MMA(0, 1, At, B1); PG8_BAR;
            PG8_LDA(At, 1, 1); PG8_STAGE(PG8_SA(1, 0), a3, voffA);
            PG8_BAR; PG8_WAIT_L(0); PG8_MMA(1, 0, At, B0); PG8_BAR; PG8_SCHED;
            PG8_STAGE(PG8_SB(1, 1), b3 + hstep, voffB);
            PG8_WAIT_V(6); PG8_BAR; PG8_MMA(1, 1, At, B1); PG8_BAR;
            }
        }
        if constexpr (ALIGN_EPI) { if (wr == 0) PG8_BAR; }
        if constexpr (!Epi::AFTER_DRAIN) { E(acc, cur, wr, wc, fr, fq); S.done(cur); }
        if (!has_next) break;
#pragma unroll
        for (int a = 0; a < 2; ++a)
#pragma unroll
            for (int b = 0; b < 2; ++b)
#pragma unroll
                for (int m = 0; m < 4; ++m)
#pragma unroll
                    for (int n = 0; n < 2; ++n) acc[a][b][m][n] = (f32x4){0.f, 0.f, 0.f, 0.f};
        cur = nxt; cA = nA; cB = nB; ++ui;
        if constexpr (ALIGN_EPI) { if (wr == 1) PG8_BAR; }
    }
    PG8_WAIT_V(0);
    if constexpr (!ALIGN_EPI) { if (wr == 0) PG8_BAR; }
    PG8_BAR;
    if constexpr (Epi::AFTER_DRAIN) { E.fused(acc, cur, wr, wc, fr, fq, lds, wid, lane); S.done(cur); }
#undef PG8_SA
#undef PG8_SB
#undef PG8_STAGE
#undef PG8_LDA
#undef PG8_LDB
#undef PG8_MMA
#undef PG8_WAIT_V
#undef PG8_WAIT_L
#undef PG8_BAR
#undef PG8_SCHED
}
}
#ifndef PG8_SP2
#define PG8_SP2 true
#endif
#ifndef PG8_ALIGN
#define PG8_ALIGN true
#endif

constexpr int NWAVES = 8;
constexpr int N_PHASES = 13;
constexpr size_t MiB = 1u << 20;
constexpr size_t WS_CTL = 0, CTL_ZERO_BYTES = 16384;
constexpr size_t WS_MOD = 1 * MiB;
constexpr size_t WS_AGG = 6 * MiB, WS_WG = 7 * MiB;
constexpr size_t WS_W1GU = 8 * MiB, WS_W1D = 20 * MiB, WS_WMI = 26 * MiB, WS_WMO = 31 * MiB, WS_W2GU = 33 * MiB, WS_W2D = 45 * MiB;
constexpr size_t WS_XN = 52 * MiB;
constexpr size_t WS_H = 86 * MiB;
constexpr size_t WS_PART = 186 * MiB;
constexpr size_t WS_END = 202 * MiB;
constexpr size_t O_YP = 0, O_YS = (size_t)NP * D, O_CP = O_YS + (size_t)NS * D, O_HP = O_CP + 8 * 3 * 512, O_SP = O_HP + 8 * 512,
                 O_CS = O_SP + 8 * 2 * 512, O_HS = O_CS + 128 * 3 * 512, O_SS = O_HS + 128 * 512, O_END = O_SS + 128 * 2 * 512;
constexpr int LDS_BYTES = 147456, MISC_OFF = LDS_BYTES - 16;

#define LAS __attribute__((address_space(3)))
typedef unsigned short bf16;
typedef unsigned v4u __attribute__((ext_vector_type(4)));
typedef float f32x4 __attribute__((ext_vector_type(4)));
typedef short bf16x8 __attribute__((ext_vector_type(8)));
#define LDS_WAIT() asm volatile("s_waitcnt lgkmcnt(0)" ::: "memory")
__device__ __forceinline__ unsigned f2bf(float f) { unsigned u = __builtin_bit_cast(unsigned, f); return (u + 0x7fffu + ((u >> 16) & 1u)) >> 16; }
__device__ __forceinline__ unsigned pk2(float lo, float hi) { return f2bf(lo) | (f2bf(hi) << 16); }
__device__ __forceinline__ float bf2f(unsigned short h) { return __builtin_bit_cast(float, (unsigned)h << 16); }
__device__ __forceinline__ float bflo(unsigned w) { return __builtin_bit_cast(float, w << 16); }
__device__ __forceinline__ float bfhi(unsigned w) { return __builtin_bit_cast(float, w & 0xffff0000u); }
__device__ __forceinline__ void unpack8(const v4u v, float (&o)[8]) { o[0] = bflo(v.x); o[1] = bfhi(v.x); o[2] = bflo(v.y); o[3] = bfhi(v.y); o[4] = bflo(v.z); o[5] = bfhi(v.z); o[6] = bflo(v.w); o[7] = bfhi(v.w); }
__device__ __forceinline__ v4u pack8(const float (&o)[8]) { v4u v; v.x = pk2(o[0], o[1]); v.y = pk2(o[2], o[3]); v.z = pk2(o[4], o[5]); v.w = pk2(o[6], o[7]); return v; }
__device__ __forceinline__ void ld8f(const float* p, float (&o)[8]) { const f32x4 a = *(const f32x4*)p, b = *(const f32x4*)(p + 4); o[0] = a.x; o[1] = a.y; o[2] = a.z; o[3] = a.w; o[4] = b.x; o[5] = b.y; o[6] = b.z; o[7] = b.w; }
__device__ __forceinline__ void st8f(float* p, const float (&o)[8]) { *(f32x4*)p = (f32x4){o[0], o[1], o[2], o[3]}; *(f32x4*)(p + 4) = (f32x4){o[4], o[5], o[6], o[7]}; }
__device__ __forceinline__ float sigmoid_f(float x) { return __builtin_amdgcn_rcpf(1.0f + __builtin_amdgcn_exp2f(x * -1.44269504089f)); }
__device__ __forceinline__ float wave_sum(float v) {
#pragma unroll
    for (int o = 1; o < 64; o <<= 1) v += __shfl_xor(v, o);
    return v;
}

#define RLX_AGENT __ATOMIC_RELAXED, __HIP_MEMORY_SCOPE_AGENT
#define XB_TMO      128
#define XB_XCNT(j)  (256  + 64 * (j))
#define XB_XSUB(j)  (1280 + 64 * (j))
#define XB_XGEN(j)  (2304 + 64 * (j))
#define XB_TOP      3328
#define XB_TOPGEN   3392
#define XCD_BAR_WORDS 3456
#define XB_SPIN_CAP (1u << 18)

__device__ __forceinline__ unsigned xb_ld(unsigned* p)              { return __hip_atomic_load(p, __ATOMIC_RELAXED, __HIP_MEMORY_SCOPE_AGENT); }
__device__ __forceinline__ unsigned xb_add(unsigned* p, unsigned v) { return __hip_atomic_fetch_add(p, v, __ATOMIC_RELAXED, __HIP_MEMORY_SCOPE_AGENT); }
__device__ __forceinline__ unsigned xb_xcc_id() { return (unsigned)__builtin_amdgcn_s_getreg((3 << 11) | 20) & 0xFu; }
#define XB_SPIN(cond, bar) do { unsigned _sp = 0; while (cond) { __builtin_amdgcn_s_sleep(1); \
    if ((++_sp & 255u) == 0u) { if (xb_ld(&(bar)[XB_TMO])) break; if (_sp > XB_SPIN_CAP) { atomicAdd(&(bar)[XB_TMO], 1u); break; } } } } while (0)

struct XcdBarrier {
    unsigned* bar; unsigned x;
    volatile LAS unsigned* st;
};

__device__ __forceinline__ XcdBarrier xcd_barrier_post(unsigned* bar, volatile LAS unsigned* st) {
    XcdBarrier b; b.bar = bar; b.x = xb_xcc_id(); b.st = st;
    if (threadIdx.x == 0) (void)xb_add(&bar[XB_XCNT(b.x)], 1u);
    return b;
}
__device__ __forceinline__ void xcd_barrier_complete(unsigned* bar, unsigned x, unsigned& nloc, unsigned& nx) {
    const unsigned G = gridDim.x * gridDim.y * gridDim.z;
    unsigned sum, cnt, mine, sp = 0u;
    for (;;) {
        sum = 0u; cnt = 0u; mine = 0u;
#pragma unroll
        for (unsigned j = 0; j < 16; ++j) { const unsigned c = xb_ld(&bar[XB_XCNT(j)]); sum += c; cnt += (c > 0u) ? 1u : 0u; mine = (j == x) ? c : mine; }
        if (sum == G) break;
        __builtin_amdgcn_s_sleep(1);
        if ((++sp & 255u) == 0u) { if (xb_ld(&bar[XB_TMO])) break; if (sp > XB_SPIN_CAP) { atomicAdd(&bar[XB_TMO], 1u); break; } }
    }
    nloc = mine > 0u ? mine : 1u; nx = cnt > 0u ? cnt : 1u;
}

__device__ __forceinline__ void xcd_barrier(const XcdBarrier& b) {
    asm volatile("s_waitcnt vmcnt(0)" ::: "memory");
    __syncthreads();
    if (threadIdx.x == 0) {
        unsigned* bar = b.bar;
        __builtin_amdgcn_s_waitcnt(0);
        unsigned nloc = b.st[0], nx = b.st[1];
        if (nloc == 0u) { xcd_barrier_complete(bar, b.x, nloc, nx); b.st[0] = nloc; b.st[1] = nx; }
        const unsigned old = xb_add(&bar[XB_XSUB(b.x)], 1u);
        const unsigned gen = old / nloc;
        if (old + 1u == (gen + 1u) * nloc) {
            __builtin_amdgcn_fence(__ATOMIC_RELEASE, "agent");
            asm volatile("s_waitcnt vmcnt(0)" ::: "memory");
            const unsigned og = xb_add(&bar[XB_TOP], 1u);
            const unsigned tg = og / nx;
            if (og + 1u == (tg + 1u) * nx) xb_add(&bar[XB_TOPGEN], 1u);
            else XB_SPIN(xb_ld(&bar[XB_TOPGEN]) == tg, bar);
            __builtin_amdgcn_fence(__ATOMIC_ACQUIRE, "agent");
            xb_add(&bar[XB_XGEN(b.x)], 1u);
            asm volatile("s_waitcnt vmcnt(0)" ::: "memory");
        } else {
            XB_SPIN(xb_ld(&bar[XB_XGEN(b.x)]) == gen, bar);
            __builtin_amdgcn_fence(__ATOMIC_ACQUIRE, "agent");
            asm volatile("s_waitcnt vmcnt(0)" ::: "memory");
        }
    }
    __syncthreads();
}

struct Frame {
    LAS unsigned char* lds;
    int tid, lane, wave, G;
    const float* in[29];
    float* out;
    float* mod; float* agg; float* part;
    bf16 *W1GU, *W1D, *WMI, *WMO, *W2GU, *W2D, *XN, *U, *H, *Z, *WG;
};

constexpr int TR_SCR = 64 * 65 * 4;
__device__ __forceinline__ void transpose_item(const float* W, int K, int N, bf16* WT, int mode, LAS float* scr, int item, int lane) {
    const int nblk = N / 64, kb = item / nblk, nb = item % nblk, k0 = 64 * kb, n0 = 64 * nb;
    const int rbase = (mode == 0) ? n0 : (256 * (n0 >> 7) + (n0 & 127) + (mode == 2 ? 128 : 0));
    const int kr = lane >> 4, n4 = (lane & 15) * 4;
    f32x4 v[16];
#pragma unroll
    for (int i = 0; i < 16; ++i) v[i] = *(const f32x4*)(W + (size_t)(k0 + kr + 4 * i) * N + n0 + n4);
#pragma unroll
    for (int i = 0; i < 16; ++i) { LAS float* d = scr + (kr + 4 * i) * 65 + n4; d[0] = v[i].x; d[1] = v[i].y; d[2] = v[i].z; d[3] = v[i].w; }
    LDS_WAIT(); asm volatile("" ::: "memory");
    const int c = lane & 7;
#pragma unroll
    for (int j = 0; j < 8; ++j) { const int n = (lane >> 3) + 8 * j; const LAS float* sp = scr + (8 * c) * 65 + n;
        v4u o; o.x = pk2(sp[0 * 65], sp[1 * 65]); o.y = pk2(sp[2 * 65], sp[3 * 65]); o.z = pk2(sp[4 * 65], sp[5 * 65]); o.w = pk2(sp[6 * 65], sp[7 * 65]);
        *(v4u*)(WT + (size_t)(rbase + n) * K + k0 + 8 * c) = o; }
    LDS_WAIT(); asm volatile("" ::: "memory");
}
constexpr int I_GU = (D / 64) * (FF / 64), I_DN = (FF / 64) * (D / 64), I_MI = (D / 64) * (DIN / 64), I_MO = (D / 64) * (D / 64);
static_assert(I_GU == I_DN, "item counts");
__device__ __forceinline__ void transpose_set(Frame& F, int set, int wi, int nw) {
    LAS float* scr = (LAS float*)(F.lds + F.wave * TR_SCR);
    if (set == 0) {
        for (int it = wi; it < 2 * I_GU; it += nw) { if (it < I_GU) transpose_item(F.in[10], D, FF, F.W1GU, 1, scr, it, F.lane); else transpose_item(F.in[11], D, FF, F.W1GU, 2, scr, it - I_GU, F.lane); }
    } else if (set == 1) {
        for (int it = wi; it < I_DN + I_MI + I_MO; it += nw) {
            if (it < I_DN) transpose_item(F.in[12], FF, D, F.W1D, 0, scr, it, F.lane);
            else if (it < I_DN + I_MI) transpose_item(F.in[14], D, DIN, F.WMI, 0, scr, it - I_DN, F.lane);
            else transpose_item(F.in[23], D, D, F.WMO, 0, scr, it - I_DN - I_MI, F.lane); }
    } else if (set == 2) {
        for (int it = wi; it < 2 * I_GU; it += nw) { if (it < I_GU) transpose_item(F.in[25], D, FF, F.W2GU, 1, scr, it, F.lane); else transpose_item(F.in[26], D, FF, F.W2GU, 2, scr, it - I_GU, F.lane); }
    } else {
        for (int it = wi; it < I_DN; it += nw) transpose_item(F.in[27], FF, D, F.W2D, 0, scr, it, F.lane);
    }
}
__device__ __forceinline__ void p0_prologue(Frame& F) {
    if (blockIdx.x < 192) {
        const float* cP = F.in[5]; const float* cS = F.in[6]; const float* wada = F.in[7]; const float* bada = F.in[8];
        const int fr = F.lane & 15, fq = F.lane >> 4, w = F.wave;
        LAS float* red = (LAS float*)F.lds;
        for (int it = blockIdx.x; it < 192; it += F.G) {
            const int n0 = it * 48;
            f32x4 acc[9][3];
#pragma unroll
            for (int mt = 0; mt < 9; ++mt)
#pragma unroll
                for (int t = 0; t < 3; ++t) acc[mt][t] = (f32x4){0.f, 0.f, 0.f, 0.f};
#pragma unroll 1
            for (int kk = 0; kk < 4; ++kk) {
                const int k0 = 128 * w + 32 * kk + 8 * fq;
                bf16x8 bfrag[3];
#pragma unroll
                for (int t = 0; t < 3; ++t) { float bv[8];
#pragma unroll
                    for (int j = 0; j < 8; ++j) bv[j] = wada[(size_t)(k0 + j) * (NMOD * D) + n0 + 16 * t + fr];
                    const v4u bp = pack8(bv); bfrag[t] = __builtin_bit_cast(bf16x8, bp); }
#pragma unroll
                for (int mt = 0; mt < 9; ++mt) {
                    const int row = 16 * mt + fr;
                    float av[8];
                    if (row < NBATCH) { const float* cp = (row < 8) ? cP + (size_t)row * D : cS + (size_t)(row - 8) * D; ld8f(cp + k0, av);
#pragma unroll
                        for (int j = 0; j < 8; ++j) av[j] = av[j] * sigmoid_f(av[j]); }
                    else {
#pragma unroll
                        for (int j = 0; j < 8; ++j) av[j] = 0.f; }
                    const v4u ap = pack8(av); const bf16x8 afrag = __builtin_bit_cast(bf16x8, ap);
#pragma unroll
                    for (int t = 0; t < 3; ++t) acc[mt][t] = __builtin_amdgcn_mfma_f32_16x16x32_bf16(afrag, bfrag[t], acc[mt][t], 0, 0, 0);
                }
            }
            if (w >= 4) {
#pragma unroll
                for (int mt = 0; mt < 9; ++mt)
#pragma unroll
                    for (int t = 0; t < 3; ++t)
#pragma unroll
                        for (int i = 0; i < 4; ++i) red[((w - 4) * 144 + 16 * mt + 4 * fq + i) * 48 + 16 * t + fr] = acc[mt][t][i];
            }
            __syncthreads();
            if (w < 4) {
#pragma unroll
                for (int mt = 0; mt < 9; ++mt)
#pragma unroll
                    for (int t = 0; t < 3; ++t)
#pragma unroll
                        for (int i = 0; i < 4; ++i) { LAS float* q = red + (w * 144 + 16 * mt + 4 * fq + i) * 48 + 16 * t + fr; *q = *q + acc[mt][t][i]; }
            }
            __syncthreads();
            for (int o = F.tid; o < NBATCH * 48; o += NWAVES * 64) {
                const int row = o / 48, c = o % 48; float sacc = bada[n0 + c];
#pragma unroll
                for (int ww = 0; ww < 4; ++ww) sacc += red[(ww * 144 + row) * 48 + c];
                F.mod[(size_t)row * (NMOD * D) + n0 + c] = sacc;
            }
            __syncthreads();
        }
    }
    transpose_set(F, 0, blockIdx.x * NWAVES + F.wave, F.G * NWAVES);
    for (int o = blockIdx.x * (NWAVES * 64) + F.tid; o < 2 * 32768; o += F.G * NWAVES * 64) {
        const int g = o >> 15, r = o & 32767, h = r >> 12, n = (r >> 6) & 63, k = r & 63;
        const float* w = g ? F.in[19] : F.in[17];
        F.WG[o] = (bf16)f2bf(w[(h * 64 + k) * 64 + n]);
    }
}

__device__ __forceinline__ void norm_pass(Frame& F, const float* srcP, const float* srcS, const float* gain, int ishift, int iscale, int nsplit) {
    const int gw = blockIdx.x * NWAVES + F.wave, NGW = F.G * NWAVES;
    const f32x4* gr = (const f32x4*)gain + F.lane;
    f32x4 g[4];
#pragma unroll
    for (int j = 0; j < 4; ++j) g[j] = gr[64 * j];
    for (int m0 = 2 * gw; m0 < M; m0 += 2 * NGW) {
        f32x4 v[2][4];
#pragma unroll
        for (int q = 0; q < 2; ++q) { const int m = m0 + q;
            const f32x4* xr = (const f32x4*)((m < NP) ? srcP + (size_t)m * D : srcS + (size_t)(m - NP) * D) + F.lane;
#pragma unroll
            for (int j = 0; j < 4; ++j) v[q][j] = xr[64 * j]; }
#pragma unroll
        for (int q = 0; q < 2; ++q) { const int m = m0 + q;
            if (m >= NP && nsplit > 0) {
                for (int sp = 0; sp < nsplit; ++sp) { const f32x4* pr = (const f32x4*)(F.part + ((size_t)sp * NS + (m - NP)) * D) + F.lane;
#pragma unroll
                    for (int j = 0; j < 4; ++j) v[q][j] += pr[64 * j]; }
                f32x4* orow = (f32x4*)(F.out + (size_t)m * D) + F.lane;
#pragma unroll
                for (int j = 0; j < 4; ++j) orow[64 * j] = v[q][j];
            }
            const int b = row_batch(m);
            const f32x4* sh = (const f32x4*)(F.mod + (size_t)(b * NMOD + ishift) * D) + F.lane;
            const f32x4* sc = (const f32x4*)(F.mod + (size_t)(b * NMOD + iscale) * D) + F.lane;
            float s = 0.f;
#pragma unroll
            for (int j = 0; j < 4; ++j) s += (v[q][j].x * v[q][j].x + v[q][j].y * v[q][j].y) + (v[q][j].z * v[q][j].z + v[q][j].w * v[q][j].w);
            const float rstd = 1.0f / sqrtf(wave_sum(s) * (1.f / D) + EPS);
            unsigned long long* o8 = (unsigned long long*)(F.XN + (size_t)m * D) + F.lane;
#pragma unroll
            for (int j = 0; j < 4; ++j) { const f32x4 a = sh[64 * j], c = sc[64 * j];
                const f32x4 o = (v[q][j] * rstd) * g[j] * (c + 1.0f) + a;
                o8[64 * j] = (unsigned long long)pk2(o.x, o.y) | ((unsigned long long)pk2(o.z, o.w) << 32); }
        }
    }
}
__device__ __forceinline__ void final_norm(Frame& F, int nsplit) {
    const int gw = blockIdx.x * NWAVES + F.wave, NGW = F.G * NWAVES;
    const f32x4* gr = (const f32x4*)F.in[28] + F.lane;
    f32x4 g[4];
#pragma unroll
    for (int j = 0; j < 4; ++j) g[j] = gr[64 * j];
    for (int m0 = 2 * gw; m0 < M; m0 += 2 * NGW) {
        f32x4 v[2][4];
#pragma unroll
        for (int q = 0; q < 2; ++q) { f32x4* xr = (f32x4*)(F.out + (size_t)(m0 + q) * D) + F.lane;
#pragma unroll
            for (int j = 0; j < 4; ++j) v[q][j] = xr[64 * j]; }
#pragma unroll
        for (int q = 0; q < 2; ++q) { const int m = m0 + q;
            f32x4* xr = (f32x4*)(F.out + (size_t)m * D) + F.lane;
            if (m >= NP) {
                for (int sp = 0; sp < nsplit; ++sp) { const f32x4* pr = (const f32x4*)(F.part + ((size_t)sp * NS + (m - NP)) * D) + F.lane;
#pragma unroll
                    for (int j = 0; j < 4; ++j) v[q][j] += pr[64 * j]; }
            }
            float s = 0.f;
#pragma unroll
            for (int j = 0; j < 4; ++j) s += (v[q][j].x * v[q][j].x + v[q][j].y * v[q][j].y) + (v[q][j].z * v[q][j].z + v[q][j].w * v[q][j].w);
            const float rstd = 1.0f / sqrtf(wave_sum(s) * (1.f / D) + EPS);
#pragma unroll
            for (int j = 0; j < 4; ++j) xr[64 * j] = (v[q][j] * rstd) * g[j];
        }
    }
}

#ifndef NEG_EXPM1
#define NEG_EXPM1(x) (-expm1f(x))
#endif
constexpr int RS = 1040;
constexpr int XL_OFF = 0, XC_OFF = 67 * RS;
static_assert(XC_OFF % 16 == 0 && XC_OFF + 64 * RS <= LDS_BYTES, "mixer LDS map");
constexpr int CARRY_OFF = XC_OFF + 64 * RS;
static_assert(CARRY_OFF % 16 == 0 && CARRY_OFF + 2048 <= MISC_OFF, "mixer LDS map");
__device__ __forceinline__ float neg_expm1(float x, float ex) {
    const float ser = -x * (1.0f + x * (0.5f + x * (0.16666667f + x * 0.041666668f)));
    return x > -0.125f ? ser : 1.0f - ex;
}
template <int PASS>
__device__ __forceinline__ void mixer_mid(Frame& F) {
    const int tid = F.tid, lane = F.lane, fr = lane & 15, fq = lane >> 4;
    LAS unsigned char* lds = F.lds;
    const bf16* Z = F.Z;
    const float* st_conv = F.in[2]; const float* st_h = F.in[3]; const float* st_sc = F.in[4];
    const int nunits = (PASS == 1) ? 264 : 256;
    for (int unit = blockIdx.x; unit < nunits; unit += F.G) {
        const bool samp = unit >= 256;
        const bool full = (PASS == 2) || samp;
        const int row0 = unit * 64;
        const int b = unit >> 5, chunk = unit & 31;
        const int seq0 = (unit - 256) * 16;
        const int chb = 64 * F.wave;
        if (PASS == 2) {
            const float* ap = F.agg + (size_t)(b * 32) * 1024 + tid; float h = 0.f;
            for (int jc = 0; jc < chunk; jc += 8) {
                float A[8], Bv[8];
#pragma unroll
                for (int j = 0; j < 8; ++j) { const bool ok = jc + j < chunk; A[j] = ok ? ap[(size_t)(jc + j) * 1024] : 1.f; Bv[j] = ok ? ap[(size_t)(jc + j) * 1024 + 512] : 0.f; }
#pragma unroll
                for (int j = 0; j < 8; ++j) h = A[j] * h + Bv[j];
            }
            *(LAS float*)(lds + CARRY_OFF + tid * 4) = h;
        }
        for (int p = tid; p < 67 * 64; p += NWAVES * 64) {
            const int hr = p >> 6, c16 = p & 63, tok = hr - 3;
            v4u v = (v4u){0u, 0u, 0u, 0u};
            const bool valid = samp ? (tok >= 0) : (tok >= 0 || chunk > 0);
            if (valid) v = *(const v4u*)(Z + (size_t)(row0 + tok) * DIN + c16 * 8);
            *(LAS v4u*)(lds + XL_OFF + hr * RS + c16 * 16) = v;
        }
        if (PASS == 1) {
            const int ch0 = (tid & 63) * 8, r = tid >> 6;
            const float* wsc = F.in[22];
            float w0[8], w1[8], w2[8]; ld8f(wsc + ch0, w0); ld8f(wsc + 512 + ch0, w1); ld8f(wsc + 1024 + ch0, w2);
            float u2[8], u1[8];
#pragma unroll
            for (int j = 0; j < 8; ++j) { u2[j] = 0.f; u1[j] = 0.f; }
            if (!samp && (r > 0 || chunk > 0)) {
                const bf16* zr = Z + (size_t)(row0 + 8 * r - 2) * DIN + ch0;
                float c[8], v[8];
                unpack8(*(const v4u*)(zr + 1536), c); unpack8(*(const v4u*)(zr + 2048), v);
#pragma unroll
                for (int j = 0; j < 8; ++j) u2[j] = c[j] * v[j];
                unpack8(*(const v4u*)(zr + DIN + 1536), c); unpack8(*(const v4u*)(zr + DIN + 2048), v);
#pragma unroll
                for (int j = 0; j < 8; ++j) u1[j] = c[j] * v[j];
            }
#pragma unroll
            for (int t = 0; t < 8; ++t) {
                const int tok = 8 * r + t; const int seq = seq0 + (tok >> 2);
                if (samp && (t & 3) == 0) { ld8f(st_sc + (size_t)(seq * 2 + 0) * 512 + ch0, u2); ld8f(st_sc + (size_t)(seq * 2 + 1) * 512 + ch0, u1); }
                const bf16* zr = Z + (size_t)(row0 + tok) * DIN + ch0;
                float bs[8], c[8], v[8], u0[8], o[8];
                unpack8(*(const v4u*)(zr + 1024), bs); unpack8(*(const v4u*)(zr + 1536), c); unpack8(*(const v4u*)(zr + 2048), v);
#pragma unroll
                for (int j = 0; j < 8; ++j) { u0[j] = c[j] * v[j]; o[j] = bs[j] * (w0[j] * u2[j] + w1[j] * u1[j] + w2[j] * u0[j]); }
                *(v4u*)(F.U + (size_t)(row0 + tok) * D + 512 + ch0) = pack8(o);
                if (samp) { if ((t & 3) >= 2) st8f(F.out + O_SS + (size_t)(seq * 2 + ((t & 3) - 2)) * 512 + ch0, u0); }
                else if (chunk == 31 && tok >= 62) st8f(F.out + O_SP + (size_t)(b * 2 + (tok - 62)) * 512 + ch0, u0);
#pragma unroll
                for (int j = 0; j < 8; ++j) { u2[j] = u1[j]; u1[j] = u0[j]; }
            }
        }
        __syncthreads();
        {
            const int ch0 = (tid & 63) * 8, r = tid >> 6;
            const float* wc = F.in[15]; const float* bc = F.in[16];
            float w0[8], w1[8], w2[8], w3[8], bb[8];
            ld8f(wc + ch0, w0); ld8f(wc + 512 + ch0, w1); ld8f(wc + 1024 + ch0, w2); ld8f(wc + 1536 + ch0, w3); ld8f(bc + ch0, bb);
            float x3[8], x2[8], x1[8];
            unpack8(*(const LAS v4u*)(lds + XL_OFF + (8 * r + 0) * RS + ch0 * 2), x3);
            unpack8(*(const LAS v4u*)(lds + XL_OFF + (8 * r + 1) * RS + ch0 * 2), x2);
            unpack8(*(const LAS v4u*)(lds + XL_OFF + (8 * r + 2) * RS + ch0 * 2), x1);
#pragma unroll 2
            for (int t = 0; t < 8; ++t) {
                const int tok = 8 * r + t; const int seq = seq0 + (tok >> 2);
                if (samp && (t & 3) == 0) { ld8f(st_conv + (size_t)(seq * 3 + 0) * 512 + ch0, x3); ld8f(st_conv + (size_t)(seq * 3 + 1) * 512 + ch0, x2); ld8f(st_conv + (size_t)(seq * 3 + 2) * 512 + ch0, x1); }
                float x0[8], o[8];
                unpack8(*(const LAS v4u*)(lds + XL_OFF + (tok + 3) * RS + ch0 * 2), x0);
#pragma unroll
                for (int j = 0; j < 8; ++j) o[j] = bb[j] + w3[j] * x0[j] + w2[j] * x1[j] + w1[j] * x2[j] + w0[j] * x3[j];
                *(LAS v4u*)(lds + XC_OFF + tok * RS + ch0 * 2) = pack8(o);
                if (full) {
                    if (samp) { if ((t & 3) >= 1) st8f(F.out + O_CS + (size_t)(seq * 3 + ((t & 3) - 1)) * 512 + ch0, x0); }
                    else if (chunk == 31 && tok >= 61) st8f(F.out + O_CP + (size_t)(b * 3 + (tok - 61)) * 512 + ch0, x0);
                }
#pragma unroll
                for (int j = 0; j < 8; ++j) { x3[j] = x2[j]; x2[j] = x1[j]; x1[j] = x0[j]; }
            }
        }
        __syncthreads();
        bf16x8 wa[4][2], wx[4][2];
        float ba[4], bx[4], cl2[4];
        {
            const bf16* wga = F.WG + (size_t)F.wave * 4096; const bf16* wgx = F.WG + 32768 + (size_t)F.wave * 4096;
#pragma unroll
            for (int nt = 0; nt < 4; ++nt) {
#pragma unroll
                for (int kk = 0; kk < 2; ++kk) { const int o = (16 * nt + fr) * 64 + 32 * kk + 8 * fq;
                    wa[nt][kk] = *(const bf16x8*)(wga + o); wx[nt][kk] = *(const bf16x8*)(wgx + o); }
                const int ch = chb + 16 * nt + fr; ba[nt] = F.in[18][ch]; bx[nt] = F.in[20][ch];
                cl2[nt] = (-8.0f * 1.44269504089f) * log1pf(__expf(-F.in[21][ch]));
            }
        }
        if (full) {
#pragma unroll
            for (int i = 0; i < 8; ++i) { const int p = tid + 512 * i, tok = p >> 6, c16 = p & 63;
                *(LAS v4u*)(lds + XL_OFF + tok * RS + c16 * 16) = *(const v4u*)(Z + (size_t)(row0 + tok) * DIN + 512 + c16 * 8); }
            __syncthreads();
        }
        {
            float hc[4], Ac[4];
#pragma unroll
            for (int nt = 0; nt < 4; ++nt) { hc[nt] = (PASS == 2) ? *(const LAS float*)(lds + CARRY_OFF + (chb + 16 * nt + fr) * 4) : 0.f; Ac[nt] = 1.f; }
#pragma unroll 1
            for (int mt = 0; mt < 4; ++mt) {
                bf16x8 xa[2];
#pragma unroll
                for (int kk = 0; kk < 2; ++kk) xa[kk] = *(const LAS bf16x8*)(lds + XC_OFF + (16 * mt + fr) * RS + (chb + 32 * kk + 8 * fq) * 2);
                f32x4 accA[4], accX[4];
#pragma unroll
                for (int nt = 0; nt < 4; ++nt) { accA[nt] = (f32x4){0.f, 0.f, 0.f, 0.f}; accX[nt] = (f32x4){0.f, 0.f, 0.f, 0.f};
#pragma unroll
                    for (int kk = 0; kk < 2; ++kk) { accA[nt] = __builtin_amdgcn_mfma_f32_16x16x32_bf16(xa[kk], wa[nt][kk], accA[nt], 0, 0, 0);
                        accX[nt] = __builtin_amdgcn_mfma_f32_16x16x32_bf16(xa[kk], wx[nt][kk], accX[nt], 0, 0, 0); } }
#pragma unroll
                for (int nt = 0; nt < 4; ++nt) {
                    const int ch = chb + 16 * nt + fr;
                    float P[4], Hh[4];
#pragma unroll
                    for (int i = 0; i < 4; ++i) {
                        const int tok = 16 * mt + 4 * fq + i;
                        const float xcv = bf2f(*(const LAS unsigned short*)(lds + XC_OFF + tok * RS + ch * 2));
                        const float rg = sigmoid_f(accA[nt][i] + ba[nt]), ig = sigmoid_f(accX[nt][i] + bx[nt]);
                        const float l2 = cl2[nt] * rg;
                        const float a = __builtin_amdgcn_exp2f(l2), mult = __builtin_amdgcn_sqrtf(neg_expm1(l2 * (2.0f * 0.69314718056f), a * a));
                        const float bvv = mult * (ig * xcv);
                        if (i == 0) { P[0] = a; Hh[0] = bvv; } else { P[i] = a * P[i - 1]; Hh[i] = a * Hh[i - 1] + bvv; }
                    }
                    float hin;
                    if (samp) { hin = st_h[(size_t)(seq0 + 4 * mt + fq) * 512 + ch]; }
                    else {
                        float Ai = P[3], Bi = Hh[3];
                        float Au = __shfl_up(Ai, 16), Bu = __shfl_up(Bi, 16);
                        if (fq >= 1) { Bi = Ai * Bu + Bi; Ai = Au * Ai; }
                        Au = __shfl_up(Ai, 32); Bu = __shfl_up(Bi, 32);
                        if (fq >= 2) { Bi = Ai * Bu + Bi; Ai = Au * Ai; }
                        float Ae = __shfl_up(Ai, 16), Be = __shfl_up(Bi, 16);
                        if (fq == 0) { Ae = 1.f; Be = 0.f; }
                        hin = Ae * hc[nt] + Be;
                        const float At = __shfl(Ai, fr + 48), Bt = __shfl(Bi, fr + 48);
                        hc[nt] = At * hc[nt] + Bt;
                        if (PASS == 1) Ac[nt] *= At;
                    }
                    if (full) {
                        float hv[4];
#pragma unroll
                        for (int i = 0; i < 4; ++i) {
                            const int tok = 16 * mt + 4 * fq + i;
                            hv[i] = P[i] * hin + Hh[i];
                            const float g = bf2f(*(const LAS unsigned short*)(lds + XL_OFF + tok * RS + ch * 2));
                            const float y2 = 1.5957691216f * (g + 0.044715f * g * g * g);
                            const float o = hv[i] * (g * sigmoid_f(y2));
                            *(LAS unsigned short*)(lds + XC_OFF + tok * RS + ch * 2) = (unsigned short)f2bf(o);
                        }
                        if (samp) F.out[O_HS + (size_t)(seq0 + 4 * mt + fq) * 512 + ch] = hv[3];
                        else if (chunk == 31 && mt == 3 && fq == 3) F.out[O_HP + (size_t)b * 512 + ch] = hv[3];
                    }
                    __builtin_amdgcn_sched_barrier(0);
                }
            }
            if (PASS == 1 && !samp && fq == 0) {
#pragma unroll
                for (int nt = 0; nt < 4; ++nt) { const int ch = chb + 16 * nt + fr; float* ap = F.agg + (size_t)((b * 32 + chunk) * 2) * 512 + ch; ap[0] = Ac[nt]; ap[512] = hc[nt]; }
            }
        }
        __syncthreads();
        if (full) {
            for (int p = tid; p < 64 * 64; p += NWAVES * 64) {
                const int tok = p >> 6, c16 = p & 63;
                *(v4u*)(F.U + (size_t)(row0 + tok) * D + c16 * 8) = *(const LAS v4u*)(lds + XC_OFF + tok * RS + c16 * 16);
            }
        }
    }
}

struct Args { const float* in[29]; float* out; unsigned char* ws; int ph_lo, ph_hi; };
__global__ void __launch_bounds__(NWAVES * 64, 2) fwd_kernel(Args args) {
    extern __shared__ __attribute__((aligned(16))) unsigned char lds_raw[];
    Frame F;
    F.lds = (LAS unsigned char*)lds_raw;
    F.tid = threadIdx.x; F.lane = F.tid & 63; F.wave = __builtin_amdgcn_readfirstlane(F.tid >> 6); F.G = gridDim.x;
#pragma unroll
    for (int i = 0; i < 29; ++i) F.in[i] = args.in[i];
    F.out = args.out;
    unsigned char* ws = args.ws;
    F.mod = (float*)(ws + WS_MOD); F.agg = (float*)(ws + WS_AGG); F.part = (float*)(ws + WS_PART);
    F.W1GU = (bf16*)(ws + WS_W1GU); F.W1D = (bf16*)(ws + WS_W1D); F.WMI = (bf16*)(ws + WS_WMI); F.WMO = (bf16*)(ws + WS_WMO); F.W2GU = (bf16*)(ws + WS_W2GU); F.W2D = (bf16*)(ws + WS_W2D);
    F.WG = (bf16*)(ws + WS_WG); F.XN = (bf16*)(ws + WS_XN); F.U = F.XN; F.H = (bf16*)(ws + WS_H); F.Z = F.H;
    if (F.tid < 4) ((LAS unsigned*)(F.lds + MISC_OFF))[F.tid] = 0u;
    __syncthreads();
    XcdBarrier bar = xcd_barrier_post((unsigned*)(ws + WS_CTL), (volatile LAS unsigned*)(F.lds + MISC_OFF));
    const int lo = args.ph_lo, hi = args.ph_hi;
#ifndef PH_MASK
#define PH_MASK 0x1FFF
#endif
#define IN(k) (((PH_MASK >> (k)) & 1) && lo <= (k) && (k) < hi)
#ifndef REP_MASK
#define REP_MASK 0
#endif
#define REP(k) for (int rep_ = 0; rep_ < (((REP_MASK) >> (k)) & 1) + 1; ++rep_) if (rep_ == 0 || (xcd_barrier(bar), true))
#define SEAM(k) do { if (IN(k) && IN((k) + 1)) { if (lo < 0) cg::this_grid().sync(); else xcd_barrier(bar); } } while (0)

    constexpr int SPLIT_DN = 8, SPLIT_MO = 4;
    if (IN(0)) REP(0) { p0_prologue(F); } SEAM(0);
    if (IN(1)) REP(1) { norm_pass(F, F.in[0], F.in[1], F.in[9], 0, 1, 0); } SEAM(1);
    if (IN(2)) REP(2) { pg8::Gemm g{F.XN, F.W1GU, M, 2 * FF, D}; pg8::StaticOrder S; S.init(M, 2 * FF, D, F.G, (int)blockIdx.x);
        pg8::EpiSwiglu E{F.H, FF}; pg8::gemm_phase<pg8::EpiSwiglu, pg8::StaticOrder, PG8_ALIGN, PG8_SP2>(F.lds, g, S, E);
        { constexpr int first_idle = ((M / 256) * (2 * FF / 256)) % 256; if (rep_ == 0 && F.G == 256 && (int)blockIdx.x >= first_idle) transpose_set(F, 1, ((int)blockIdx.x - first_idle) * NWAVES + F.wave, (256 - first_idle) * NWAVES); else if (rep_ == 0 && F.G != 256) transpose_set(F, 1, blockIdx.x * NWAVES + F.wave, F.G * NWAVES); } } SEAM(2);
    if (IN(3)) REP(3) { pg8::Gemm g{F.H, F.W1D, M, D, FF}; pg8::SplitOrder S; S.init(FF, SPLIT_DN, F.G, (int)blockIdx.x);
        pg8::EpiResid E{F.in[0], F.in[1], F.out, F.mod, 2, 0.5f, F.part}; pg8::gemm_phase<pg8::EpiResid, pg8::SplitOrder, PG8_ALIGN, PG8_SP2>(F.lds, g, S, E);
        { constexpr int first_idle = 8 * SPLIT_DN; if (rep_ == 0 && F.G == 256 && (int)blockIdx.x >= first_idle) transpose_set(F, 2, ((int)blockIdx.x - first_idle) * NWAVES + F.wave, (256 - first_idle) * NWAVES); else if (rep_ == 0 && F.G != 256) transpose_set(F, 2, blockIdx.x * NWAVES + F.wave, F.G * NWAVES); } } SEAM(3);
    if (IN(4)) REP(4) { norm_pass(F, F.out, F.in[1], F.in[13], 3, 4, SPLIT_DN); } SEAM(4);
    if (IN(5)) REP(5) { pg8::Gemm g{F.XN, F.WMI, M, DIN, D}; pg8::StaticOrder S; S.init(M, DIN, D, F.G, (int)blockIdx.x);
        pg8::EpiBf16 E{F.Z, DIN}; pg8::gemm_phase<pg8::EpiBf16, pg8::StaticOrder, PG8_ALIGN, PG8_SP2>(F.lds, g, S, E);
        { constexpr int first_idle = ((M / 256) * (DIN / 256)) % 256; if (rep_ == 0 && F.G == 256 && (int)blockIdx.x >= first_idle) transpose_set(F, 3, ((int)blockIdx.x - first_idle) * NWAVES + F.wave, (256 - first_idle) * NWAVES); else if (rep_ == 0 && F.G != 256) transpose_set(F, 3, blockIdx.x * NWAVES + F.wave, F.G * NWAVES); } } SEAM(5);
    if (IN(6)) REP(6) { mixer_mid<1>(F); } SEAM(6);
    if (IN(7)) REP(7) { mixer_mid<2>(F); } SEAM(7);
    if (IN(8)) REP(8) { pg8::Gemm g{F.U, F.WMO, M, D, D}; pg8::SplitOrder S; S.init(D, SPLIT_MO, F.G, (int)blockIdx.x);
        pg8::EpiResid E{F.out, F.out + (size_t)NP * D, F.out, F.mod, 5, 1.0f, F.part}; pg8::gemm_phase<pg8::EpiResid, pg8::SplitOrder, PG8_ALIGN, PG8_SP2>(F.lds, g, S, E); } SEAM(8);
    if (IN(9)) REP(9) { norm_pass(F, F.out, F.out + (size_t)NP * D, F.in[24], 6, 7, SPLIT_MO); } SEAM(9);
    if (IN(10)) REP(10) { pg8::Gemm g{F.XN, F.W2GU, M, 2 * FF, D}; pg8::StaticOrder S; S.init(M, 2 * FF, D, F.G, (int)blockIdx.x);
        pg8::EpiSwiglu E{F.H, FF}; pg8::gemm_phase<pg8::EpiSwiglu, pg8::StaticOrder, PG8_ALIGN, PG8_SP2>(F.lds, g, S, E); } SEAM(10);
    if (IN(11)) REP(11) { pg8::Gemm g{F.H, F.W2D, M, D, FF}; pg8::SplitOrder S; S.init(FF, SPLIT_DN, F.G, (int)blockIdx.x);
        pg8::EpiResid E{F.out, F.out + (size_t)NP * D, F.out, F.mod, 8, 0.5f, F.part}; pg8::gemm_phase<pg8::EpiResid, pg8::SplitOrder, PG8_ALIGN, PG8_SP2>(F.lds, g, S, E); } SEAM(11);
    if (IN(12)) REP(12) { final_norm(F, SPLIT_DN); }
#undef IN
#undef SEAM
}

extern "C" void kernel_launch(void* const* d_in, const int* in_sizes, int n_in, void* d_out, int out_size, void* d_ws, size_t ws_size, hipStream_t stream) {
    static int grid = 0;
    if (grid == 0) {
        if (n_in != 29 || in_sizes[0] != NP * D || (size_t)out_size != O_END || ws_size < WS_END) {
            fprintf(stderr, "kernel_launch: unexpected shapes: n_in %d in0 %d out %d ws %zu\n", n_in, n_in > 0 ? in_sizes[0] : -1, out_size, ws_size); grid = -1; return; }
        int dev = 0, cus = 0, per_cu = 0;
        (void)hipGetDevice(&dev); (void)hipDeviceGetAttribute(&cus, hipDeviceAttributeMultiprocessorCount, dev);
        if (hipFuncSetAttribute((const void*)fwd_kernel, hipFuncAttributeMaxDynamicSharedMemorySize, LDS_BYTES) != hipSuccess) { fprintf(stderr, "kernel_launch: hipFuncSetAttribute failed\n"); grid = -1; return; }
        if (hipOccupancyMaxActiveBlocksPerMultiprocessor(&per_cu, (const void*)fwd_kernel, NWAVES * 64, LDS_BYTES) != hipSuccess || per_cu < 1) { fprintf(stderr, "kernel_launch: occupancy query says %d\n", per_cu); per_cu = 1; }
        (void)hipGetLastError();
        grid = cus * per_cu;
        fprintf(stderr, "kernel_launch: cus %d per_cu %d grid %d\n", cus, per_cu, grid);
    }
    if (grid < 0) return;
    if (hipMemsetAsync((char*)d_ws + WS_CTL, 0, CTL_ZERO_BYTES, stream) != hipSuccess) { fprintf(stderr, "kernel_launch: memset failed\n"); return; }
    Args a{};
    for (int i = 0; i < 29; ++i) a.in[i] = (const float*)d_in[i];
    a.out = (float*)d_out; a.ws = (unsigned char*)d_ws;
#if MK_N_LAUNCHES == 1
    a.ph_lo = 0; a.ph_hi = N_PHASES;
    void* kargs[] = {&a};
    hipError_t e = hipLaunchCooperativeKernel((const void*)fwd_kernel, dim3(grid), dim3(NWAVES * 64), kargs, LDS_BYTES, stream);
    if (e != hipSuccess) fprintf(stderr, "kernel_launch: cooperative launch failed: %s (grid %d)\n", hipGetErrorString(e), grid);
#else
    for (int li = 0; li < N_PHASES; ++li) {
        a.ph_lo = li; a.ph_hi = li + 1;
        hipLaunchKernelGGL(fwd_kernel, dim3(grid), dim3(NWAVES * 64), LDS_BYTES, stream, a);
    }
#endif
}
```

```cpp
#include <hip/hip_runtime.h>
#include <hip/hip_cooperative_groups.h>
#include <cstdio>
#include <cstdint>
namespace cg = cooperative_groups;

#ifndef MK_N_LAUNCHES
#define MK_N_LAUNCHES 1
#endif

constexpr int D = 1024, NP = 16384, NS = 512, M = NP + NS, FF = 3072, DIN = 2560, DL = 512;
constexpr int TP = 2048, NBATCH = 136, NMOD = 9;
constexpr float EPS = 1e-6f;
__device__ __forceinline__ int row_batch(int r) { return r < NP ? (r >> 11) : 8 + ((r - NP) >> 2); }

namespace pg8 {
#define PG8_LAS __attribute__((address_space(3)))
typedef unsigned short bf16_t;
typedef short bf16x8 __attribute__((ext_vector_type(8)));
typedef float f32x4 __attribute__((ext_vector_type(4)));
typedef unsigned u32x4 __attribute__((ext_vector_type(4)));
constexpr int BM = 256, BK = 64, HALF = 128, HTB = HALF * BK * 2  , STAGE_BYTES = 8 * HTB, NXCD = 8, WGM = 8;

__host__ __device__ __forceinline__ int lds_byte(int r, int c) { const int st = (r >> 4) * 2 + (c >> 5), rr = r & 15, cc = c & 31, ob = rr * 64 + cc * 2; return st * 1024 + (ob ^ (((ob >> 9) & 1) << 5)); }
__host__ __device__ __forceinline__ void stage_rc(int b, int& R, int& C) { const int st = b / 1024, sb = b % 1024, swz = sb ^ (((sb >> 9) & 1) << 5); R = (st >> 1) * 16 + swz / 64; C = (st & 1) * 32 + (swz % 64) / 2; }
__host__ __device__ __forceinline__ int perm32(int rho) { const int n = rho >> 4, i = rho & 15; return 8 * (i >> 2) + 4 * n + (i & 3); }

struct Unit { int pm, pn, kt0, nkt, slab; };
struct Gemm { const bf16_t* A; const bf16_t* Bt; int M, N, K; };

struct StaticOrder {
    int nM, nN, nwg, G, c, nkt;
    __host__ __device__ void init(int M, int N, int K, int G_, int c_) { nM = M / BM; nN = N / BM; nwg = nM * nN; G = G_; c = c_; nkt = K / BK; }
    __host__ __device__ __forceinline__ bool next(int i, Unit& u) const {
        const long L = (long)i * G + c; if (L >= nwg) return false;
        int wgid = (int)L; { const int q = nwg / NXCD, r = nwg % NXCD, xcd = wgid % NXCD, off = wgid / NXCD; wgid = (xcd < r ? xcd * (q + 1) : r * (q + 1) + (xcd - r) * q) + off; }
        const int nig = WGM * nN, gid = wgid / nig, fm = gid * WGM, gsz = (nM - fm) < WGM ? (nM - fm) : WGM;
        u.pm = fm + ((wgid % nig) % gsz); u.pn = (wgid % nig) / gsz; u.kt0 = 0; u.nkt = nkt; u.slab = -1; return true;
    }
    __device__ __forceinline__ void a_ready(const Unit&) const {}
    __device__ __forceinline__ void done(const Unit&) const {}
};
struct SplitOrder {
    StaticOrder P; int G, c, S, nkt;
    __host__ __device__ void init(int K, int S_, int G_, int c_) { P.init(64 * BM, 4 * BM, K, 1, 0); G = G_; c = c_; S = S_; nkt = K / BK; }
    __host__ __device__ __forceinline__ bool next(int i, Unit& u) const {
        int L;
        if (G == 256) { const bool hs = c < 8 * S; if (i == 0) L = hs ? 256 + c : c; else if (i == 1 && hs) L = c; else return false; }
        else { L = i * G + c; if (L >= 256 + 8 * S) return false; }
        const bool pr = L < 256; const int r = L - 256, t = r & 7, s = r >> 3, ns = nkt / S;
        const int w = (L & 7) * 32 + (L >> 3);
        u.pm = pr ? ((w >> 5) * 8 + (w & 7)) : 64 + (t >> 2); u.pn = pr ? ((w & 31) >> 3) : (t & 3);
        u.kt0 = pr ? 0 : s * ns; u.nkt = pr ? nkt : ns; u.slab = pr ? -1 : s; return true;
    }
    __device__ __forceinline__ void a_ready(const Unit&) const {}
    __device__ __forceinline__ void done(const Unit&) const {}
};


__device__ __forceinline__ unsigned cvt_pk_bf16(float lo, float hi) { unsigned r; asm volatile("v_cvt_pk_bf16_f32 %0, %1, %2" : "=v"(r) : "v"(lo), "v"(hi)); return r; }
__device__ __forceinline__ float silu_f(float g) { return g * __builtin_amdgcn_rcpf(1.0f + __builtin_amdgcn_exp2f(g * -1.44269504089f)); }

struct EpiBf16 {
    static constexpr bool PERM = true, AFTER_DRAIN = false;
    bf16_t* O; int ldc;
    __device__ __forceinline__ void operator()(const f32x4 (&acc)[2][2][4][2], const Unit& u, int wr, int wc, int fr, int fq) const {
        const int row0 = u.pm * BM + wr * 64 + fr; const int col0 = u.pn * BM + wc * 32 + 8 * fq;
#pragma unroll
        for (int ai = 0; ai < 2; ++ai)
#pragma unroll
            for (int m = 0; m < 4; ++m) { bf16_t* rowp = O + (size_t)(row0 + ai * HALF + m * 16) * ldc + col0;
#pragma unroll
                for (int bj = 0; bj < 2; ++bj) { const f32x4 v0 = acc[ai][bj][m][0], v1 = acc[ai][bj][m][1];
                    u32x4 w; w.x = cvt_pk_bf16(v0[0], v0[1]); w.y = cvt_pk_bf16(v0[2], v0[3]); w.z = cvt_pk_bf16(v1[0], v1[1]); w.w = cvt_pk_bf16(v1[2], v1[3]);
                    *(u32x4*)(rowp + bj * HALF) = w; } }
    }
};
struct EpiSwiglu {
    static constexpr bool PERM = true, AFTER_DRAIN = false;
    bf16_t* O; int ldc;
    __device__ __forceinline__ void operator()(const f32x4 (&acc)[2][2][4][2], const Unit& u, int wr, int wc, int fr, int fq) const {
        const int row0 = u.pm * BM + wr * 64 + fr; const int col0 = u.pn * HALF + wc * 32 + 8 * fq;
#pragma unroll
        for (int ai = 0; ai < 2; ++ai)
#pragma unroll
            for (int m = 0; m < 4; ++m) { bf16_t* rowp = O + (size_t)(row0 + ai * HALF + m * 16) * ldc + col0;
                const f32x4 g0 = acc[ai][0][m][0], g1 = acc[ai][0][m][1], u0 = acc[ai][1][m][0], u1 = acc[ai][1][m][1];
                u32x4 w;
                w.x = cvt_pk_bf16(silu_f(g0[0]) * u0[0], silu_f(g0[1]) * u0[1]); w.y = cvt_pk_bf16(silu_f(g0[2]) * u0[2], silu_f(g0[3]) * u0[3]);
                w.z = cvt_pk_bf16(silu_f(g1[0]) * u1[0], silu_f(g1[1]) * u1[1]); w.w = cvt_pk_bf16(silu_f(g1[2]) * u1[2], silu_f(g1[3]) * u1[3]);
                *(u32x4*)rowp = w; }
    }
};
struct EpiResid {
    static constexpr bool PERM = false, AFTER_DRAIN = false;
    const float* baseP; const float* baseS; float* out; const float* mod; int idx; float fac; float* part;
    __device__ __forceinline__ void operator()(const f32x4 (&acc)[2][2][4][2], const Unit& u, int wr, int wc, int fr, int fq) const {
        const int colb = u.pn * BM + wc * 32 + 4 * fq;
        if (u.slab >= 0) {
#pragma unroll
            for (int ai = 0; ai < 2; ++ai)
#pragma unroll
                for (int m = 0; m < 4; ++m) {
                    const int r = u.pm * BM + ai * HALF + wr * 64 + m * 16 + fr;
                    const float* mp = mod + (size_t)(row_batch(r) * NMOD + idx) * D;
                    float* pp = part + ((size_t)u.slab * NS + (r - NP)) * D;
#pragma unroll
                    for (int bj = 0; bj < 2; ++bj)
#pragma unroll
                        for (int n = 0; n < 2; ++n) { const int c = colb + bj * HALF + n * 16; const f32x4 mv = *(const f32x4*)(mp + c);
                            *(f32x4*)(pp + c) = (mv * fac) * acc[ai][bj][m][n]; }
                    if (m & 1) asm volatile("" ::: "memory"); }
            return;
        }
#pragma unroll
        for (int ai = 0; ai < 2; ++ai)
#pragma unroll
            for (int m = 0; m < 4; ++m) {
                const int r = u.pm * BM + ai * HALF + wr * 64 + m * 16 + fr;
                const float* bp = (r < NP) ? baseP + (size_t)r * D : baseS + (size_t)(r - NP) * D;
                const float* mp = mod + (size_t)(row_batch(r) * NMOD + idx) * D;
                float* op = out + (size_t)r * D;
#pragma unroll
                for (int bj = 0; bj < 2; ++bj)
#pragma unroll
                    for (int n = 0; n < 2; ++n) { const int c = colb + bj * HALF + n * 16;
                        const f32x4 bs = *(const f32x4*)(bp + c); const f32x4 mv = *(const f32x4*)(mp + c);
                        *(f32x4*)(op + c) = bs + (mv * fac) * acc[ai][bj][m][n]; }
                if (m & 1) asm volatile("" ::: "memory"); }
    }
};

template <class Epi, class Sched, bool ALIGN_EPI = false, bool SP2 = false>
__device__ __forceinline__ void gemm_phase(PG8_LAS unsigned char* lds, const Gemm g, const Sched& S, const Epi& E) {
    const int tid = threadIdx.x, wid = __builtin_amdgcn_readfirstlane(tid >> 6), lane = tid & 63, wr = wid >> 2, wc = wid & 3, fr = lane & 15, fq = lane >> 4;
    const int K = g.K;
    unsigned voffA[2], voffB[2];
#pragma unroll
    for (int i = 0; i < 2; ++i) { int R, C; stage_rc(tid * 16 + i * 8192, R, C); const int Rb = Epi::PERM ? ((R & ~31) + perm32(R & 31)) : R;
        voffA[i] = (unsigned)(R * K + C) * 2u; voffB[i] = (unsigned)(Rb * K + C) * 2u; }
    const size_t kstep = (size_t)(BK * 2);
    const size_t hstep = (size_t)HALF * K * 2;
    const size_t tstep = 2 * hstep;
    const unsigned ldsw = (unsigned)wid * 1024u;
    const int aoff = lds_byte(wr * 64 + fr, fq * 8), boff = lds_byte(wc * 32 + fr, fq * 8);
#define PG8_SA(b, h) (((b) * 2 + (h)) * HTB)
#define PG8_SB(b, h) ((4 + (b) * 2 + (h)) * HTB)
#define PG8_STAGE(bufoff, gbase, voff) do { _Pragma("unroll") for (int _i = 0; _i < 2; ++_i) \
        __builtin_amdgcn_global_load_lds((const unsigned*)((const char*)(gbase) + (voff)[_i]), (PG8_LAS unsigned*)(lds + (bufoff) + ldsw + _i * 8192), 16, 0, 0); } while (0)
#define PG8_LDA(dst, b, h) do { _Pragma("unroll") for (int m = 0; m < 4; ++m) _Pragma("unroll") for (int k = 0; k < 2; ++k) dst[m][k] = *(const PG8_LAS bf16x8*)(lds + PG8_SA(b, h) + aoff + m * 2048 + k * 1024); } while (0)
#define PG8_LDB(dst, b, h) do { _Pragma("unroll") for (int n = 0; n < 2; ++n) _Pragma("unroll") for (int k = 0; k < 2; ++k) dst[n][k] = *(const PG8_LAS bf16x8*)(lds + PG8_SB(b, h) + boff + n * 2048 + k * 1024); } while (0)
#define PG8_MMA(ai, bj, At, Bt) do { __builtin_amdgcn_s_setprio(1); _Pragma("unroll") for (int m = 0; m < 4; ++m) _Pragma("unroll") for (int n = 0; n < 2; ++n) _Pragma("unroll") for (int k = 0; k < 2; ++k) \
        acc[ai][bj][m][n] = __builtin_amdgcn_mfma_f32_16x16x32_bf16(Bt[n][k], At[m][k], acc[ai][bj][m][n], 0, 0, 0); __builtin_amdgcn_s_setprio(0); } while (0)
#define PG8_WAIT_V(n) asm volatile("s_waitcnt vmcnt(" #n ")" ::: "memory")
#define PG8_WAIT_L(n) asm volatile("s_waitcnt lgkmcnt(" #n ")" ::: "memory")
#define PG8_BAR __builtin_amdgcn_s_barrier()
#define PG8_SCHED __builtin_amdgcn_sched_barrier(0)
    Unit cur, nxt; int ui = 0;
    if (!S.next(0, cur)) return;
    f32x4 acc[2][2][4][2];
#pragma unroll
    for (int a = 0; a < 2; ++a)
#pragma unroll
        for (int b = 0; b < 2; ++b)
#pragma unroll
            for (int m = 0; m < 4; ++m)
#pragma unroll
                for (int n = 0; n < 2; ++n) acc[a][b][m][n] = (f32x4){0.f, 0.f, 0.f, 0.f};
    bf16x8 At[4][2], B0[2][2], B1[2][2];
    const char* cA = (const char*)g.A + (size_t)cur.pm * tstep + (size_t)cur.kt0 * kstep; const char* cB = (const char*)g.Bt + (size_t)cur.pn * tstep + (size_t)cur.kt0 * kstep;
    S.a_ready(cur);
    if constexpr (SP2) {
        PG8_STAGE(PG8_SB(0, 0), cB, voffB); PG8_STAGE(PG8_SB(0, 1), cB + hstep, voffB); PG8_STAGE(PG8_SA(0, 0), cA, voffA); PG8_STAGE(PG8_SA(0, 1), cA + hstep, voffA);
        if (wr == 1) PG8_BAR;
        PG8_WAIT_V(2); PG8_BAR;
        PG8_STAGE(PG8_SB(1, 0), cB + kstep, voffB); PG8_STAGE(PG8_SA(1, 0), cA + kstep, voffA); PG8_STAGE(PG8_SB(1, 1), cB + hstep + kstep, voffB);
        PG8_WAIT_V(6); PG8_BAR;
    } else {
        PG8_STAGE(PG8_SB(0, 0), cB, voffB); PG8_STAGE(PG8_SA(0, 0), cA, voffA); PG8_STAGE(PG8_SB(0, 1), cB + hstep, voffB); PG8_STAGE(PG8_SA(0, 1), cA + hstep, voffA);
        if (wr == 1) PG8_BAR;
        PG8_WAIT_V(4); PG8_BAR;
        PG8_STAGE(PG8_SB(1, 0), cB + kstep, voffB); PG8_STAGE(PG8_SA(1, 0), cA + kstep, voffA); PG8_STAGE(PG8_SB(1, 1), cB + hstep + kstep, voffB);
        PG8_WAIT_V(6); PG8_BAR;
    }
    for (;;) {
        const bool has_next = S.next(ui + 1, nxt);
        const char* nA = has_next ? (const char*)g.A + (size_t)nxt.pm * tstep + (size_t)nxt.kt0 * kstep : cA; const char* nB = has_next ? (const char*)g.Bt + (size_t)nxt.pn * tstep + (size_t)nxt.kt0 * kstep : cB;
        const int nt = cur.nkt;
        for (int t = 0; t < nt; t += 2) {
            const bool last = (t == nt - 2);
            const char* a1 = cA + (size_t)(t + 1) * kstep;
            const char* a2 = last ? nA : cA + (size_t)(t + 2) * kstep; const char* b2 = last ? nB : cB + (size_t)(t + 2) * kstep;
            const char* a3 = a2 + kstep; const char* b3 = b2 + kstep;
            if (last && has_next) S.a_ready(nxt);
            if constexpr (SP2) {
            PG8_LDB(B0, 0, 0); PG8_LDB(B1, 0, 1); PG8_SCHED; PG8_LDA(At, 0, 0); PG8_STAGE(PG8_SA(1, 1), a1 + hstep, voffA);
            PG8_WAIT_V(8); PG8_WAIT_L(0); PG8_BAR; PG8_MMA(0, 0, At, B0); PG8_MMA(0, 1, At, B1); PG8_BAR; PG8_SCHED;
            PG8_LDA(At, 0, 1); PG8_STAGE(PG8_SB(0, 0), b2, voffB); PG8_STAGE(PG8_SB(0, 1), b2 + hstep, voffB); PG8_STAGE(PG8_SA(0, 0), a2, voffA);
            PG8_WAIT_V(8); PG8_WAIT_L(0); PG8_BAR; PG8_MMA(1, 0, At, B0); PG8_MMA(1, 1, At, B1); PG8_BAR; PG8_SCHED;
            PG8_LDB(B0, 1, 0); PG8_LDB(B1, 1, 1); PG8_SCHED; PG8_LDA(At, 1, 0); PG8_STAGE(PG8_SA(0, 1), a2 + hstep, voffA);
            PG8_WAIT_V(8); PG8_WAIT_L(0); PG8_BAR; PG8_MMA(0, 0, At, B0); PG8_MMA(0, 1, At, B1); PG8_BAR; PG8_SCHED;
            PG8_LDA(At, 1, 1); PG8_STAGE(PG8_SB(1, 0), b3, voffB); PG8_STAGE(PG8_SB(1, 1), b3 + hstep, voffB); PG8_STAGE(PG8_SA(1, 0), a3, voffA);
            PG8_WAIT_V(8); PG8_WAIT_L(0); PG8_BAR; PG8_MMA(1, 0, At, B0); PG8_MMA(1, 1, At, B1); PG8_BAR; PG8_SCHED;
            } else {
            PG8_LDB(B0, 0, 0); PG8_SCHED; PG8_LDA(At, 0, 0); PG8_STAGE(PG8_SA(1, 1), a1 + hstep, voffA);
            PG8_WAIT_L(8); PG8_BAR; PG8_WAIT_L(0); PG8_MMA(0, 0, At, B0); PG8_BAR; PG8_SCHED;
            PG8_LDB(B1, 0, 1); PG8_STAGE(PG8_SB(0, 0), b2, voffB);
            PG8_BAR; PG8_WAIT_L(0); PG8_MMA(0, 1, At, B1); PG8_BAR;
            PG8_LDA(At, 0, 1); PG8_STAGE(PG8_SA(0, 0), a2, voffA);
            PG8_BAR; PG8_WAIT_L(0); PG8_MMA(1, 0, At, B0); PG8_BAR; PG8_SCHED;
            PG8_STAGE(PG8_SB(0, 1), b2 + hstep, voffB);
            PG8_WAIT_V(6); PG8_BAR; PG8_MMA(1, 1, At, B1); PG8_BAR;
            PG8_LDB(B0, 1, 0); PG8_SCHED; PG8_LDA(At, 1, 0); PG8_STAGE(PG8_SA(0, 1), a2 + hstep, voffA);
            PG8_WAIT_L(8); PG8_BAR; PG8_WAIT_L(0); PG8_MMA(0, 0, At, B0); PG8_BAR; PG8_SCHED;
            PG8_LDB(B1, 1, 1); PG8_STAGE(PG8_SB(1, 0), b3, voffB);
            PG8_BAR; PG8_WAIT_L(0); PG8_MMA(0, 1, At, B1); PG8_BAR;
            PG8_LDA(At, 1, 1); PG8_STAGE(PG8_SA(1, 0), a3, voffA);
            PG8_BAR; PG8_WAIT_L(0); PG8_MMA(1, 0, At, B0); PG8_BAR; PG8_SCHED;
            PG8_STAGE(PG8_SB(1, 1), b3 + hstep, voffB);
            PG8_WAIT_V(6); PG8_BAR; PG8_MMA(1, 1, At, B1); PG8_BAR;
            }
        }
        if constexpr (ALIGN_EPI) { if (wr == 0) PG8_BAR; }
        if constexpr (!Epi::AFTER_DRAIN) { E(acc, cur, wr, wc, fr, fq); S.done(cur); }
        if (!has_next) break;
#pragma unroll
        for (int a = 0; a < 2; ++a)
#pragma unroll
            for (int b = 0; b < 2; ++b)
#pragma unroll
                for (int m = 0; m < 4; ++m)
#pragma unroll
                    for (int n = 0; n < 2; ++n) acc[a][b][m][n] = (f32x4){0.f, 0.f, 0.f, 0.f};
        cur = nxt; cA = nA; cB = nB; ++ui;
        if constexpr (ALIGN_EPI) { if (wr == 1) PG8_BAR; }
    }
    PG8_WAIT_V(0);
    if constexpr (!ALIGN_EPI) { if (wr == 0) PG8_BAR; }
    PG8_BAR;
    if constexpr (Epi::AFTER_DRAIN) { E.fused(acc, cur, wr, wc, fr, fq, lds, wid, lane); S.done(cur); }
#undef PG8_SA
#undef PG8_SB
#undef PG8_STAGE
#undef PG8_LDA
#undef PG8_LDB
#undef PG8_MMA
#undef PG8_WAIT_V
#undef PG8_WAIT_L
#undef PG8_BAR
#undef PG8_SCHED
}
}
#ifndef PG8_SP2
#define PG8_SP2 true
#endif
#ifndef PG8_ALIGN
#define PG8_ALIGN true
#endif

constexpr int NWAVES = 8;
constexpr int N_PHASES = 13;
constexpr size_t MiB = 1u << 20;
constexpr size_t WS_CTL = 0, CTL_ZERO_BYTES = 16384;
constexpr size_t WS_MOD = 1 * MiB;
constexpr size_t WS_AGG = 6 * MiB, WS_WG = 7 * MiB;
constexpr size_t WS_W1GU = 8 * MiB, WS_W1D = 20 * MiB, WS_WMI = 26 * MiB, WS_WMO = 31 * MiB, WS_W2GU = 33 * MiB, WS_W2D = 45 * MiB;
constexpr size_t WS_XN = 52 * MiB;
constexpr size_t WS_H = 86 * MiB;
constexpr size_t WS_PART = 186 * MiB;
constexpr size_t WS_END = 202 * MiB;
constexpr size_t O_YP = 0, O_YS = (size_t)NP * D, O_CP = O_YS + (size_t)NS * D, O_HP = O_CP + 8 * 3 * 512, O_SP = O_HP + 8 * 512,
                 O_CS = O_SP + 8 * 2 * 512, O_HS = O_CS + 128 * 3 * 512, O_SS = O_HS + 128 * 512, O_END = O_SS + 128 * 2 * 512;
constexpr int LDS_BYTES = 147456, MISC_OFF = LDS_BYTES - 16;

#define LAS __attribute__((address_space(3)))
typedef unsigned short bf16;
typedef unsigned v4u __attribute__((ext_vector_type(4)));
typedef float f32x4 __attribute__((ext_vector_type(4)));
typedef short bf16x8 __attribute__((ext_vector_type(8)));
#define LDS_WAIT() asm volatile("s_waitcnt lgkmcnt(0)" ::: "memory")
__device__ __forceinline__ unsigned f2bf(float f) { unsigned u = __builtin_bit_cast(unsigned, f); return (u + 0x7fffu + ((u >> 16) & 1u)) >> 16; }
__device__ __forceinline__ unsigned pk2(float lo, float hi) { return f2bf(lo) | (f2bf(hi) << 16); }
__device__ __forceinline__ float bf2f(unsigned short h) { return __builtin_bit_cast(float, (unsigned)h << 16); }
__device__ __forceinline__ float bflo(unsigned w) { return __builtin_bit_cast(float, w << 16); }
__device__ __forceinline__ float bfhi(unsigned w) { return __builtin_bit_cast(float, w & 0xffff0000u); }
__device__ __forceinline__ void unpack8(const v4u v, float (&o)[8]) { o[0] = bflo(v.x); o[1] = bfhi(v.x); o[2] = bflo(v.y); o[3] = bfhi(v.y); o[4] = bflo(v.z); o[5] = bfhi(v.z); o[6] = bflo(v.w); o[7] = bfhi(v.w); }
__device__ __forceinline__ v4u pack8(const float (&o)[8]) { v4u v; v.x = pk2(o[0], o[1]); v.y = pk2(o[2], o[3]); v.z = pk2(o[4], o[5]); v.w = pk2(o[6], o[7]); return v; }
__device__ __forceinline__ void ld8f(const float* p, float (&o)[8]) { const f32x4 a = *(const f32x4*)p, b = *(const f32x4*)(p + 4); o[0] = a.x; o[1] = a.y; o[2] = a.z; o[3] = a.w; o[4] = b.x; o[5] = b.y; o[6] = b.z; o[7] = b.w; }
__device__ __forceinline__ void st8f(float* p, const float (&o)[8]) { *(f32x4*)p = (f32x4){o[0], o[1], o[2], o[3]}; *(f32x4*)(p + 4) = (f32x4){o[4], o[5], o[6], o[7]}; }
__device__ __forceinline__ float sigmoid_f(float x) { return __builtin_amdgcn_rcpf(1.0f + __builtin_amdgcn_exp2f(x * -1.44269504089f)); }
__device__ __forceinline__ float wave_sum(float v) {
#pragma unroll
    for (int o = 1; o < 64; o <<= 1) v += __shfl_xor(v, o);
    return v;
}

#define RLX_AGENT __ATOMIC_RELAXED, __HIP_MEMORY_SCOPE_AGENT
#define XB_TMO      128
#define XB_XCNT(j)  (256  + 64 * (j))
#define XB_XSUB(j)  (1280 + 64 * (j))
#define XB_XGEN(j)  (2304 + 64 * (j))
#define XB_TOP      3328
#define XB_TOPGEN   3392
#define XCD_BAR_WORDS 3456
#define XB_SPIN_CAP (1u << 18)

__device__ __forceinline__ unsigned xb_ld(unsigned* p)              { return __hip_atomic_load(p, __ATOMIC_RELAXED, __HIP_MEMORY_SCOPE_AGENT); }
__device__ __forceinline__ unsigned xb_add(unsigned* p, unsigned v) { return __hip_atomic_fetch_add(p, v, __ATOMIC_RELAXED, __HIP_MEMORY_SCOPE_AGENT); }
__device__ __forceinline__ unsigned xb_xcc_id() { return (unsigned)__builtin_amdgcn_s_getreg((3 << 11) | 20) & 0xFu; }
#define XB_SPIN(cond, bar) do { unsigned _sp = 0; while (cond) { __builtin_amdgcn_s_sleep(1); \
    if ((++_sp & 255u) == 0u) { if (xb_ld(&(bar)[XB_TMO])) break; if (_sp > XB_SPIN_CAP) { atomicAdd(&(bar)[XB_TMO], 1u); break; } } } } while (0)

struct XcdBarrier {
    unsigned* bar; unsigned x;
    volatile LAS unsigned* st;
};

__device__ __forceinline__ XcdBarrier xcd_barrier_post(unsigned* bar, volatile LAS unsigned* st) {
    XcdBarrier b; b.bar = bar; b.x = xb_xcc_id(); b.st = st;
    if (threadIdx.x == 0) (void)xb_add(&bar[XB_XCNT(b.x)], 1u);
    return b;
}
__device__ __forceinline__ void xcd_barrier_complete(unsigned* bar, unsigned x, unsigned& nloc, unsigned& nx) {
    const unsigned G = gridDim.x * gridDim.y * gridDim.z;
    unsigned sum, cnt, mine, sp = 0u;
    for (;;) {
        sum = 0u; cnt = 0u; mine = 0u;
#pragma unroll
        for (unsigned j = 0; j < 16; ++j) { const unsigned c = xb_ld(&bar[XB_XCNT(j)]); sum += c; cnt += (c > 0u) ? 1u : 0u; mine = (j == x) ? c : mine; }
        if (sum == G) break;
        __builtin_amdgcn_s_sleep(1);
        if ((++sp & 255u) == 0u) { if (xb_ld(&bar[XB_TMO])) break; if (sp > XB_SPIN_CAP) { atomicAdd(&bar[XB_TMO], 1u); break; } }
    }
    nloc = mine > 0u ? mine : 1u; nx = cnt > 0u ? cnt : 1u;
}

__device__ __forceinline__ void xcd_barrier(const XcdBarrier& b) {
    asm volatile("s_waitcnt vmcnt(0)" ::: "memory");
    __syncthreads();
    if (threadIdx.x == 0) {
        unsigned* bar = b.bar;
        __builtin_amdgcn_s_waitcnt(0);
        unsigned nloc = b.st[0], nx = b.st[1];
        if (nloc == 0u) { xcd_barrier_complete(bar, b.x, nloc, nx); b.st[0] = nloc; b.st[1] = nx; }
        const unsigned old = xb_add(&bar[XB_XSUB(b.x)], 1u);
        const unsigned gen = old / nloc;
        if (old + 1u == (gen + 1u) * nloc) {
            __builtin_amdgcn_fence(__ATOMIC_RELEASE, "agent");
            asm volatile("s_waitcnt vmcnt(0)" ::: "memory");
            const unsigned og = xb_add(&bar[XB_TOP], 1u);
            const unsigned tg = og / nx;
            if (og + 1u == (tg + 1u) * nx) xb_add(&bar[XB_TOPGEN], 1u);
            else XB_SPIN(xb_ld(&bar[XB_TOPGEN]) == tg, bar);
            __builtin_amdgcn_fence(__ATOMIC_ACQUIRE, "agent");
            xb_add(&bar[XB_XGEN(b.x)], 1u);
            asm volatile("s_waitcnt vmcnt(0)" ::: "memory");
        } else {
            XB_SPIN(xb_ld(&bar[XB_XGEN(b.x)]) == gen, bar);
            __builtin_amdgcn_fence(__ATOMIC_ACQUIRE, "agent");
            asm volatile("s_waitcnt vmcnt(0)" ::: "memory");
        }
    }
    __syncthreads();
}

struct Frame {
    LAS unsigned char* lds;
    int tid, lane, wave, G;
    const float* in[29];
    float* out;
    float* mod; float* agg; float* part;
    bf16 *W1GU, *W1D, *WMI, *WMO, *W2GU, *W2D, *XN, *U, *H, *Z, *WG;
};

constexpr int TR_SCR = 64 * 65 * 4;
__device__ __forceinline__ void transpose_item(const float* W, int K, int N, bf16* WT, int mode, LAS float* scr, int item, int lane) {
    const int nblk = N / 64, kb = item / nblk, nb = item % nblk, k0 = 64 * kb, n0 = 64 * nb;
    const int rbase = (mode == 0) ? n0 : (256 * (n0 >> 7) + (n0 & 127) + (mode == 2 ? 128 : 0));
    const int kr = lane >> 4, n4 = (lane & 15) * 4;
    f32x4 v[16];
#pragma unroll
    for (int i = 0; i < 16; ++i) v[i] = *(const f32x4*)(W + (size_t)(k0 + kr + 4 * i) * N + n0 + n4);
#pragma unroll
    for (int i = 0; i < 16; ++i) { LAS float* d = scr + (kr + 4 * i) * 65 + n4; d[0] = v[i].x; d[1] = v[i].y; d[2] = v[i].z; d[3] = v[i].w; }
    LDS_WAIT(); asm volatile("" ::: "memory");
    const int c = lane & 7;
#pragma unroll
    for (int j = 0; j < 8; ++j) { const int n = (lane >> 3) + 8 * j; const LAS float* sp = scr + (8 * c) * 65 + n;
        v4u o; o.x = pk2(sp[0 * 65], sp[1 * 65]); o.y = pk2(sp[2 * 65], sp[3 * 65]); o.z = pk2(sp[4 * 65], sp[5 * 65]); o.w = pk2(sp[6 * 65], sp[7 * 65]);
        *(v4u*)(WT + (size_t)(rbase + n) * K + k0 + 8 * c) = o; }
    LDS_WAIT(); asm volatile("" ::: "memory");
}
constexpr int I_GU = (D / 64) * (FF / 64), I_DN = (FF / 64) * (D / 64), I_MI = (D / 64) * (DIN / 64), I_MO = (D / 64) * (D / 64);
static_assert(I_GU == I_DN, "item counts");
__device__ __forceinline__ void transpose_set(Frame& F, int set, int wi, int nw) {
    LAS float* scr = (LAS float*)(F.lds + F.wave * TR_SCR);
    if (set == 0) {
        for (int it = wi; it < 2 * I_GU; it += nw) { if (it < I_GU) transpose_item(F.in[10], D, FF, F.W1GU, 1, scr, it, F.lane); else transpose_item(F.in[11], D, FF, F.W1GU, 2, scr, it - I_GU, F.lane); }
    } else if (set == 1) {
        for (int it = wi; it < I_DN + I_MI + I_MO; it += nw) {
            if (it < I_DN) transpose_item(F.in[12], FF, D, F.W1D, 0, scr, it, F.lane);
            else if (it < I_DN + I_MI) transpose_item(F.in[14], D, DIN, F.WMI, 0, scr, it - I_DN, F.lane);
            else transpose_item(F.in[23], D, D, F.WMO, 0, scr, it - I_DN - I_MI, F.lane); }
    } else if (set == 2) {
        for (int it = wi; it < 2 * I_GU; it += nw) { if (it < I_GU) transpose_item(F.in[25], D, FF, F.W2GU, 1, scr, it, F.lane); else transpose_item(F.in[26], D, FF, F.W2GU, 2, scr, it - I_GU, F.lane); }
    } else {
        for (int it = wi; it < I_DN; it += nw) transpose_item(F.in[27], FF, D, F.W2D, 0, scr, it, F.lane);
    }
}
__device__ __forceinline__ void p0_prologue(Frame& F) {
    if (blockIdx.x < 192) {
        const float* cP = F.in[5]; const float* cS = F.in[6]; const float* wada = F.in[7]; const float* bada = F.in[8];
        const int fr = F.lane & 15, fq = F.lane >> 4, w = F.wave;
        LAS float* red = (LAS float*)F.lds;
        for (int it = blockIdx.x; it < 192; it += F.G) {
            const int n0 = it * 48;
            f32x4 acc[9][3];
#pragma unroll
            for (int mt = 0; mt < 9; ++mt)
#pragma unroll
                for (int t = 0; t < 3; ++t) acc[mt][t] = (f32x4){0.f, 0.f, 0.f, 0.f};
#pragma unroll 1
            for (int kk = 0; kk < 4; ++kk) {
                const int k0 = 128 * w + 32 * kk + 8 * fq;
                bf16x8 bfrag[3];
#pragma unroll
                for (int t = 0; t < 3; ++t) { float bv[8];
#pragma unroll
                    for (int j = 0; j < 8; ++j) bv[j] = wada[(size_t)(k0 + j) * (NMOD * D) + n0 + 16 * t + fr];
                    const v4u bp = pack8(bv); bfrag[t] = __builtin_bit_cast(bf16x8, bp); }
#pragma unroll
                for (int mt = 0; mt < 9; ++mt) {
                    const int row = 16 * mt + fr;
                    float av[8];
                    if (row < NBATCH) { const float* cp = (row < 8) ? cP + (size_t)row * D : cS + (size_t)(row - 8) * D; ld8f(cp + k0, av);
#pragma unroll
                        for (int j = 0; j < 8; ++j) av[j] = av[j] * sigmoid_f(av[j]); }
                    else {
#pragma unroll
                        for (int j = 0; j < 8; ++j) av[j] = 0.f; }
                    const v4u ap = pack8(av); const bf16x8 afrag = __builtin_bit_cast(bf16x8, ap);
#pragma unroll
                    for (int t = 0; t < 3; ++t) acc[mt][t] = __builtin_amdgcn_mfma_f32_16x16x32_bf16(afrag, bfrag[t], acc[mt][t], 0, 0, 0);
                }
            }
            if (w >= 4) {
#pragma unroll
                for (int mt = 0; mt < 9; ++mt)
#pragma unroll
                    for (int t = 0; t < 3; ++t)
#pragma unroll
                        for (int i = 0; i < 4; ++i) red[((w - 4) * 144 + 16 * mt + 4 * fq + i) * 48 + 16 * t + fr] = acc[mt][t][i];
            }
            __syncthreads();
            if (w < 4) {
#pragma unroll
                for (int mt = 0; mt < 9; ++mt)
#pragma unroll
                    for (int t = 0; t < 3; ++t)
#pragma unroll
                        for (int i = 0; i < 4; ++i) { LAS float* q = red + (w * 144 + 16 * mt + 4 * fq + i) * 48 + 16 * t + fr; *q = *q + acc[mt][t][i]; }
            }
            __syncthreads();
            for (int o = F.tid; o < NBATCH * 48; o += NWAVES * 64) {
                const int row = o / 48, c = o % 48; float sacc = bada[n0 + c];
#pragma unroll
                for (int ww = 0; ww < 4; ++ww) sacc += red[(ww * 144 + row) * 48 + c];
                F.mod[(size_t)row * (NMOD * D) + n0 + c] = sacc;
            }
            __syncthreads();
        }
    }
    transpose_set(F, 0, blockIdx.x * NWAVES + F.wave, F.G * NWAVES);
    for (int o = blockIdx.x * (NWAVES * 64) + F.tid; o < 2 * 32768; o += F.G * NWAVES * 64) {
        const int g = o >> 15, r = o & 32767, h = r >> 12, n = (r >> 6) & 63, k = r & 63;
        const float* w = g ? F.in[19] : F.in[17];
        F.WG[o] = (bf16)f2bf(w[(h * 64 + k) * 64 + n]);
    }
}

__device__ __forceinline__ void norm_pass(Frame& F, const float* srcP, const float* srcS, const float* gain, int ishift, int iscale, int nsplit) {
    const int gw = blockIdx.x * NWAVES + F.wave, NGW = F.G * NWAVES;
    const f32x4* gr = (const f32x4*)gain + F.lane;
    f32x4 g[4];
#pragma unroll
    for (int j = 0; j < 4; ++j) g[j] = gr[64 * j];
    for (int m0 = 2 * gw; m0 < M; m0 += 2 * NGW) {
        f32x4 v[2][4];
#pragma unroll
        for (int q = 0; q < 2; ++q) { const int m = m0 + q;
            const f32x4* xr = (const f32x4*)((m < NP) ? srcP + (size_t)m * D : srcS + (size_t)(m - NP) * D) + F.lane;
#pragma unroll
            for (int j = 0; j < 4; ++j) v[q][j] = xr[64 * j]; }
#pragma unroll
        for (int q = 0; q < 2; ++q) { const int m = m0 + q;
            if (m >= NP && nsplit > 0) {
                for (int sp = 0; sp < nsplit; ++sp) { const f32x4* pr = (const f32x4*)(F.part + ((size_t)sp * NS + (m - NP)) * D) + F.lane;
#pragma unroll
                    for (int j = 0; j < 4; ++j) v[q][j] += pr[64 * j]; }
                f32x4* orow = (f32x4*)(F.out + (size_t)m * D) + F.lane;
#pragma unroll
                for (int j = 0; j < 4; ++j) orow[64 * j] = v[q][j];
            }
            const int b = row_batch(m);
            const f32x4* sh = (const f32x4*)(F.mod + (size_t)(b * NMOD + ishift) * D) + F.lane;
            const f32x4* sc = (const f32x4*)(F.mod + (size_t)(b * NMOD + iscale) * D) + F.lane;
            float s = 0.f;
#pragma unroll
            for (int j = 0; j < 4; ++j) s += (v[q][j].x * v[q][j].x + v[q][j].y * v[q][j].y) + (v[q][j].z * v[q][j].z + v[q][j].w * v[q][j].w);
            const float rstd = 1.0f / sqrtf(wave_sum(s) * (1.f / D) + EPS);
            unsigned long long* o8 = (unsigned long long*)(F.XN + (size_t)m * D) + F.lane;
#pragma unroll
            for (int j = 0; j < 4; ++j) { const f32x4 a = sh[64 * j], c = sc[64 * j];
                const f32x4 o = (v[q][j] * rstd) * g[j] * (c + 1.0f) + a;
                o8[64 * j] = (unsigned long long)pk2(o.x, o.y) | ((unsigned long long)pk2(o.z, o.w) << 32); }
        }
    }
}
__device__ __forceinline__ void final_norm(Frame& F, int nsplit) {
    const int gw = blockIdx.x * NWAVES + F.wave, NGW = F.G * NWAVES;
    const f32x4* gr = (const f32x4*)F.in[28] + F.lane;
    f32x4 g[4];
#pragma unroll
    for (int j = 0; j < 4; ++j) g[j] = gr[64 * j];
    for (int m0 = 2 * gw; m0 < M; m0 += 2 * NGW) {
        f32x4 v[2][4];
#pragma unroll
        for (int q = 0; q < 2; ++q) { f32x4* xr = (f32x4*)(F.out + (size_t)(m0 + q) * D) + F.lane;
#pragma unroll
            for (int j = 0; j < 4; ++j) v[q][j] = xr[64 * j]; }
#pragma unroll
        for (int q = 0; q < 2; ++q) { const int m = m0 + q;
            f32x4* xr = (f32x4*)(F.out + (size_t)m * D) + F.lane;
            if (m >= NP) {
                for (int sp = 0; sp < nsplit; ++sp) { const f32x4* pr = (const f32x4*)(F.part + ((size_t)sp * NS + (m - NP)) * D) + F.lane;
#pragma unroll
                    for (int j = 0; j < 4; ++j) v[q][j] += pr[64 * j]; }
            }
            float s = 0.f;
#pragma unroll
            for (int j = 0; j < 4; ++j) s += (v[q][j].x * v[q][j].x + v[q][j].y * v[q][j].y) + (v[q][j].z * v[q][j].z + v[q][j].w * v[q][j].w);
            const float rstd = 1.0f / sqrtf(wave_sum(s) * (1.f / D) + EPS);
#pragma unroll
            for (int j = 0; j < 4; ++j) xr[64 * j] = (v[q][j] * rstd) * g[j];
        }
    }
}

#ifndef NEG_EXPM1
#define NEG_EXPM1(x) (-expm1f(x))
#endif
constexpr int RS = 1040;
constexpr int XL_OFF = 0, XC_OFF = 67 * RS;
static_assert(XC_OFF % 16 == 0 && XC_OFF + 64 * RS <= LDS_BYTES, "mixer LDS map");
constexpr int CARRY_OFF = XC_OFF + 64 * RS;
static_assert(CARRY_OFF % 16 == 0 && CARRY_OFF + 2048 <= MISC_OFF, "mixer LDS map");
__device__ __forceinline__ float neg_expm1(float x, float ex) {
    const float ser = -x * (1.0f + x * (0.5f + x * (0.16666667f + x * 0.041666668f)));
    return x > -0.125f ? ser : 1.0f - ex;
}
template <int PASS>
__device__ __forceinline__ void mixer_mid(Frame& F) {
    const int tid = F.tid, lane = F.lane, fr = lane & 15, fq = lane >> 4;
    LAS unsigned char* lds = F.lds;
    const bf16* Z = F.Z;
    const float* st_conv = F.in[2]; const float* st_h = F.in[3]; const float* st_sc = F.in[4];
    const int nunits = 256;
    for (int unit = blockIdx.x; unit < nunits; unit += F.G) {
        constexpr bool samp = false;
        const bool full = (PASS == 2) || samp;
        constexpr int ntok = 64;
        const int row0 = samp ? NP + (unit - 256) * 16 : unit * 64;
        const int b = unit >> 5, chunk = unit & 31;
        const int seq0 = (unit - 256) * 4;
        const int chb = 64 * F.wave;
        if (PASS == 2) {
            const float* ap = F.agg + (size_t)(b * 32) * 1024 + tid; float h = 0.f;
            for (int jc = 0; jc < chunk; jc += 8) {
                float A[8], Bv[8];
#pragma unroll
                for (int j = 0; j < 8; ++j) { const bool ok = jc + j < chunk; A[j] = ok ? ap[(size_t)(jc + j) * 1024] : 1.f; Bv[j] = ok ? ap[(size_t)(jc + j) * 1024 + 512] : 0.f; }
#pragma unroll
                for (int j = 0; j < 8; ++j) h = A[j] * h + Bv[j];
            }
            *(LAS float*)(lds + CARRY_OFF + tid * 4) = h;
        }
        for (int p = tid; p < (ntok + 3) * 64; p += NWAVES * 64) {
            const int hr = p >> 6, c16 = p & 63, tok = hr - 3;
            v4u v = (v4u){0u, 0u, 0u, 0u};
            const bool valid = samp ? (tok >= 0) : (tok >= 0 || chunk > 0);
            if (valid) v = *(const v4u*)(Z + (size_t)(row0 + tok) * DIN + c16 * 8);
            *(LAS v4u*)(lds + XL_OFF + hr * RS + c16 * 16) = v;
        }
        if (PASS == 1 && 8 * (tid >> 6) < ntok) {
            const int ch0 = (tid & 63) * 8, r = tid >> 6;
            const float* wsc = F.in[22];
            float w0[8], w1[8], w2[8]; ld8f(wsc + ch0, w0); ld8f(wsc + 512 + ch0, w1); ld8f(wsc + 1024 + ch0, w2);
            float u2[8], u1[8];
#pragma unroll
            for (int j = 0; j < 8; ++j) { u2[j] = 0.f; u1[j] = 0.f; }
            if (!samp && (r > 0 || chunk > 0)) {
                const bf16* zr = Z + (size_t)(row0 + 8 * r - 2) * DIN + ch0;
                float c[8], v[8];
                unpack8(*(const v4u*)(zr + 1536), c); unpack8(*(const v4u*)(zr + 2048), v);
#pragma unroll
                for (int j = 0; j < 8; ++j) u2[j] = c[j] * v[j];
                unpack8(*(const v4u*)(zr + DIN + 1536), c); unpack8(*(const v4u*)(zr + DIN + 2048), v);
#pragma unroll
                for (int j = 0; j < 8; ++j) u1[j] = c[j] * v[j];
            }
#pragma unroll
            for (int hb = 0; hb < 2; ++hb) {
                v4u zb[4], zc[4], zv[4];
#pragma unroll
                for (int t = 0; t < 4; ++t) { const bf16* zr = Z + (size_t)(row0 + 8 * r + 4 * hb + t) * DIN + ch0;
                    zb[t] = *(const v4u*)(zr + 1024); zc[t] = *(const v4u*)(zr + 1536); zv[t] = *(const v4u*)(zr + 2048); }
                const int seq = seq0 + 2 * r + hb;
                if (samp) { ld8f(st_sc + (size_t)(seq * 2 + 0) * 512 + ch0, u2); ld8f(st_sc + (size_t)(seq * 2 + 1) * 512 + ch0, u1); }
#pragma unroll
                for (int t = 0; t < 4; ++t) {
                    const int tok = 8 * r + 4 * hb + t;
                    float bs[8], c[8], v[8], u0[8], o[8];
                    unpack8(zb[t], bs); unpack8(zc[t], c); unpack8(zv[t], v);
#pragma unroll
                    for (int j = 0; j < 8; ++j) { u0[j] = c[j] * v[j]; o[j] = bs[j] * (w0[j] * u2[j] + w1[j] * u1[j] + w2[j] * u0[j]); }
                    *(v4u*)(F.U + (size_t)(row0 + tok) * D + 512 + ch0) = pack8(o);
                    if (samp) { if (t >= 2) st8f(F.out + O_SS + (size_t)(seq * 2 + (t - 2)) * 512 + ch0, u0); }
                    else if (chunk == 31 && tok >= 62) st8f(F.out + O_SP + (size_t)(b * 2 + (tok - 62)) * 512 + ch0, u0);
#pragma unroll
                    for (int j = 0; j < 8; ++j) { u2[j] = u1[j]; u1[j] = u0[j]; }
                }
            }
        }
        __syncthreads();
        if (8 * (tid >> 6) < ntok) {
            const int ch0 = (tid & 63) * 8, r = tid >> 6;
            const float* wc = F.in[15]; const float* bc = F.in[16];
            float w0[8], w1[8], w2[8], w3[8], bb[8];
            ld8f(wc + ch0, w0); ld8f(wc + 512 + ch0, w1); ld8f(wc + 1024 + ch0, w2); ld8f(wc + 1536 + ch0, w3); ld8f(bc + ch0, bb);
            float x3[8], x2[8], x1[8];
            unpack8(*(const LAS v4u*)(lds + XL_OFF + (8 * r + 0) * RS + ch0 * 2), x3);
            unpack8(*(const LAS v4u*)(lds + XL_OFF + (8 * r + 1) * RS + ch0 * 2), x2);
            unpack8(*(const LAS v4u*)(lds + XL_OFF + (8 * r + 2) * RS + ch0 * 2), x1);
#pragma unroll 2
            for (int t = 0; t < 8; ++t) {
                const int tok = 8 * r + t; const int seq = seq0 + (tok >> 2);
                if (samp && (t & 3) == 0) { ld8f(st_conv + (size_t)(seq * 3 + 0) * 512 + ch0, x3); ld8f(st_conv + (size_t)(seq * 3 + 1) * 512 + ch0, x2); ld8f(st_conv + (size_t)(seq * 3 + 2) * 512 + ch0, x1); }
                float x0[8], o[8];
                unpack8(*(const LAS v4u*)(lds + XL_OFF + (tok + 3) * RS + ch0 * 2), x0);
#pragma unroll
                for (int j = 0; j < 8; ++j) o[j] = bb[j] + w3[j] * x0[j] + w2[j] * x1[j] + w1[j] * x2[j] + w0[j] * x3[j];
                *(LAS v4u*)(lds + XC_OFF + tok * RS + ch0 * 2) = pack8(o);
                if (full) {
                    if (samp) { if ((t & 3) >= 1) st8f(F.out + O_CS + (size_t)(seq * 3 + ((t & 3) - 1)) * 512 + ch0, x0); }
                    else if (chunk == 31 && tok >= 61) st8f(F.out + O_CP + (size_t)(b * 3 + (tok - 61)) * 512 + ch0, x0);
                }
#pragma unroll
                for (int j = 0; j < 8; ++j) { x3[j] = x2[j]; x2[j] = x1[j]; x1[j] = x0[j]; }
            }
        }
        __syncthreads();
        bf16x8 wa[4][2], wx[4][2];
        float ba[4], bx[4], cl2[4];
        {
            const bf16* wga = F.WG + (size_t)F.wave * 4096; const bf16* wgx = F.WG + 32768 + (size_t)F.wave * 4096;
#pragma unroll
            for (int nt = 0; nt < 4; ++nt) {
#pragma unroll
                for (int kk = 0; kk < 2; ++kk) { const int o = (16 * nt + fr) * 64 + 32 * kk + 8 * fq;
                    wa[nt][kk] = *(const bf16x8*)(wga + o); wx[nt][kk] = *(const bf16x8*)(wgx + o); }
                const int ch = chb + 16 * nt + fr; ba[nt] = F.in[18][ch]; bx[nt] = F.in[20][ch];
                cl2[nt] = (-8.0f * 1.44269504089f) * log1pf(__expf(-F.in[21][ch]));
            }
        }
        if (full) {
#pragma unroll
            for (int i = 0; i < 8; ++i) { const int p = tid + 512 * i, tok = p >> 6, c16 = p & 63;
                if (tok < ntok) *(LAS v4u*)(lds + XL_OFF + tok * RS + c16 * 16) = *(const v4u*)(Z + (size_t)(row0 + tok) * DIN + 512 + c16 * 8); }
            __syncthreads();
        }
        {
            float hc[4], Ac[4];
#pragma unroll
            for (int nt = 0; nt < 4; ++nt) { hc[nt] = (PASS == 2) ? *(const LAS float*)(lds + CARRY_OFF + (chb + 16 * nt + fr) * 4) : 0.f; Ac[nt] = 1.f; }
#pragma unroll 1
            for (int mt = 0; mt < (ntok >> 4); ++mt) {
                bf16x8 xa[2];
#pragma unroll
                for (int kk = 0; kk < 2; ++kk) xa[kk] = *(const LAS bf16x8*)(lds + XC_OFF + (16 * mt + fr) * RS + (chb + 32 * kk + 8 * fq) * 2);
                f32x4 accA[4], accX[4];
#pragma unroll
                for (int nt = 0; nt < 4; ++nt) { accA[nt] = (f32x4){0.f, 0.f, 0.f, 0.f}; accX[nt] = (f32x4){0.f, 0.f, 0.f, 0.f};
#pragma unroll
                    for (int kk = 0; kk < 2; ++kk) { accA[nt] = __builtin_amdgcn_mfma_f32_16x16x32_bf16(xa[kk], wa[nt][kk], accA[nt], 0, 0, 0);
                        accX[nt] = __builtin_amdgcn_mfma_f32_16x16x32_bf16(xa[kk], wx[nt][kk], accX[nt], 0, 0, 0); } }
#pragma unroll
                for (int nt = 0; nt < 4; ++nt) {
                    const int ch = chb + 16 * nt + fr;
                    float P[4], Hh[4];
#pragma unroll
                    for (int i = 0; i < 4; ++i) {
                        const int tok = 16 * mt + 4 * fq + i;
                        const float xcv = bf2f(*(const LAS unsigned short*)(lds + XC_OFF + tok * RS + ch * 2));
                        const float rg = sigmoid_f(accA[nt][i] + ba[nt]), ig = sigmoid_f(accX[nt][i] + bx[nt]);
                        const float l2 = cl2[nt] * rg;
                        const float a = __builtin_amdgcn_exp2f(l2), mult = __builtin_amdgcn_sqrtf(neg_expm1(l2 * (2.0f * 0.69314718056f), a * a));
                        const float bvv = mult * (ig * xcv);
                        if (i == 0) { P[0] = a; Hh[0] = bvv; } else { P[i] = a * P[i - 1]; Hh[i] = a * Hh[i - 1] + bvv; }
                    }
                    float hin;
                    if (samp) { hin = st_h[(size_t)(seq0 + 4 * mt + fq) * 512 + ch]; }
                    else {
                        float Ai = P[3], Bi = Hh[3];
                        float Au = __shfl_up(Ai, 16), Bu = __shfl_up(Bi, 16);
                        if (fq >= 1) { Bi = Ai * Bu + Bi; Ai = Au * Ai; }
                        Au = __shfl_up(Ai, 32); Bu = __shfl_up(Bi, 32);
                        if (fq >= 2) { Bi = Ai * Bu + Bi; Ai = Au * Ai; }
                        float Ae = __shfl_up(Ai, 16), Be = __shfl_up(Bi, 16);
                        if (fq == 0) { Ae = 1.f; Be = 0.f; }
                        hin = Ae * hc[nt] + Be;
                        const float At = __shfl(Ai, fr + 48), Bt = __shfl(Bi, fr + 48);
                        hc[nt] = At * hc[nt] + Bt;
                        if (PASS == 1) Ac[nt] *= At;
                    }
                    if (full) {
                        float hv[4];
#pragma unroll
                        for (int i = 0; i < 4; ++i) {
                            const int tok = 16 * mt + 4 * fq + i;
                            hv[i] = P[i] * hin + Hh[i];
                            const float g = bf2f(*(const LAS unsigned short*)(lds + XL_OFF + tok * RS + ch * 2));
                            const float y2 = 1.5957691216f * (g + 0.044715f * g * g * g);
                            const float o = hv[i] * (g * sigmoid_f(y2));
                            *(LAS unsigned short*)(lds + XC_OFF + tok * RS + ch * 2) = (unsigned short)f2bf(o);
                        }
                        if (samp) F.out[O_HS + (size_t)(seq0 + 4 * mt + fq) * 512 + ch] = hv[3];
                        else if (chunk == 31 && mt == 3 && fq == 3) F.out[O_HP + (size_t)b * 512 + ch] = hv[3];
                    }
                    __builtin_amdgcn_sched_barrier(0);
                }
            }
            if (PASS == 1 && !samp && fq == 0) {
#pragma unroll
                for (int nt = 0; nt < 4; ++nt) { const int ch = chb + 16 * nt + fr; float* ap = F.agg + (size_t)((b * 32 + chunk) * 2) * 512 + ch; ap[0] = Ac[nt]; ap[512] = hc[nt]; }
            }
        }
        __syncthreads();
        if (full) {
            for (int p = tid; p < ntok * 64; p += NWAVES * 64) {
                const int tok = p >> 6, c16 = p & 63;
                *(v4u*)(F.U + (size_t)(row0 + tok) * D + c16 * 8) = *(const LAS v4u*)(lds + XC_OFF + tok * RS + c16 * 16);
            }
        }
    }
}

__device__ __forceinline__ void sample_mixer(Frame& F) {
    const int gw = blockIdx.x * NWAVES + F.wave, NGW = F.G * NWAVES, lane = F.lane;
    for (int task = gw; task < 128 * 8; task += NGW) {
        const int s = task >> 3, h = task & 7, c = 64 * h + lane;
        const bf16* zr = F.Z + (size_t)(NP + 4 * s) * DIN + c;
        float x[4], g[4], bs[4], cs[4], vs[4];
#pragma unroll
        for (int t = 0; t < 4; ++t) { x[t] = bf2f(zr[t * DIN]); g[t] = bf2f(zr[t * DIN + 512]); bs[t] = bf2f(zr[t * DIN + 1024]); cs[t] = bf2f(zr[t * DIN + 1536]); vs[t] = bf2f(zr[t * DIN + 2048]); }
        const float* sc = F.in[2] + (size_t)s * 3 * 512 + c; const float xm3 = sc[0], xm2 = sc[512], xm1 = sc[1024];
        float hprev = F.in[3][(size_t)s * 512 + c];
        const float* ss = F.in[4] + (size_t)s * 2 * 512 + c; const float um2 = ss[0], um1 = ss[512];
        const float wc0 = F.in[15][c], wc1 = F.in[15][512 + c], wc2 = F.in[15][1024 + c], wc3 = F.in[15][1536 + c], bcv = F.in[16][c];
        const float ws0 = F.in[22][c], ws1 = F.in[22][512 + c], ws2 = F.in[22][1024 + c];
        const float ba = F.in[18][c], bx = F.in[20][c], cl2 = (-8.0f * 1.44269504089f) * log1pf(__expf(-F.in[21][c]));
        float xc[4];
        xc[0] = bcv + wc3 * x[0] + wc2 * xm1 + wc1 * xm2 + wc0 * xm3;
        xc[1] = bcv + wc3 * x[1] + wc2 * x[0] + wc1 * xm1 + wc0 * xm2;
        xc[2] = bcv + wc3 * x[2] + wc2 * x[1] + wc1 * x[0] + wc0 * xm1;
        xc[3] = bcv + wc3 * x[3] + wc2 * x[2] + wc1 * x[1] + wc0 * x[0];
        float aa[4] = {0.f, 0.f, 0.f, 0.f}, ax[4] = {0.f, 0.f, 0.f, 0.f};
        const float* wga = F.in[17] + (size_t)h * 4096 + lane; const float* wgx = F.in[19] + (size_t)h * 4096 + lane;
#pragma unroll 8
        for (int k = 0; k < 64; ++k) { const float wa = wga[k * 64], wx = wgx[k * 64];
#pragma unroll
            for (int t = 0; t < 4; ++t) { const float xk = __shfl(xc[t], k); aa[t] += xk * wa; ax[t] += xk * wx; } }
        float* Urow = nullptr;
#pragma unroll
        for (int t = 0; t < 4; ++t) {
            const float rg = sigmoid_f(aa[t] + ba), ig = sigmoid_f(ax[t] + bx);
            const float l2 = cl2 * rg, a = __builtin_amdgcn_exp2f(l2), mult = __builtin_amdgcn_sqrtf(neg_expm1(l2 * (2.0f * 0.69314718056f), a * a));
            hprev = a * hprev + mult * (ig * xc[t]);
            const float y2 = 1.5957691216f * (g[t] + 0.044715f * g[t] * g[t] * g[t]);
            F.U[(size_t)(NP + 4 * s + t) * D + c] = (bf16)f2bf(hprev * (g[t] * sigmoid_f(y2)));
        }
        (void)Urow;
        F.out[O_HS + (size_t)s * 512 + c] = hprev;
#pragma unroll
        for (int k = 0; k < 3; ++k) F.out[O_CS + (size_t)(s * 3 + k) * 512 + c] = x[k + 1];
        float u[4];
#pragma unroll
        for (int t = 0; t < 4; ++t) u[t] = cs[t] * vs[t];
        const float cv0 = ws0 * um2 + ws1 * um1 + ws2 * u[0], cv1 = ws0 * um1 + ws1 * u[0] + ws2 * u[1], cv2 = ws0 * u[0] + ws1 * u[1] + ws2 * u[2], cv3 = ws0 * u[1] + ws1 * u[2] + ws2 * u[3];
        bf16* Us = F.U + (size_t)(NP + 4 * s) * D + 512 + c;
        Us[0] = (bf16)f2bf(bs[0] * cv0); Us[D] = (bf16)f2bf(bs[1] * cv1); Us[2 * D] = (bf16)f2bf(bs[2] * cv2); Us[3 * D] = (bf16)f2bf(bs[3] * cv3);
        F.out[O_SS + (size_t)(s * 2 + 0) * 512 + c] = u[2]; F.out[O_SS + (size_t)(s * 2 + 1) * 512 + c] = u[3];
    }
}

struct Args { const float* in[29]; float* out; unsigned char* ws; int ph_lo, ph_hi; };
__global__ void __launch_bounds__(NWAVES * 64, 2) fwd_kernel(Args args) {
    extern __shared__ __attribute__((aligned(16))) unsigned char lds_raw[];
    Frame F;
    F.lds = (LAS unsigned char*)lds_raw;
    F.tid = threadIdx.x; F.lane = F.tid & 63; F.wave = __builtin_amdgcn_readfirstlane(F.tid >> 6); F.G = gridDim.x;
#pragma unroll
    for (int i = 0; i < 29; ++i) F.in[i] = args.in[i];
    F.out = args.out;
    unsigned char* ws = args.ws;
    F.mod = (float*)(ws + WS_MOD); F.agg = (float*)(ws + WS_AGG); F.part = (float*)(ws + WS_PART);
    F.W1GU = (bf16*)(ws + WS_W1GU); F.W1D = (bf16*)(ws + WS_W1D); F.WMI = (bf16*)(ws + WS_WMI); F.WMO = (bf16*)(ws + WS_WMO); F.W2GU = (bf16*)(ws + WS_W2GU); F.W2D = (bf16*)(ws + WS_W2D);
    F.WG = (bf16*)(ws + WS_WG); F.XN = (bf16*)(ws + WS_XN); F.U = F.XN; F.H = (bf16*)(ws + WS_H); F.Z = F.H;
    if (F.tid < 4) ((LAS unsigned*)(F.lds + MISC_OFF))[F.tid] = 0u;
    __syncthreads();
    XcdBarrier bar = xcd_barrier_post((unsigned*)(ws + WS_CTL), (volatile LAS unsigned*)(F.lds + MISC_OFF));
    const int lo = args.ph_lo, hi = args.ph_hi;
#ifndef PH_MASK
#define PH_MASK 0x1FFF
#endif
#define IN(k) (((PH_MASK >> (k)) & 1) && lo <= (k) && (k) < hi)
#ifndef REP_MASK
#define REP_MASK 0
#endif
#define REP(k) for (int rep_ = 0; rep_ < (((REP_MASK) >> (k)) & 1) + 1; ++rep_) if (rep_ == 0 || (xcd_barrier(bar), true))
#define SEAM(k) do { if (IN(k) && IN((k) + 1)) { if (lo < 0) cg::this_grid().sync(); else xcd_barrier(bar); } } while (0)

    constexpr int SPLIT_DN = 8, SPLIT_MO = 4;
    if (IN(0)) REP(0) { p0_prologue(F); } SEAM(0);
    if (IN(1)) REP(1) { norm_pass(F, F.in[0], F.in[1], F.in[9], 0, 1, 0); } SEAM(1);
    if (IN(2)) REP(2) { pg8::Gemm g{F.XN, F.W1GU, M, 2 * FF, D}; pg8::StaticOrder S; S.init(M, 2 * FF, D, F.G, (int)blockIdx.x);
        pg8::EpiSwiglu E{F.H, FF}; pg8::gemm_phase<pg8::EpiSwiglu, pg8::StaticOrder, PG8_ALIGN, PG8_SP2>(F.lds, g, S, E);
        { constexpr int first_idle = ((M / 256) * (2 * FF / 256)) % 256; if (rep_ == 0 && F.G == 256 && (int)blockIdx.x >= first_idle) transpose_set(F, 1, ((int)blockIdx.x - first_idle) * NWAVES + F.wave, (256 - first_idle) * NWAVES); else if (rep_ == 0 && F.G != 256) transpose_set(F, 1, blockIdx.x * NWAVES + F.wave, F.G * NWAVES); } } SEAM(2);
    if (IN(3)) REP(3) { pg8::Gemm g{F.H, F.W1D, M, D, FF}; pg8::SplitOrder S; S.init(FF, SPLIT_DN, F.G, (int)blockIdx.x);
        pg8::EpiResid E{F.in[0], F.in[1], F.out, F.mod, 2, 0.5f, F.part}; pg8::gemm_phase<pg8::EpiResid, pg8::SplitOrder, PG8_ALIGN, PG8_SP2>(F.lds, g, S, E);
        { constexpr int first_idle = 8 * SPLIT_DN; if (rep_ == 0 && F.G == 256 && (int)blockIdx.x >= first_idle) transpose_set(F, 2, ((int)blockIdx.x - first_idle) * NWAVES + F.wave, (256 - first_idle) * NWAVES); else if (rep_ == 0 && F.G != 256) transpose_set(F, 2, blockIdx.x * NWAVES + F.wave, F.G * NWAVES); } } SEAM(3);
    if (IN(4)) REP(4) { norm_pass(F, F.out, F.in[1], F.in[13], 3, 4, SPLIT_DN); } SEAM(4);
    if (IN(5)) REP(5) { pg8::Gemm g{F.XN, F.WMI, M, DIN, D}; pg8::StaticOrder S; S.init(M, DIN, D, F.G, (int)blockIdx.x);
        pg8::EpiBf16 E{F.Z, DIN}; pg8::gemm_phase<pg8::EpiBf16, pg8::StaticOrder, PG8_ALIGN, PG8_SP2>(F.lds, g, S, E);
        { constexpr int first_idle = ((M / 256) * (DIN / 256)) % 256; if (rep_ == 0 && F.G == 256 && (int)blockIdx.x >= first_idle) transpose_set(F, 3, ((int)blockIdx.x - first_idle) * NWAVES + F.wave, (256 - first_idle) * NWAVES); else if (rep_ == 0 && F.G != 256) transpose_set(F, 3, blockIdx.x * NWAVES + F.wave, F.G * NWAVES); } } SEAM(5);
    if (IN(6)) REP(6) { sample_mixer(F); mixer_mid<1>(F); } SEAM(6);
    if (IN(7)) REP(7) { mixer_mid<2>(F); } SEAM(7);
    if (IN(8)) REP(8) { pg8::Gemm g{F.U, F.WMO, M, D, D}; pg8::SplitOrder S; S.init(D, SPLIT_MO, F.G, (int)blockIdx.x);
        pg8::EpiResid E{F.out, F.out + (size_t)NP * D, F.out, F.mod, 5, 1.0f, F.part}; pg8::gemm_phase<pg8::EpiResid, pg8::SplitOrder, PG8_ALIGN, PG8_SP2>(F.lds, g, S, E); } SEAM(8);
    if (IN(9)) REP(9) { norm_pass(F, F.out, F.out + (size_t)NP * D, F.in[24], 6, 7, SPLIT_MO); } SEAM(9);
    if (IN(10)) REP(10) { pg8::Gemm g{F.XN, F.W2GU, M, 2 * FF, D}; pg8::StaticOrder S; S.init(M, 2 * FF, D, F.G, (int)blockIdx.x);
        pg8::EpiSwiglu E{F.H, FF}; pg8::gemm_phase<pg8::EpiSwiglu, pg8::StaticOrder, PG8_ALIGN, PG8_SP2>(F.lds, g, S, E); } SEAM(10);
    if (IN(11)) REP(11) { pg8::Gemm g{F.H, F.W2D, M, D, FF}; pg8::SplitOrder S; S.init(FF, SPLIT_DN, F.G, (int)blockIdx.x);
        pg8::EpiResid E{F.out, F.out + (size_t)NP * D, F.out, F.mod, 8, 0.5f, F.part}; pg8::gemm_phase<pg8::EpiResid, pg8::SplitOrder, PG8_ALIGN, PG8_SP2>(F.lds, g, S, E); } SEAM(11);
    if (IN(12)) REP(12) { final_norm(F, SPLIT_DN); }
#undef IN
#undef SEAM
}

extern "C" void kernel_launch(void* const* d_in, const int* in_sizes, int n_in, void* d_out, int out_size, void* d_ws, size_t ws_size, hipStream_t stream) {
    static int grid = 0;
    if (grid == 0) {
        if (n_in != 29 || in_sizes[0] != NP * D || (size_t)out_size != O_END || ws_size < WS_END) {
            fprintf(stderr, "kernel_launch: unexpected shapes: n_in %d in0 %d out %d ws %zu\n", n_in, n_in > 0 ? in_sizes[0] : -1, out_size, ws_size); grid = -1; return; }
        int dev = 0, cus = 0, per_cu = 0;
        (void)hipGetDevice(&dev); (void)hipDeviceGetAttribute(&cus, hipDeviceAttributeMultiprocessorCount, dev);
        if (hipFuncSetAttribute((const void*)fwd_kernel, hipFuncAttributeMaxDynamicSharedMemorySize, LDS_BYTES) != hipSuccess) { fprintf(stderr, "kernel_launch: hipFuncSetAttribute failed\n"); grid = -1; return; }
        if (hipOccupancyMaxActiveBlocksPerMultiprocessor(&per_cu, (const void*)fwd_kernel, NWAVES * 64, LDS_BYTES) != hipSuccess || per_cu < 1) { fprintf(stderr, "kernel_launch: occupancy query says %d\n", per_cu); per_cu = 1; }
        (void)hipGetLastError();
        grid = cus * per_cu;
        fprintf(stderr, "kernel_launch: cus %d per_cu %d grid %d\n", cus, per_cu, grid);
    }
    if (grid < 0) return;
    if (hipMemsetAsync((char*)d_ws + WS_CTL, 0, CTL_ZERO_BYTES, stream) != hipSuccess) { fprintf(stderr, "kernel_launch: memset failed\n"); return; }
    Args a{};
    for (int i = 0; i < 29; ++i) a.in[i] = (const float*)d_in[i];
    a.out = (float*)d_out; a.ws = (unsigned char*)d_ws;
#if MK_N_LAUNCHES == 1
    a.ph_lo = 0; a.ph_hi = N_PHASES;
    void* kargs[] = {&a};
    hipError_t e = hipLaunchCooperativeKernel((const void*)fwd_kernel, dim3(grid), dim3(NWAVES * 64), kargs, LDS_BYTES, stream);
    if (e != hipSuccess) fprintf(stderr, "kernel_launch: cooperative launch failed: %s (grid %d)\n", hipGetErrorString(e), grid);
#else
    for (int li = 0; li < N_PHASES; ++li) {
        a.ph_lo = li; a.ph_hi = li + 1;
        hipLaunchKernelGGL(fwd_kernel, dim3(grid), dim3(NWAVES * 64), LDS_BYTES, stream, a);
    }
#endif
}
```
